# Optimizing an MI355X kernel written in HIP

```python
import math
import jax, jax.numpy as jnp
from jax import lax
import numpy as np

D_MODEL = 1024
BATCH = 8
SEQ = 2048
DEPTH = 1

N_ATTN_HEADS = 4
ATTN_HEAD_DIM = 64
ATTN_V_DIM = 2 * ATTN_HEAD_DIM
ATTN_WIDTH = N_ATTN_HEADS * ATTN_V_DIM
LRU_WIDTH = D_MODEL - ATTN_WIDTH
LRU_BLOCKS = 8
LRU_BLOCK_DIM = LRU_WIDTH // LRU_BLOCKS
LRU_CONV_WIDTH = 4
LRU_CONV_LEFT = 2
LRU_C = 8.0
N_DIRECTIONS = 2
IN_WIDTH = 3 * ATTN_WIDTH + 2 * LRU_WIDTH
D_FF = 2816
FFN_CONV_WIDTH = 3
FFN_CONV_LEFT = (FFN_CONV_WIDTH - 1) // 2
Q_BLOCK = 128
NORM_EPS = 1e-6

kernel_name = "hymba_diffattn_rglru_convglu_encoder"


def rms_norm(x, g):
    xf = x.astype(jnp.float32)
    y = xf * lax.rsqrt(jnp.mean(xf * xf, axis=-1, keepdims=True) + NORM_EPS)
    return (y * g.astype(jnp.float32)).astype(x.dtype)


def depthwise_conv(x, w, b, left):
    width = w.shape[0]
    s = x.shape[1]
    xp = jnp.pad(x, ((0, 0), (left, width - 1 - left), (0, 0)))
    out = b
    for tap in range(width):
        out = out + xp[:, tap:tap + s] * w[tap]
    return out


def diff_attention(q, k, v, lam, lambda_init, subln_g):
    b, s, _ = q.shape
    qh = q.reshape(b, s, N_ATTN_HEADS, 2, ATTN_HEAD_DIM)
    kh = k.reshape(b, s, N_ATTN_HEADS, 2, ATTN_HEAD_DIM)
    vh = v.reshape(b, s, N_ATTN_HEADS, ATTN_V_DIM).astype(jnp.float32)
    scale = ATTN_HEAD_DIM ** -0.5
    slopes = jnp.exp2(-8.0 * jnp.arange(1, N_ATTN_HEADS + 1, dtype=jnp.float32) / N_ATTN_HEADS)
    key_pos = jnp.arange(s)

    def block(start):
        qb = lax.dynamic_slice_in_dim(qh, start, Q_BLOCK, axis=1)
        sc = jnp.einsum('bqhcd,bkhcd->bhcqk', qb, kh).astype(jnp.float32) * scale
        dist = jnp.abs(start + jnp.arange(Q_BLOCK)[:, None] - key_pos[None, :]).astype(jnp.float32)
        sc = sc - slopes[:, None, None, None] * dist
        p = jax.nn.softmax(sc, axis=-1)
        w = p[:, :, 0] - lam * p[:, :, 1]
        return jnp.einsum('bhqk,bkhe->bqhe', w, vh)

    starts = jnp.arange(s // Q_BLOCK) * Q_BLOCK
    o = lax.map(block, starts)
    o = jnp.moveaxis(o, 0, 1).reshape(b, s, N_ATTN_HEADS, ATTN_V_DIM)
    o = rms_norm(o, subln_g) * (1.0 - lambda_init)
    return o.reshape(b, s, ATTN_WIDTH).astype(q.dtype)


def _linear_combine(c1, c2):
    a1, b1 = c1
    a2, b2 = c2
    return a1 * a2, a2 * b1 + b2


def rg_lru(xc, w_a, b_a, w_x, b_x, lru_lambda, reverse):
    b, s, c = xc.shape
    xb = xc.reshape(b, s, LRU_BLOCKS, LRU_BLOCK_DIM)
    r = jax.nn.sigmoid(jnp.einsum('bsni,nij->bsnj', xb, w_a.astype(jnp.float32)).reshape(b, s, c)
                       + b_a.astype(jnp.float32))
    i = jax.nn.sigmoid(jnp.einsum('bsni,nij->bsnj', xb, w_x.astype(jnp.float32)).reshape(b, s, c)
                       + b_x.astype(jnp.float32))
    log_a = -LRU_C * r * jax.nn.softplus(-lru_lambda.astype(jnp.float32))
    a = jnp.exp(log_a)
    u = jnp.sqrt(-jnp.expm1(2.0 * log_a)) * (i * xc)
    _, h = lax.associative_scan(_linear_combine, (a, u), axis=1, reverse=reverse)
    return h


def recurrent_group(xr, gr, conv_w, conv_b, w_a, b_a, w_x, b_x, lru_lambda):
    xc = depthwise_conv(xr, conv_w, conv_b, LRU_CONV_LEFT).astype(jnp.float32)
    y = (rg_lru(xc, w_a[0], b_a[0], w_x[0], b_x[0], lru_lambda[0], reverse=False)
         + rg_lru(xc, w_a[1], b_a[1], w_x[1], b_x[1], lru_lambda[1], reverse=True))
    return (jax.nn.gelu(gr.astype(jnp.float32)) * y).astype(xr.dtype)


def conv_glu_ffn(h, w_up, conv_w, conv_b, w_down):
    u = depthwise_conv(h @ w_up, conv_w, conv_b, FFN_CONV_LEFT)
    gate, val = jnp.split(u, 2, axis=-1)
    return (jax.nn.gelu(gate) * val) @ w_down


def setup_inputs(seed: int = 0) -> dict:
    key = jax.random.key(seed)
    ks = jax.random.split(key, 24)
    f32 = jnp.float32

    def nrm(k, shape, scale):
        return jax.random.normal(k, shape, f32) * scale

    a0 = jax.random.uniform(ks[12], (DEPTH, N_DIRECTIONS, LRU_WIDTH), f32, 0.9, 0.999)
    s0 = a0 ** (1.0 / LRU_C)
    lru_lambda = jnp.log(s0) - jnp.log1p(-s0)
    return {
        "x": jax.random.normal(ks[0], (BATCH, SEQ, D_MODEL), f32),
        "attn_norm_g": 1.0 + nrm(ks[1], (DEPTH, D_MODEL), 0.02),
        "w_in": nrm(ks[2], (DEPTH, D_MODEL, IN_WIDTH), D_MODEL ** -0.5),
        "lambda_q1": nrm(ks[3], (DEPTH, ATTN_HEAD_DIM), 0.1),
        "lambda_k1": nrm(ks[4], (DEPTH, ATTN_HEAD_DIM), 0.1),
        "lambda_q2": nrm(ks[5], (DEPTH, ATTN_HEAD_DIM), 0.1),
        "lambda_k2": nrm(ks[6], (DEPTH, ATTN_HEAD_DIM), 0.1),
        "subln_g": 1.0 + nrm(ks[7], (DEPTH, ATTN_V_DIM), 0.02),
        "lru_conv_w": nrm(ks[8], (DEPTH, LRU_CONV_WIDTH, LRU_WIDTH), LRU_CONV_WIDTH ** -0.5),
        "lru_conv_b": nrm(ks[9], (DEPTH, LRU_WIDTH), 0.02),
        "lru_w_a": nrm(ks[10], (DEPTH, N_DIRECTIONS, LRU_BLOCKS, LRU_BLOCK_DIM, LRU_BLOCK_DIM), LRU_BLOCK_DIM ** -0.5),
        "lru_b_a": nrm(ks[11], (DEPTH, N_DIRECTIONS, LRU_WIDTH), 0.1),
        "lru_w_x": nrm(ks[13], (DEPTH, N_DIRECTIONS, LRU_BLOCKS, LRU_BLOCK_DIM, LRU_BLOCK_DIM), LRU_BLOCK_DIM ** -0.5),
        "lru_b_x": nrm(ks[14], (DEPTH, N_DIRECTIONS, LRU_WIDTH), 0.1),
        "lru_lambda": lru_lambda,
        "w_out": nrm(ks[15], (DEPTH, D_MODEL, D_MODEL), D_MODEL ** -0.5),
        "ffn_norm_g": 1.0 + nrm(ks[16], (DEPTH, D_MODEL), 0.02),
        "w_up": nrm(ks[17], (DEPTH, D_MODEL, 2 * D_FF), D_MODEL ** -0.5),
        "ffn_conv_w": nrm(ks[18], (DEPTH, FFN_CONV_WIDTH, 2 * D_FF), FFN_CONV_WIDTH ** -0.5),
        "ffn_conv_b": nrm(ks[19], (DEPTH, 2 * D_FF), 0.02),
        "w_down": nrm(ks[20], (DEPTH, D_FF, D_MODEL), D_FF ** -0.5),
        "final_norm_g": 1.0 + nrm(ks[21], (D_MODEL,), 0.02),
    }


def reference(x, attn_norm_g, w_in, lambda_q1, lambda_k1, lambda_q2, lambda_k2, subln_g,
              lru_conv_w, lru_conv_b, lru_w_a, lru_b_a, lru_w_x, lru_b_x, lru_lambda,
              w_out, ffn_norm_g, w_up, ffn_conv_w, ffn_conv_b, w_down, final_norm_g):
    for l in range(DEPTH):
        h = rms_norm(x, attn_norm_g[l])
        proj = h @ w_in[l]
        q, k, v, xr, gr = jnp.split(
            proj, [ATTN_WIDTH, 2 * ATTN_WIDTH, 3 * ATTN_WIDTH, 3 * ATTN_WIDTH + LRU_WIDTH], axis=-1)
        lambda_init = 0.8 - 0.6 * math.exp(-0.3 * l)
        lam = (jnp.exp(jnp.sum(lambda_q1[l].astype(jnp.float32) * lambda_k1[l].astype(jnp.float32)))
               - jnp.exp(jnp.sum(lambda_q2[l].astype(jnp.float32) * lambda_k2[l].astype(jnp.float32)))
               + lambda_init)
        attn_out = diff_attention(q, k, v, lam, lambda_init, subln_g[l])
        lru_out = recurrent_group(xr, gr, lru_conv_w[l], lru_conv_b[l], lru_w_a[l], lru_b_a[l],
                                  lru_w_x[l], lru_b_x[l], lru_lambda[l])
        x = x + jnp.concatenate([attn_out, lru_out], axis=-1) @ w_out[l]
        x = x + conv_glu_ffn(rms_norm(x, ffn_norm_g[l]), w_up[l], ffn_conv_w[l], ffn_conv_b[l], w_down[l])
    return rms_norm(x, final_norm_g)
```

```cpp
#include <hip/hip_runtime.h>
#include <hip/hip_cooperative_groups.h>
#include <cstdint>
#include <cstdio>
namespace cg = cooperative_groups;
#ifndef EXP_REP_LRU
#define EXP_REP_LRU 1
#endif
#ifndef EXP_REP_ATT
#define EXP_REP_ATT 1
#endif
#ifndef EXP_REP_P1
#define EXP_REP_P1 1
#endif
#ifndef EXP_REP_P4
#define EXP_REP_P4 1
#endif
#ifndef EXP_REP_P0
#define EXP_REP_P0 1
#endif
#ifndef EXP_EXTRA_SYNC
#define EXP_EXTRA_SYNC 0
#endif
#ifndef EXP_REP_P3
#define EXP_REP_P3 1
#endif
#ifndef EXP_REP_P5
#define EXP_REP_P5 1
#endif
#ifndef EXP_MIXSCALE
#define EXP_MIXSCALE 1.f
#endif
#ifndef EXP_FFNSCALE
#define EXP_FFNSCALE 1.f
#endif
#ifndef EXP_ATTSCALE
#define EXP_ATTSCALE 1.f
#endif
#ifndef EXP_LRUSCALE
#define EXP_LRUSCALE 1.f
#endif

#define LAS __attribute__((address_space(3)))
typedef short bf16x8 __attribute__((ext_vector_type(8)));
typedef short s16x4 __attribute__((ext_vector_type(4)));
typedef float f32x2 __attribute__((ext_vector_type(2)));
typedef float f32x4 __attribute__((ext_vector_type(4)));
typedef float f32x8 __attribute__((ext_vector_type(8)));
typedef float f32x16 __attribute__((ext_vector_type(16)));
typedef unsigned u32x2 __attribute__((ext_vector_type(2)));
typedef unsigned u32x4 __attribute__((ext_vector_type(4)));

constexpr int T_ = 16384, DM = 1024, SEQ = 2048, INW = 2560, FF = 2816, FF2 = 5632;
constexpr float EPS = 1e-6f, L2E = 1.4426950408889634f;
constexpr size_t MiB = 1u << 20;
constexpr size_t WS_BAR = 262144;
constexpr size_t WS_PCNT = 327680;
constexpr size_t WS_LCNT = 360448;
constexpr size_t WS_ZERO_BYTES = 393216;
constexpr size_t WS_QUEUE = 0, WS_SS1 = 65536, WS_SS2 = 131072, WS_RS0 = 196608;
constexpr size_t WS_WIN = 1 * MiB, WS_WOUT = 6 * MiB, WS_WUP = 8 * MiB, WS_WDN = 19 * MiB;
constexpr size_t WS_XB = 26 * MiB;
constexpr size_t WS_PROJ = 59 * MiB;
constexpr size_t WS_MIX = 139 * MiB;
constexpr size_t WS_YS = 171 * MiB;
constexpr size_t WS_ACT = 59 * MiB;
constexpr size_t WS_END = 235 * MiB;
constexpr int LDS_EDGE = 131072, LDS_TOT = 135168, LDS_CW = 143360, LDS_MISC = 145408, LDS_BYTES = 147456;

__device__ __forceinline__ unsigned cvtpk(float lo, float hi) { unsigned r; asm volatile("v_cvt_pk_bf16_f32 %0, %1, %2" : "=v"(r) : "v"(lo), "v"(hi)); return r; }
__device__ __forceinline__ float bf2f(short s) { return __uint_as_float(((unsigned)(unsigned short)s) << 16); }
__device__ __forceinline__ bf16x8 pack8(f32x8 x) { u32x4 w = {cvtpk(x[0], x[1]), cvtpk(x[2], x[3]), cvtpk(x[4], x[5]), cvtpk(x[6], x[7])}; return __builtin_bit_cast(bf16x8, w); }
__device__ __forceinline__ float gelu_tanh(float x) {
    const float e = __builtin_amdgcn_exp2f(-2.302208198f * x * (1.f + 0.044715f * x * x));
    return x * __builtin_amdgcn_rcpf(1.f + e);
}
__device__ __forceinline__ float wave_sum(float v) {
#pragma unroll
    for (int o = 1; o < 64; o <<= 1) v += __shfl_xor(v, o);
    return v;
}
typedef unsigned short bf16_t;
namespace pg8 {
#define PG8_LAS __attribute__((address_space(3)))
constexpr int BM = 256, BK = 64, HALF = 128, HTB = HALF * BK * 2  , STAGE_BYTES = 8 * HTB, NXCD = 8, WGM = 8;

__host__ __device__ __forceinline__ int lds_byte(int r, int c) { const int st = (r >> 4) * 2 + (c >> 5), rr = r & 15, cc = c & 31, ob = rr * 64 + cc * 2; return st * 1024 + (ob ^ (((ob >> 9) & 1) << 5)); }
__host__ __device__ __forceinline__ void stage_rc(int b, int& R, int& C) { const int st = b / 1024, sb = b % 1024, swz = sb ^ (((sb >> 9) & 1) << 5); R = (st >> 1) * 16 + swz / 64; C = (st & 1) * 32 + (swz % 64) / 2; }
__host__ __device__ __forceinline__ int perm32(int rho) { const int n = rho >> 4, i = rho & 15; return 8 * (i >> 2) + 4 * n + (i & 3); }

struct Unit { int pm, pn; };
struct Gemm { const bf16_t* A; const bf16_t* Bt; int M, N, K, a_rows; };

struct StaticOrder {
    int nM, nN, nwg, G, c;
    __host__ __device__ void init(int M, int N, int G_, int c_) { nM = M / BM; nN = N / BM; nwg = nM * nN; G = G_; c = c_; }
    __host__ __device__ bool next(int i, Unit& u) const {
        const long L = (long)i * G + c; if (L >= nwg) return false;
        int wgid = (int)L; { const int q = nwg / NXCD, r = nwg % NXCD, xcd = wgid % NXCD, off = wgid / NXCD; wgid = (xcd < r ? xcd * (q + 1) : r * (q + 1) + (xcd - r) * q) + off; }
        const int nig = WGM * nN, gid = wgid / nig, fm = gid * WGM, gsz = (nM - fm) < WGM ? (nM - fm) : WGM;
        u.pm = fm + ((wgid % nig) % gsz); u.pn = (wgid % nig) / gsz; return true;
    }
    __device__ __forceinline__ void a_ready(const Unit&) const {}
    __device__ __forceinline__ void done(const Unit&) const {}
};
struct EpiProj {
    static constexpr bool PERM = true, AFTER_DRAIN = false;
    bf16_t* O; int ldc; const float* rs;
    __device__ __forceinline__ void operator()(f32x4 (&acc)[2][2][4][2], const Unit& u, int wr, int wc, int fr, int fq) const {
        const int row0 = u.pm * BM + wr * 64 + fr, col0 = u.pn * BM + wc * 32 + 8 * fq;
#pragma unroll
        for (int ai = 0; ai < 2; ++ai)
#pragma unroll
            for (int m = 0; m < 4; ++m) { const int row = row0 + ai * HALF + m * 16; const float s = rs[row]; bf16_t* rowp = O + (size_t)row * ldc + col0;
#pragma unroll
                for (int bj = 0; bj < 2; ++bj) { const f32x4 v0 = acc[ai][bj][m][0] * s, v1 = acc[ai][bj][m][1] * s;
                    u32x4 w; w.x = cvtpk(v0[0], v0[1]); w.y = cvtpk(v0[2], v0[3]); w.z = cvtpk(v1[0], v1[1]); w.w = cvtpk(v1[2], v1[3]);
                    *(u32x4*)(rowp + bj * HALF) = w; } }
    }
};
struct EpiRes {
    static constexpr bool PERM = false, AFTER_DRAIN = false;
    const float* base; float* out; bf16_t* xb; float* ss; float ascale;
    __device__ __forceinline__ void operator()(f32x4 (&acc)[2][2][4][2], const Unit& u, int wr, int wc, int fr, int fq) const {
        const int row0 = u.pm * BM + wr * 64 + fr, col0 = u.pn * BM + wc * 32 + 4 * fq;
#pragma unroll
        for (int ai = 0; ai < 2; ++ai)
#pragma unroll
            for (int m = 0; m < 4; ++m) { const int row = row0 + ai * HALF + m * 16; const size_t off = (size_t)row * 1024 + col0; float sq = 0.f;
#pragma unroll
                for (int bj = 0; bj < 2; ++bj)
#pragma unroll
                    for (int n = 0; n < 2; ++n) { const size_t o2 = off + bj * HALF + n * 16; const f32x4 b = *(const f32x4*)(base + o2); const f32x4 o = b + acc[ai][bj][m][n] * ascale;
                        *(f32x4*)(out + o2) = o; sq += (o[0] * o[0] + o[1] * o[1]) + (o[2] * o[2] + o[3] * o[3]);
                        if (xb) { u32x2 w; w.x = cvtpk(o[0], o[1]); w.y = cvtpk(o[2], o[3]); *(u32x2*)(xb + o2) = w; } }
                sq += __shfl_xor(sq, 16); sq += __shfl_xor(sq, 32);
                if (fq == 0) atomicAdd(ss + row, sq); }
    }
};
__device__ __forceinline__ float bflo(unsigned w) { return __uint_as_float(w << 16); }
__device__ __forceinline__ float bfhi(unsigned w) { return __uint_as_float(w & 0xffff0000u); }
struct EpiResBf {
    static constexpr bool PERM = false, AFTER_DRAIN = false;
    bf16_t* xb; float* ss; PG8_LAS float* red;
    __device__ __forceinline__ void operator()(f32x4 (&acc)[2][2][4][2], const Unit& u, int wr, int wc, int fr, int fq) const {
        const int row0 = u.pm * BM + wr * 64 + fr, col0 = u.pn * BM + wc * 32 + 4 * fq;
#pragma unroll
        for (int ai = 0; ai < 2; ++ai)
#pragma unroll
            for (int m = 0; m < 4; ++m) { const int row = row0 + ai * HALF + m * 16; const size_t off = (size_t)row * 1024 + col0; float sq = 0.f;
#pragma unroll
                for (int bj = 0; bj < 2; ++bj)
#pragma unroll
                    for (int n = 0; n < 2; ++n) { const size_t o2 = off + bj * HALF + n * 16; const u32x2 bw = *(const u32x2*)(xb + o2); const f32x4 b = {bflo(bw.x), bfhi(bw.x), bflo(bw.y), bfhi(bw.y)}; const f32x4 o = b + acc[ai][bj][m][n];
                        u32x2 w; w.x = cvtpk(o[0], o[1]); w.y = cvtpk(o[2], o[3]); *(u32x2*)(xb + o2) = w;
                        const float r0 = bflo(w.x), r1 = bfhi(w.x), r2 = bflo(w.y), r3 = bfhi(w.y); sq += (r0 * r0 + r1 * r1) + (r2 * r2 + r3 * r3); }
                sq += __shfl_xor(sq, 16); sq += __shfl_xor(sq, 32);
                if (fq == 0) red[wc * 256 + ai * HALF + wr * 64 + m * 16 + fr] = sq; }
        asm volatile("s_waitcnt lgkmcnt(0)" ::: "memory"); __builtin_amdgcn_s_barrier(); asm volatile("" ::: "memory");
        if (threadIdx.x < 256) { const int r = threadIdx.x; atomicAdd(ss + u.pm * BM + r, (red[r] + red[256 + r]) + (red[512 + r] + red[768 + r])); }
    }
};
struct EpiResNorm {
    static constexpr bool PERM = false, AFTER_DRAIN = false;
    const bf16_t* base; float* out; float* ss; unsigned* cnt; const float* gain; PG8_LAS float* red;
    __device__ __forceinline__ void operator()(f32x4 (&acc)[2][2][4][2], const Unit& u, int wr, int wc, int fr, int fq) const {
        const int row0 = u.pm * BM + wr * 64 + fr, col0 = u.pn * BM + wc * 32 + 4 * fq;
#pragma unroll
        for (int ai = 0; ai < 2; ++ai)
#pragma unroll
            for (int m = 0; m < 4; ++m) { const int row = row0 + ai * HALF + m * 16; const size_t off = (size_t)row * 1024 + col0; float sq = 0.f;
#pragma unroll
                for (int bj = 0; bj < 2; ++bj)
#pragma unroll
                    for (int n = 0; n < 2; ++n) { const u32x2 bw = *(const u32x2*)(base + off + bj * HALF + n * 16); const f32x4 b = {bflo(bw.x), bfhi(bw.x), bflo(bw.y), bfhi(bw.y)}; const f32x4 o = b + acc[ai][bj][m][n];
                        acc[ai][bj][m][n] = o; sq += (o[0] * o[0] + o[1] * o[1]) + (o[2] * o[2] + o[3] * o[3]); }
                sq += __shfl_xor(sq, 16); sq += __shfl_xor(sq, 32);
                if (fq == 0) red[wc * 256 + ai * HALF + wr * 64 + m * 16 + fr] = sq; }
        asm volatile("s_waitcnt lgkmcnt(0)" ::: "memory"); __builtin_amdgcn_s_barrier(); asm volatile("" ::: "memory");
        unsigned* pc = cnt + 64 * u.pm;
        if (threadIdx.x < 256) { const int r = threadIdx.x;
            __hip_atomic_fetch_add(ss + u.pm * BM + r, (red[r] + red[256 + r]) + (red[512 + r] + red[768 + r]), __ATOMIC_RELAXED, __HIP_MEMORY_SCOPE_AGENT);
            asm volatile("s_waitcnt vmcnt(0)" ::: "memory");
            if ((threadIdx.x & 63) == 0) __hip_atomic_fetch_add(pc, 1u, __ATOMIC_RELAXED, __HIP_MEMORY_SCOPE_AGENT); }
        if (threadIdx.x < 64) { unsigned sp = 0;
            while ((unsigned)__builtin_amdgcn_readfirstlane(__hip_atomic_load(pc, __ATOMIC_RELAXED, __HIP_MEMORY_SCOPE_AGENT)) < 16u) { __builtin_amdgcn_s_sleep(2); if (++sp > (1u << 22)) break; }
            __builtin_amdgcn_fence(__ATOMIC_ACQUIRE, "agent"); }
        asm volatile("s_waitcnt vmcnt(0) lgkmcnt(0)" ::: "memory"); __builtin_amdgcn_s_barrier(); asm volatile("" ::: "memory");
        f32x4 gv[2][2];
#pragma unroll
        for (int bj = 0; bj < 2; ++bj)
#pragma unroll
            for (int n = 0; n < 2; ++n) gv[bj][n] = *(const f32x4*)(gain + col0 + bj * HALF + n * 16);
#pragma unroll
        for (int ai = 0; ai < 2; ++ai)
#pragma unroll
            for (int m = 0; m < 4; ++m) { const int row = row0 + ai * HALF + m * 16; const size_t off = (size_t)row * 1024 + col0;
                const float rs = __builtin_amdgcn_rsqf(__hip_atomic_load(ss + row, __ATOMIC_RELAXED, __HIP_MEMORY_SCOPE_AGENT) * (1.f / 1024.f) + EPS);
#pragma unroll
                for (int bj = 0; bj < 2; ++bj)
#pragma unroll
                    for (int n = 0; n < 2; ++n) *(f32x4*)(out + off + bj * HALF + n * 16) = acc[ai][bj][m][n] * rs * gv[bj][n]; }
    }
};
__device__ __forceinline__ f32x4 dpp_shr1(f32x4 c, f32x4 old) { float r0 = old[0], r1 = old[1], r2 = old[2], r3 = old[3];
    asm("s_nop 1\n\tv_mov_b32_dpp %0, %4 row_shr:1 row_mask:0xf bank_mask:0xf\n\tv_mov_b32_dpp %1, %5 row_shr:1 row_mask:0xf bank_mask:0xf\n\tv_mov_b32_dpp %2, %6 row_shr:1 row_mask:0xf bank_mask:0xf\n\tv_mov_b32_dpp %3, %7 row_shr:1 row_mask:0xf bank_mask:0xf"
        : "+&v"(r0), "+&v"(r1), "+&v"(r2), "+&v"(r3) : "v"(c[0]), "v"(c[1]), "v"(c[2]), "v"(c[3]));
    return (f32x4){r0, r1, r2, r3}; }
__device__ __forceinline__ f32x4 dpp_shl1(f32x4 c, f32x4 old) { float r0 = old[0], r1 = old[1], r2 = old[2], r3 = old[3];
    asm("s_nop 1\n\tv_mov_b32_dpp %0, %4 row_shl:1 row_mask:0xf bank_mask:0xf\n\tv_mov_b32_dpp %1, %5 row_shl:1 row_mask:0xf bank_mask:0xf\n\tv_mov_b32_dpp %2, %6 row_shl:1 row_mask:0xf bank_mask:0xf\n\tv_mov_b32_dpp %3, %7 row_shl:1 row_mask:0xf bank_mask:0xf"
        : "+&v"(r0), "+&v"(r1), "+&v"(r2), "+&v"(r3) : "v"(c[0]), "v"(c[1]), "v"(c[2]), "v"(c[3]));
    return (f32x4){r0, r1, r2, r3}; }
__device__ __forceinline__ f32x4 dpp_mirror(f32x4 c) { float r0, r1, r2, r3;
    asm("s_nop 1\n\tv_mov_b32_dpp %0, %4 row_mirror row_mask:0xf bank_mask:0xf\n\tv_mov_b32_dpp %1, %5 row_mirror row_mask:0xf bank_mask:0xf\n\tv_mov_b32_dpp %2, %6 row_mirror row_mask:0xf bank_mask:0xf\n\tv_mov_b32_dpp %3, %7 row_mirror row_mask:0xf bank_mask:0xf"
        : "=&v"(r0), "=&v"(r1), "=&v"(r2), "=&v"(r3) : "v"(c[0]), "v"(c[1]), "v"(c[2]), "v"(c[3]));
    return (f32x4){r0, r1, r2, r3}; }
struct EpiUp {
    static constexpr bool PERM = false, AFTER_DRAIN = false;
    bf16_t* act; const float* ss1; const float* cw; const float* cb; PG8_LAS float* edge;
    __device__ __forceinline__ void operator()(f32x4 (&acc)[2][2][4][2], const Unit& u, int wr, int wc, int fr, int fq) const {
        const int tbase = u.pm * 254 - 1;
        const bool bnd = ((tbase + 1) >> 11) != ((tbase + 256) >> 11) || ((tbase + 1) & (SEQ - 1)) == 0 || tbase < 0;
#pragma unroll
        for (int ai = 0; ai < 2; ++ai)
#pragma unroll
            for (int m = 0; m < 4; ++m) { const int t = tbase + ai * HALF + wr * 64 + m * 16 + fr; float s = 0.f;
                if (t >= 0 && t < T_) s = __builtin_amdgcn_rsqf(ss1[t] * (1.f / 1024.f) + EPS);
#pragma unroll
                for (int bj = 0; bj < 2; ++bj)
#pragma unroll
                    for (int n = 0; n < 2; ++n) acc[ai][bj][m][n] *= s; }
        const int colw = wc * 32 + 4 * fq;
        if (fr == 0 || fr == 15) { const int e = (fr == 15) ? 1 : 0;
#pragma unroll
            for (int ai = 0; ai < 2; ++ai) { const int g = 2 * ai + wr;
#pragma unroll
                for (int bj = 0; bj < 2; ++bj)
#pragma unroll
                    for (int n = 0; n < 2; ++n) *(PG8_LAS f32x4*)(edge + ((g * 2 + e) * 256 + 128 * bj + colw + 16 * n)) = e ? acc[ai][bj][3][n] : acc[ai][bj][0][n]; } }
        asm volatile("s_waitcnt lgkmcnt(0)" ::: "memory"); __builtin_amdgcn_s_barrier(); asm volatile("" ::: "memory");
#pragma unroll
        for (int n = 0; n < 2; ++n) {
            const int f = u.pn * 128 + wc * 32 + 16 * n + 4 * fq;
            f32x4 w0[2], w1[2], w2[2], bb[2];
#pragma unroll
            for (int bj = 0; bj < 2; ++bj) { const int c = f + bj * FF; w0[bj] = *(const f32x4*)(cw + c); w1[bj] = *(const f32x4*)(cw + FF2 + c); w2[bj] = *(const f32x4*)(cw + 2 * FF2 + c); bb[bj] = *(const f32x4*)(cb + c); }
#pragma unroll
            for (int ai = 0; ai < 2; ++ai) { const int g = 2 * ai + wr;
#pragma unroll
                for (int m = 0; m < 4; ++m) { const int R = ai * HALF + wr * 64 + m * 16 + fr, t = tbase + R, tp = t & (SEQ - 1);
                    f32x4 uu[2];
#pragma unroll
                    for (int bj = 0; bj < 2; ++bj) { const f32x4 cur = acc[ai][bj][m][n]; f32x4 upe, dne;
                        if (m > 0) upe = dpp_mirror(acc[ai][bj][m - 1][n]); else upe = (g > 0) ? *(PG8_LAS const f32x4*)(edge + (((g - 1) * 2 + 1) * 256 + 128 * bj + colw + 16 * n)) : (f32x4){0.f, 0.f, 0.f, 0.f};
                        if (m < 3) dne = dpp_mirror(acc[ai][bj][m + 1][n]); else dne = (g < 3) ? *(PG8_LAS const f32x4*)(edge + (((g + 1) * 2 + 0) * 256 + 128 * bj + colw + 16 * n)) : (f32x4){0.f, 0.f, 0.f, 0.f};
                        f32x4 up = dpp_shr1(cur, upe), dn = dpp_shl1(cur, dne);
                        if (bnd) {
                            if (tp == 0) up = (f32x4){0.f, 0.f, 0.f, 0.f};
                            if (tp == SEQ - 1) dn = (f32x4){0.f, 0.f, 0.f, 0.f}; }
                        uu[bj] = bb[bj] + w0[bj] * up + w1[bj] * cur + w2[bj] * dn; }
                    if (R >= 1 && R <= 254 && t < T_) { u32x2 w; w.x = cvtpk(gelu_tanh(uu[0][0]) * uu[1][0], gelu_tanh(uu[0][1]) * uu[1][1]); w.y = cvtpk(gelu_tanh(uu[0][2]) * uu[1][2], gelu_tanh(uu[0][3]) * uu[1][3]);
                        *(u32x2*)(act + (size_t)t * FF + f) = w; } } }
        }
    }
};
template <class Epi, class Sched, bool ALIGN_EPI = false, bool SP2 = false>
__device__ __forceinline__ void gemm_phase(PG8_LAS unsigned char* lds, const Gemm g, const Sched& S, const Epi& E) {
    int tid_l = threadIdx.x; asm volatile("" : "+v"(tid_l));
    const int tid = tid_l, wid = __builtin_amdgcn_readfirstlane(tid >> 6), lane = tid & 63, wr = wid >> 2, wc = wid & 3, fr = lane & 15, fq = lane >> 4;
    const int K = g.K, nt = K / BK;
    unsigned voffA[2], voffB[2];
#pragma unroll
    for (int i = 0; i < 2; ++i) { int R, C; stage_rc(tid * 16 + i * 8192, R, C); const int Rb = Epi::PERM ? ((R & ~31) + perm32(R & 31)) : R;
        voffA[i] = (unsigned)(R * K + C) * 2u; voffB[i] = (unsigned)(Rb * K + C) * 2u; }
    const size_t kstep = (size_t)(BK * 2);
    const size_t hstep = (size_t)HALF * K * 2;
    const size_t tstep = 2 * hstep; const size_t tstepA = (size_t)g.a_rows * K * 2;
    const unsigned ldsw = (unsigned)wid * 1024u;
    const int aoff = lds_byte(wr * 64 + fr, fq * 8), boff = lds_byte(wc * 32 + fr, fq * 8);
#define PG8_SA(b, h) (((b) * 2 + (h)) * HTB)
#define PG8_SB(b, h) ((4 + (b) * 2 + (h)) * HTB)
#define PG8_STAGE(bufoff, gbase, voff) do { _Pragma("unroll") for (int _i = 0; _i < 2; ++_i) \
        __builtin_amdgcn_global_load_lds((const unsigned*)((const char*)(gbase) + (voff)[_i]), (PG8_LAS unsigned*)(lds + (bufoff) + ldsw + _i * 8192), 16, 0, 0); } while (0)
#define PG8_LDA(dst, b, h) do { _Pragma("unroll") for (int m = 0; m < 4; ++m) _Pragma("unroll") for (int k = 0; k < 2; ++k) dst[m][k] = *(const PG8_LAS bf16x8*)(lds + PG8_SA(b, h) + aoff + m * 2048 + k * 1024); } while (0)
#define PG8_LDB(dst, b, h) do { _Pragma("unroll") for (int n = 0; n < 2; ++n) _Pragma("unroll") for (int k = 0; k < 2; ++k) dst[n][k] = *(const PG8_LAS bf16x8*)(lds + PG8_SB(b, h) + boff + n * 2048 + k * 1024); } while (0)
#define PG8_MMA(ai, bj, At, Bt) do { __builtin_amdgcn_s_setprio(1); _Pragma("unroll") for (int m = 0; m < 4; ++m) _Pragma("unroll") for (int n = 0; n < 2; ++n) _Pragma("unroll") for (int k = 0; k < 2; ++k) \
        acc[ai][bj][m][n] = __builtin_amdgcn_mfma_f32_16x16x32_bf16(Bt[n][k], At[m][k], acc[ai][bj][m][n], 0, 0, 0); __builtin_amdgcn_s_setprio(0); } while (0)
#define PG8_WAIT_V(n) asm volatile("s_waitcnt vmcnt(" #n ")" ::: "memory")
#define PG8_WAIT_L(n) asm volatile("s_waitcnt lgkmcnt(" #n ")" ::: "memory")
#define PG8_BAR __builtin_amdgcn_s_barrier()
#define PG8_SCHED __builtin_amdgcn_sched_barrier(0)
    Unit cur, nxt; int ui = 0;
    if (!S.next(0, cur)) return;
    f32x4 acc[2][2][4][2];
#pragma unroll
    for (int a = 0; a < 2; ++a)
#pragma unroll
        for (int b = 0; b < 2; ++b)
#pragma unroll
            for (int m = 0; m < 4; ++m)
#pragma unroll
                for (int n = 0; n < 2; ++n) acc[a][b][m][n] = (f32x4){0.f, 0.f, 0.f, 0.f};
    bf16x8 At[4][2], B0[2][2], B1[2][2];
    const char* cA = (const char*)g.A + (size_t)cur.pm * tstepA; const char* cB = (const char*)g.Bt + (size_t)cur.pn * tstep;
    S.a_ready(cur);
    if constexpr (SP2) {
        PG8_STAGE(PG8_SB(0, 0), cB, voffB); PG8_STAGE(PG8_SB(0, 1), cB + hstep, voffB); PG8_STAGE(PG8_SA(0, 0), cA, voffA); PG8_STAGE(PG8_SA(0, 1), cA + hstep, voffA);
        if (wr == 1) PG8_BAR;
        PG8_WAIT_V(2); PG8_BAR;
        PG8_STAGE(PG8_SB(1, 0), cB + kstep, voffB); PG8_STAGE(PG8_SA(1, 0), cA + kstep, voffA); PG8_STAGE(PG8_SB(1, 1), cB + hstep + kstep, voffB);
        PG8_WAIT_V(6); PG8_BAR;
    } else {
        PG8_STAGE(PG8_SB(0, 0), cB, voffB); PG8_STAGE(PG8_SA(0, 0), cA, voffA); PG8_STAGE(PG8_SB(0, 1), cB + hstep, voffB); PG8_STAGE(PG8_SA(0, 1), cA + hstep, voffA);
        if (wr == 1) PG8_BAR;
        PG8_WAIT_V(4); PG8_BAR;
        PG8_STAGE(PG8_SB(1, 0), cB + kstep, voffB); PG8_STAGE(PG8_SA(1, 0), cA + kstep, voffA); PG8_STAGE(PG8_SB(1, 1), cB + hstep + kstep, voffB);
        PG8_WAIT_V(6); PG8_BAR;
    }
    for (;;) {
        const bool has_next = S.next(ui + 1, nxt);
        const char* nA = has_next ? (const char*)g.A + (size_t)nxt.pm * tstepA : cA; const char* nB = has_next ? (const char*)g.Bt + (size_t)nxt.pn * tstep : cB;
        for (int t = 0; t < nt; t += 2) {
            const bool last = (t == nt - 2);
            const char* a1 = cA + (size_t)(t + 1) * kstep;
            const char* a2 = last ? nA : cA + (size_t)(t + 2) * kstep; const char* b2 = last ? nB : cB + (size_t)(t + 2) * kstep;
            const char* a3 = a2 + kstep; const char* b3 = b2 + kstep;
            if (last && has_next) S.a_ready(nxt);
            if constexpr (SP2) {
            PG8_LDB(B0, 0, 0); PG8_LDB(B1, 0, 1); PG8_SCHED; PG8_LDA(At, 0, 0); PG8_STAGE(PG8_SA(1, 1), a1 + hstep, voffA);
            PG8_WAIT_V(8); PG8_WAIT_L(0); PG8_BAR; PG8_MMA(0, 0, At, B0); PG8_MMA(0, 1, At, B1); PG8_BAR; PG8_SCHED;
            PG8_LDA(At, 0, 1); PG8_STAGE(PG8_SB(0, 0), b2, voffB); PG8_STAGE(PG8_SB(0, 1), b2 + hstep, voffB); PG8_STAGE(PG8_SA(0, 0), a2, voffA);
            PG8_WAIT_V(8); PG8_WAIT_L(0); PG8_BAR; PG8_MMA(1, 0, At, B0); PG8_MMA(1, 1, At, B1); PG8_BAR; PG8_SCHED;
            PG8_LDB(B0, 1, 0); PG8_LDB(B1, 1, 1); PG8_SCHED; PG8_LDA(At, 1, 0); PG8_STAGE(PG8_SA(0, 1), a2 + hstep, voffA);
            PG8_WAIT_V(8); PG8_WAIT_L(0); PG8_BAR; PG8_MMA(0, 0, At, B0); PG8_MMA(0, 1, At, B1); PG8_BAR; PG8_SCHED;
            PG8_LDA(At, 1, 1); PG8_STAGE(PG8_SB(1, 0), b3, voffB); PG8_STAGE(PG8_SB(1, 1), b3 + hstep, voffB); PG8_STAGE(PG8_SA(1, 0), a3, voffA);
            PG8_WAIT_V(8); PG8_WAIT_L(0); PG8_BAR; PG8_MMA(1, 0, At, B0); PG8_MMA(1, 1, At, B1); PG8_BAR; PG8_SCHED;
            } else {
            PG8_LDB(B0, 0, 0); PG8_SCHED; PG8_LDA(At, 0, 0); PG8_STAGE(PG8_SA(1, 1), a1 + hstep, voffA);
            PG8_WAIT_L(8); PG8_BAR; PG8_WAIT_L(0); PG8_MMA(0, 0, At, B0); PG8_BAR; PG8_SCHED;
            PG8_LDB(B1, 0, 1); PG8_STAGE(PG8_SB(0, 0), b2, voffB);
            PG8_BAR; PG8_WAIT_L(0); PG8_MMA(0, 1, At, B1); PG8_BAR;
            PG8_LDA(At, 0, 1); PG8_STAGE(PG8_SA(0, 0), a2, voffA);
            PG8_BAR; PG8_WAIT_L(0); PG8_MMA(1, 0, At, B0); PG8_BAR; PG8_SCHED;
            PG8_STAGE(PG8_SB(0, 1), b2 + hstep, voffB);
            PG8_WAIT_V(6); PG8_BAR; PG8_MMA(1, 1, At, B1); PG8_BAR;
            PG8_LDB(B0, 1, 0); PG8_SCHED; PG8_LDA(At, 1, 0); PG8_STAGE(PG8_SA(0, 1), a2 + hstep, voffA);
            PG8_WAIT_L(8); PG8_BAR; PG8_WAIT_L(0); PG8_MMA(0, 0, At, B0); PG8_BAR; PG8_SCHED;
            PG8_LDB(B1, 1, 1); PG8_STAGE(PG8_SB(1, 0), b3, voffB);
            PG8_BAR; PG8_WAIT_L(0); PG8_MMA(0, 1, At, B1); PG8_BAR;
            PG8_LDA(At, 1, 1); PG8_STAGE(PG8_SA(1, 0), a3, voffA);
            PG8_BAR; PG8_WAIT_L(0); PG8_MMA(1, 0, At, B0); PG8_BAR; PG8_SCHED;
            PG8_STAGE(PG8_SB(1, 1), b3 + hstep, voffB);
            PG8_WAIT_V(6); PG8_BAR; PG8_MMA(1, 1, At, B1); PG8_BAR;
            }
        }
        if constexpr (ALIGN_EPI) { if (wr == 0) PG8_BAR; }
        if constexpr (!Epi::AFTER_DRAIN) { E(acc, cur, wr, wc, fr, fq); S.done(cur); }
        if (!has_next) break;
#pragma unroll
        for (int a = 0; a < 2; ++a)
#pragma unroll
            for (int b = 0; b < 2; ++b)
#pragma unroll
                for (int m = 0; m < 4; ++m)
#pragma unroll
                    for (int n = 0; n < 2; ++n) acc[a][b][m][n] = (f32x4){0.f, 0.f, 0.f, 0.f};
        cur = nxt; cA = nA; cB = nB; ++ui;
        if constexpr (ALIGN_EPI) { if (wr == 1) PG8_BAR; }
    }
    PG8_WAIT_V(0);
    if constexpr (!ALIGN_EPI) { if (wr == 0) PG8_BAR; }
    PG8_BAR;
    if constexpr (Epi::AFTER_DRAIN) { E.fused(acc, cur, wr, wc, fr, fq, lds, wid, lane); S.done(cur); }
#undef PG8_SA
#undef PG8_SB
#undef PG8_STAGE
#undef PG8_LDA
#undef PG8_LDB
#undef PG8_MMA
#undef PG8_WAIT_V
#undef PG8_WAIT_L
#undef PG8_BAR
#undef PG8_SCHED
}
}
namespace att {
constexpr int LD = INW, KVBLK = 64;
constexpr size_t SHM_V = KVBLK * 128 * 2, SHM_K = KVBLK * 128 * 2;
constexpr float THR2 = 8.f * L2E;
#define KSWZ(row, colB) ((row) * 256 + ((colB) ^ (((row) & 7) << 4)))
#define SBAR() __builtin_amdgcn_sched_barrier(0)
__device__ __forceinline__ int crow(int r, int hi) { return (r & 3) + 8 * (r >> 2) + 4 * hi; }
__device__ __forceinline__ void partialSM(f32x16& p0, f32x16& p1, float& m_reg, float& mn, float& alpha, float dqs, float sl2) {
  constexpr float C = 0.125f * L2E;
#pragma unroll
  for (int r = 0; r < 16; ++r) { const float k0 = (float)((r & 3) + 8 * (r >> 2));
    p0[r] = fmaf(p0[r], C, -fabsf(fmaf(sl2, -k0, dqs))); p1[r] = fmaf(p1[r], C, -fabsf(fmaf(sl2, -(k0 + 32.f), dqs))); }
  float pmax = p0[0];
#pragma unroll
  for (int r = 1; r < 16; ++r) pmax = fmaxf(pmax, p0[r]);
#pragma unroll
  for (int r = 0; r < 16; ++r) pmax = fmaxf(pmax, p1[r]);
  { auto rr = __builtin_amdgcn_permlane32_swap(__float_as_uint(pmax), __float_as_uint(pmax), false, false);
    pmax = fmaxf(__uint_as_float(rr[0]), __uint_as_float(rr[1])); }
  if (__builtin_expect(__all(pmax - m_reg <= THR2), 1)) { mn = m_reg; alpha = 1.f; }
  else { mn = fmaxf(m_reg, pmax); alpha = __builtin_amdgcn_exp2f(m_reg - mn); m_reg = mn; }
#pragma unroll
  for (int r = 0; r < 16; ++r) { p0[r] -= mn; p1[r] -= mn; }
#pragma unroll
  for (int r = 0; r < 16; ++r) p0[r] = __builtin_amdgcn_exp2f(p0[r]);
}
__device__ __forceinline__ void partialSM1(f32x16& p0, f32x16& p1, float& m_reg, float& mn, float& alpha, float dqs, float sl2, int side) {
  constexpr float C = 0.125f * L2E;
  const float sg = side > 0 ? -sl2 : sl2, D0 = side > 0 ? (m_reg + dqs) : (m_reg - dqs);
  const f32x2 sg2 = {sg, sg}, C2 = {C, C}, Da = {D0, D0}, Db = {fmaf(sg, 32.f, D0), fmaf(sg, 32.f, D0)};
#pragma unroll
  for (int r = 0; r < 16; r += 2) {
    const f32x2 kk = {(float)((r & 3) + 8 * (r >> 2)), (float)(((r + 1) & 3) + 8 * ((r + 1) >> 2))};
    const f32x2 b0 = __builtin_elementwise_fma(sg2, kk, Da), b1 = __builtin_elementwise_fma(sg2, kk, Db);
    const f32x2 x0 = __builtin_elementwise_fma((f32x2){p0[r], p0[r + 1]}, C2, -b0), x1 = __builtin_elementwise_fma((f32x2){p1[r], p1[r + 1]}, C2, -b1);
    p0[r] = x0[0]; p0[r + 1] = x0[1]; p1[r] = x1[0]; p1[r + 1] = x1[1]; }
  float pmax = p0[0];
#pragma unroll
  for (int r = 1; r < 16; ++r) pmax = fmaxf(pmax, p0[r]);
#pragma unroll
  for (int r = 0; r < 16; ++r) pmax = fmaxf(pmax, p1[r]);
  { auto rr = __builtin_amdgcn_permlane32_swap(__float_as_uint(pmax), __float_as_uint(pmax), false, false);
    pmax = fmaxf(__uint_as_float(rr[0]), __uint_as_float(rr[1])); }
  if (__builtin_expect(__all(pmax <= THR2), 1)) { mn = m_reg; alpha = 1.f; }
  else { const float pm = fmaxf(pmax, 0.f); mn = m_reg + pm; alpha = __builtin_amdgcn_exp2f(-pm); m_reg = mn;
#pragma unroll
    for (int r = 0; r < 16; ++r) { p0[r] -= pm; p1[r] -= pm; } }
#pragma unroll
  for (int r = 0; r < 16; ++r) p0[r] = __builtin_amdgcn_exp2f(p0[r]);
}
__device__ __forceinline__ void finishSM(f32x16& p0, f32x16& p1, float alpha, float& l_reg, bf16x8& pa0, bf16x8& pa1, bf16x8& pa2, bf16x8& pa3) {
#pragma unroll
  for (int r = 0; r < 16; ++r) p1[r] = __builtin_amdgcn_exp2f(p1[r]);
  f32x2 ps2 = {0.f, 0.f};
#pragma unroll
  for (int r = 0; r < 16; r += 2) ps2 += (f32x2){p0[r], p0[r + 1]};
#pragma unroll
  for (int r = 0; r < 16; r += 2) ps2 += (f32x2){p1[r], p1[r + 1]};
  float ps = ps2[0] + ps2[1];
  { auto rr = __builtin_amdgcn_permlane32_swap(__float_as_uint(ps), __float_as_uint(ps), false, false);
    ps = __uint_as_float(rr[0]) + __uint_as_float(rr[1]); }
  l_reg = l_reg * alpha + ps;
#define PK4(P, BASE, OUT) do { unsigned a0 = cvtpk(P[BASE + 0], P[BASE + 1]), a1 = cvtpk(P[BASE + 2], P[BASE + 3]);   \
    unsigned b0 = cvtpk(P[BASE + 4], P[BASE + 5]), b1 = cvtpk(P[BASE + 6], P[BASE + 7]);                              \
    auto r0 = __builtin_amdgcn_permlane32_swap(a0, b0, false, false); auto r1 = __builtin_amdgcn_permlane32_swap(a1, b1, false, false); \
    u32x4 w = {r0[0], r1[0], r0[1], r1[1]}; OUT = __builtin_bit_cast(bf16x8, w); } while (0)
  PK4(p0, 0, pa0); PK4(p0, 8, pa1); PK4(p1, 0, pa2); PK4(p1, 8, pa3);
#undef PK4
}
__device__ __forceinline__ void qkt(f32x16& p0, f32x16& p1, const char* Ks, const bf16x8* qr, int r32, int hi, int c) {
  p0 = f32x16{}; p1 = f32x16{};
#pragma unroll
  for (int d0 = 0; d0 < 4; ++d0) { const int cb = (c * 64 + d0 * 16 + hi * 8) * 2;
    bf16x8 b0 = *reinterpret_cast<const bf16x8*>(Ks + KSWZ(r32, cb));
    bf16x8 b1 = *reinterpret_cast<const bf16x8*>(Ks + KSWZ(32 + r32, cb));
    p0 = __builtin_amdgcn_mfma_f32_32x32x16_bf16(b0, qr[d0], p0, 0, 0, 0);
    p1 = __builtin_amdgcn_mfma_f32_32x32x16_bf16(b1, qr[d0], p1, 0, 0, 0); }
}
__device__ __forceinline__ int v_st(int k, int c) { const int kk = (k & ~0xC) | ((k & 4) << 1) | ((k & 8) >> 1); return ((kk >> 3) * 4 + (c >> 5)) * 512 + ((kk & 7) * 32 + (c & 31)) * 2; }
__device__ __forceinline__ int v_rd_base(int lane) { return ((lane & 3) << 3) | (((lane >> 2) & 3) << 6) | (((lane >> 4) & 1) << 5) | (((lane >> 5) & 1) << 8); }
constexpr int v_rd_off(int d0, int ks, int half) { return d0 * 512 + ks * 4096 + half * 2048; }
template <int OFF> __device__ __forceinline__ s16x4 tr_read(int vb) {
  s16x4 r; asm volatile("ds_read_b64_tr_b16 %0, %1 offset:%2" : "=&v"(r) : "v"(vb), "i"(OFF) : "memory"); return r;
}
template <int D0> __device__ __forceinline__ void pv_one(f32x16& od, int vb, bf16x8 pa0, bf16x8 pa1, bf16x8 pa2, bf16x8 pa3) {
  const s16x4 l0 = tr_read<v_rd_off(D0, 0, 0)>(vb), h0 = tr_read<v_rd_off(D0, 0, 1)>(vb), l1 = tr_read<v_rd_off(D0, 1, 0)>(vb), h1 = tr_read<v_rd_off(D0, 1, 1)>(vb);
  const s16x4 l2 = tr_read<v_rd_off(D0, 2, 0)>(vb), h2 = tr_read<v_rd_off(D0, 2, 1)>(vb), l3 = tr_read<v_rd_off(D0, 3, 0)>(vb), h3 = tr_read<v_rd_off(D0, 3, 1)>(vb);
  asm volatile("s_waitcnt lgkmcnt(0)" ::: "memory"); SBAR();
#define PK(L, H) (bf16x8){L[0], L[1], L[2], L[3], H[0], H[1], H[2], H[3]}
  od = __builtin_amdgcn_mfma_f32_32x32x16_bf16(pa0, PK(l0, h0), od, 0, 0, 0);
  od = __builtin_amdgcn_mfma_f32_32x32x16_bf16(pa1, PK(l1, h1), od, 0, 0, 0);
  od = __builtin_amdgcn_mfma_f32_32x32x16_bf16(pa2, PK(l2, h2), od, 0, 0, 0);
  od = __builtin_amdgcn_mfma_f32_32x32x16_bf16(pa3, PK(l3, h3), od, 0, 0, 0);
#undef PK
}
__device__ __forceinline__ void pv_d0(f32x16* o, int vb, bf16x8 pa0, bf16x8 pa1, bf16x8 pa2, bf16x8 pa3) {
  pv_one<0>(o[0], vb, pa0, pa1, pa2, pa3); pv_one<1>(o[1], vb, pa0, pa1, pa2, pa3); pv_one<2>(o[2], vb, pa0, pa1, pa2, pa3); pv_one<3>(o[3], vb, pa0, pa1, pa2, pa3);
}
__device__ __forceinline__ void pv_sm1(f32x16* o, int vb, bf16x8 pa0, bf16x8 pa1, bf16x8 pa2, bf16x8 pa3, f32x16& p0, f32x16& p1, float& m_reg, float& mn, float& alpha, float dqs, float sl2, int side) {
  constexpr float C = 0.125f * L2E;
  const float sg = side > 0 ? -sl2 : sl2, D0 = side > 0 ? (m_reg + dqs) : (m_reg - dqs);
  const f32x2 sg2 = {sg, sg}, C2 = {C, C}, Da = {D0, D0}, Db = {fmaf(sg, 32.f, D0), fmaf(sg, 32.f, D0)};
  pv_one<0>(o[0], vb, pa0, pa1, pa2, pa3);
#pragma unroll
  for (int r = 0; r < 16; r += 2) { const f32x2 kk = {(float)((r & 3) + 8 * (r >> 2)), (float)(((r + 1) & 3) + 8 * ((r + 1) >> 2))};
    const f32x2 x0 = __builtin_elementwise_fma((f32x2){p0[r], p0[r + 1]}, C2, -__builtin_elementwise_fma(sg2, kk, Da)); p0[r] = x0[0]; p0[r + 1] = x0[1]; }
  pv_one<1>(o[1], vb, pa0, pa1, pa2, pa3);
#pragma unroll
  for (int r = 0; r < 16; r += 2) { const f32x2 kk = {(float)((r & 3) + 8 * (r >> 2)), (float)(((r + 1) & 3) + 8 * ((r + 1) >> 2))};
    const f32x2 x1 = __builtin_elementwise_fma((f32x2){p1[r], p1[r + 1]}, C2, -__builtin_elementwise_fma(sg2, kk, Db)); p1[r] = x1[0]; p1[r + 1] = x1[1]; }
  pv_one<2>(o[2], vb, pa0, pa1, pa2, pa3);
  float pmax = p0[0];
#pragma unroll
  for (int r = 1; r < 16; ++r) pmax = fmaxf(pmax, p0[r]);
#pragma unroll
  for (int r = 0; r < 16; ++r) pmax = fmaxf(pmax, p1[r]);
  { auto rr = __builtin_amdgcn_permlane32_swap(__float_as_uint(pmax), __float_as_uint(pmax), false, false);
    pmax = fmaxf(__uint_as_float(rr[0]), __uint_as_float(rr[1])); }
  if (__builtin_expect(__all(pmax <= THR2), 1)) { mn = m_reg; alpha = 1.f; }
  else { const float pm = fmaxf(pmax, 0.f); mn = m_reg + pm; alpha = __builtin_amdgcn_exp2f(-pm); m_reg = mn;
#pragma unroll
    for (int r = 0; r < 16; ++r) { p0[r] -= pm; p1[r] -= pm; } }
  pv_one<3>(o[3], vb, pa0, pa1, pa2, pa3);
#pragma unroll
  for (int r = 0; r < 16; ++r) p0[r] = __builtin_amdgcn_exp2f(p0[r]);
}
constexpr int XS = 132;

__device__ __forceinline__ void attn_unit(int unit, const bf16_t* __restrict__ proj, bf16_t* __restrict__ mix, const float* __restrict__ subln_g, float lam, char* lds) {
  const int b = unit >> 6, h = (unit >> 4) & 3, qb = unit & 15;
  int tid_l = threadIdx.x; asm volatile("" : "+v"(tid_l));
  const int tid = tid_l, wid = tid >> 6, lane = tid & 63, r32 = lane & 31, hi = lane >> 5, c = wid >> 2, wq = wid & 3;
  const int q0 = qb * 128;
  const bf16_t* Qb = proj + (size_t)(b * SEQ + q0) * LD + h * 128 + c * 64;
  const bf16_t* Kh = proj + (size_t)(b * SEQ) * LD + 512 + h * 128;
  const bf16_t* Vh = proj + (size_t)(b * SEQ) * LD + 1024 + h * 128;
  char* V_lds = lds; char* K_lds = lds + 3 * SHM_V;
  float* ws = (float*)(lds + 3 * SHM_V + 3 * SHM_K) + wid * 64; float* li_l = ws; float* al_l = ws + 32;
  float m_reg = -1e30f, l_reg = 0; f32x16 o[4] = {}; bf16x8 qr[4];
  const bf16_t* Qw = Qb + (size_t)(wq * 32 + r32) * LD + hi * 8;
#pragma unroll
  for (int d0 = 0; d0 < 4; ++d0) qr[d0] = *reinterpret_cast<const bf16x8*>(Qw + d0 * 16);
  const float sl2 = __builtin_amdgcn_exp2f(-2.f * (float)(h + 1)) * L2E;
  float dqs = sl2 * (float)(q0 + wq * 32 + r32 - 4 * hi);
  const int sr = tid >> 4, sc = (tid & 15) * 8, vst0 = v_st(sr, sc), vst1 = v_st(32 + sr, sc);
  const int vb0 = (int)(uintptr_t)V_lds + v_rd_base(lane);
  struct { bf16x8 vs0, vs1, ks0, ks1; } sr_[1];
#define SLOAD(i, k0) do { sr_[i].vs0 = *(const bf16x8*)(&Vh[(size_t)((k0) + sr) * LD + sc]); sr_[i].vs1 = *(const bf16x8*)(&Vh[(size_t)((k0) + 32 + sr) * LD + sc]); \
    sr_[i].ks0 = *(const bf16x8*)(&Kh[(size_t)((k0) + sr) * LD + sc]); sr_[i].ks1 = *(const bf16x8*)(&Kh[(size_t)((k0) + 32 + sr) * LD + sc]); } while (0)
#define SWRITE(bb, i) do { *(bf16x8*)(V_lds + (bb) * SHM_V + vst0) = sr_[i].vs0;          \
    *(bf16x8*)(V_lds + (bb) * SHM_V + vst1) = sr_[i].vs1; int kc = sc * 2;               \
    *(bf16x8*)(K_lds + (bb) * SHM_K + KSWZ(sr, kc)) = sr_[i].ks0;                       \
    *(bf16x8*)(K_lds + (bb) * SHM_K + KSWZ(32 + sr, kc)) = sr_[i].ks1; } while (0)
#define SWAIT() asm volatile("s_waitcnt vmcnt(0)" ::: "memory")
#define RESC(a) do { if (__any((a) < 1.f)) { if (hi == 0) al_l[r32] = (a); asm volatile("s_waitcnt lgkmcnt(0)" ::: "memory"); \
    _Pragma("unroll") for (int d = 0; d < 4; ++d) _Pragma("unroll") for (int r = 0; r < 16; ++r) o[d][r] *= al_l[crow(r, hi)]; } } while (0)
  f32x16 pA0, pA1, pB0, pB1; float mnA, mnB, alA, alB; bf16x8 pa0, pa1, pa2, pa3; constexpr int NT = SEQ / KVBLK;
  const int jd = 2 * qb; const float dq0 = dqs;
#define TK(j) ((((j) + jd) & (NT - 1)) * KVBLK)
#define DQS(j) fmaf(-sl2, (float)TK(j), dq0)
  SLOAD(0, TK(0)); asm volatile("s_waitcnt vmcnt(0)" ::: "memory"); SWRITE(0, 0);
  SLOAD(0, TK(1)); asm volatile("s_waitcnt vmcnt(0)" ::: "memory"); SWRITE(1, 0); __syncthreads();
  qkt(pA0, pA1, K_lds, qr, r32, hi, c); partialSM(pA0, pA1, m_reg, mnA, alA, DQS(0), sl2);
  const int qw0 = q0 + wq * 32;
  int cb = 0;
#define ATT_STEP(PC0, PC1, ALC, PN0, PN1, MNN, ALN, J) do { const int nb_ = (cb == 2) ? 0 : cb + 1, wb_ = (nb_ == 2) ? 0 : nb_ + 1; \
    SBAR(); qkt(PN0, PN1, K_lds + nb_ * SHM_K, qr, r32, hi, c); \
    finishSM(PC0, PC1, ALC, l_reg, pa0, pa1, pa2, pa3); SBAR(); \
    if ((J) + 2 < NT) SLOAD(0, TK((J) + 2)); SBAR(); \
    { const int kn_ = TK((J) + 1); const float dqs = DQS((J) + 1); const int side_ = (kn_ + KVBLK - 1 < qw0) ? 1 : ((kn_ > qw0 + 31) ? -1 : 0); \
      if (side_ != 0) pv_sm1(o, vb0 + cb * (int)SHM_V, pa0, pa1, pa2, pa3, PN0, PN1, m_reg, MNN, ALN, dqs, sl2, side_); \
      else { pv_d0(o, vb0 + cb * (int)SHM_V, pa0, pa1, pa2, pa3); partialSM(PN0, PN1, m_reg, MNN, ALN, dqs, sl2); } } \
    if ((J) + 2 < NT) { SWAIT(); SWRITE(wb_, 0); } \
    RESC(ALN); __syncthreads(); cb = nb_; } while (0)
  for (int j = 0; j + 2 < NT; j += 2) {
    ATT_STEP(pA0, pA1, alA, pB0, pB1, mnB, alB, j);
    ATT_STEP(pB0, pB1, alB, pA0, pA1, mnA, alA, j + 1);
  }
  ATT_STEP(pA0, pA1, alA, pB0, pB1, mnB, alB, NT - 2);
  finishSM(pB0, pB1, alB, l_reg, pa0, pa1, pa2, pa3); SBAR();
  pv_d0(o, vb0 + cb * (int)SHM_V, pa0, pa1, pa2, pa3);
#undef ATT_STEP
#undef TK
#undef DQS
  if (hi == 0) li_l[r32] = l_reg; asm volatile("s_waitcnt lgkmcnt(0)" ::: "memory");
  float rli[16];
#pragma unroll
  for (int r = 0; r < 16; ++r) rli[r] = __builtin_amdgcn_rcpf(li_l[crow(r, hi)]);
  asm volatile("s_waitcnt vmcnt(0)" ::: "memory");
  __syncthreads();
  float* X = (float*)lds + c * (128 * XS);
#pragma unroll
  for (int r = 0; r < 16; ++r) { const int orow = wq * 32 + crow(r, hi);
#pragma unroll
    for (int d0 = 0; d0 < 4; ++d0) X[orow * XS + d0 * 32 + r32] = o[d0][r] * rli[r]; }
  __syncthreads();
  { const int row = tid >> 2, q = tid & 3; const float* X1 = (const float*)lds + row * XS + q * 32; const float* X2 = X1 + 128 * XS;
    f32x4 v[8]; float ss = 0.f;
#pragma unroll
    for (int i = 0; i < 8; ++i) { const int ii = (i + 4 * (q >> 1)) & 7; const f32x4 a = *(const f32x4*)(X1 + 4 * ii), bb = *(const f32x4*)(X2 + 4 * ii);
      v[i] = a - lam * bb; ss += (v[i][0] * v[i][0] + v[i][1] * v[i][1]) + (v[i][2] * v[i][2] + v[i][3] * v[i][3]); }
    ss += __shfl_xor(ss, 1); ss += __shfl_xor(ss, 2);
    const float rn = __builtin_amdgcn_rsqf(ss * (1.f / 128.f) + EPS) * 0.8f * EXP_ATTSCALE;
    bf16_t* orow = mix + (size_t)(b * SEQ + q0 + row) * DM + h * 128 + q * 32;
#pragma unroll
    for (int i = 0; i < 8; i += 2) { const int i0 = (i + 4 * (q >> 1)) & 7;
      const f32x4 g0 = *(const f32x4*)(subln_g + q * 32 + 4 * i0), g1 = *(const f32x4*)(subln_g + q * 32 + 4 * i0 + 4);
      const f32x4 a = v[i] * rn * g0, bb = v[i + 1] * rn * g1;
      u32x4 w = {cvtpk(a[0], a[1]), cvtpk(a[2], a[3]), cvtpk(bb[0], bb[1]), cvtpk(bb[2], bb[3])};
      *(u32x4*)(orow + 4 * i0) = w; } }
  __syncthreads();
#undef SLOAD
#undef SWRITE
#undef SWAIT
#undef RESC
}
}
namespace lru {
__device__ __forceinline__ int crow(int r, int hi) { return (r & 3) + 8 * (r >> 2) + 4 * hi; }
__device__ __forceinline__ f32x8 lds_ld8(const LAS float* p) { const f32x4 a = *(const LAS f32x4*)p, b = *(const LAS f32x4*)(p + 4); return (f32x8){a[0], a[1], a[2], a[3], b[0], b[1], b[2], b[3]}; }
__device__ __forceinline__ void lds_st8(LAS float* p, f32x8 v) { *(LAS f32x4*)p = (f32x4){v[0], v[1], v[2], v[3]}; *(LAS f32x4*)(p + 4) = (f32x4){v[4], v[5], v[6], v[7]}; }
struct Params { const bf16_t* proj; float* ys; bf16_t* mix; unsigned* pair_cnt; const float *conv_w, *conv_b, *w_a, *b_a, *w_x, *b_x, *lambda; };
__device__ __forceinline__ void lru_item(int item, const Params& p, LAS unsigned char* lds) {
  int tid_l = threadIdx.x; asm volatile("" : "+v"(tid_l));
  const int tid = tid_l, wid = __builtin_amdgcn_readfirstlane(tid >> 6), lane = tid & 63, r32 = lane & 31, hi = lane >> 5;
  const int dir = item & 1, seg = wid, b = item >> 4, n = (item >> 1) & 7;
  LAS float* xcu = (LAS float*)(lds + wid * 16896);
  LAS float* abuf = (LAS float*)(lds + wid * 16896 + 8704);
  LAS float* tot = (LAS float*)(lds + LDS_TOT);
  LAS float* cwl = (LAS float*)(lds + LDS_CW);
  if (tid < 320) { const int k = tid >> 6, ch = tid & 63; cwl[tid] = (k < 4) ? p.conv_w[k * 512 + 64 * n + ch] : p.conv_b[64 * n + ch]; }
  bf16x8 Bf[2][2][4];
#pragma unroll
  for (int g = 0; g < 2; ++g) { const float* W = (g == 0 ? p.w_a : p.w_x) + (size_t)((dir * 8 + n) * 64) * 64;
#pragma unroll
    for (int nb = 0; nb < 2; ++nb)
#pragma unroll
      for (int s = 0; s < 4; ++s) { f32x8 w;
#pragma unroll
        for (int j = 0; j < 8; ++j) w[j] = W[(16 * s + 8 * hi + j) * 64 + 32 * nb + r32];
        Bf[g][nb][s] = pack8(w); } }
  float ba[2], bx[2], cl2[2];
#pragma unroll
  for (int nb = 0; nb < 2; ++nb) { const int ch = dir * 512 + 64 * n + 32 * nb + r32; ba[nb] = p.b_a[ch]; bx[nb] = p.b_x[ch];
    const float lam = p.lambda[ch]; const float sp = (lam > 15.f) ? __expf(-lam) : log1pf(__expf(-lam));
    cl2[nb] = 8.f * sp * L2E; }
  float hc = 0.f;
  __syncthreads();
  const bf16_t* xr_base = p.proj + (size_t)(b * SEQ) * INW + 1536 + 64 * n;
  float* ybase = p.ys + (size_t)dir * T_ * 512 + (size_t)(b * SEQ) * 512 + 64 * n;
  u32x4 pre[5];
#define LRU_LOAD_RAW(T0) do { _Pragma("unroll") for (int i = 0; i < 5; ++i) { const int row = i * 8 + (lane >> 3), tt = (T0) - 2 + row; pre[i] = (u32x4){0u, 0u, 0u, 0u}; \
      if (row < 35 && tt >= 0 && tt < SEQ) pre[i] = *(const u32x4*)(xr_base + (size_t)tt * INW + (lane & 7) * 8); } } while (0)
  LRU_LOAD_RAW((dir ? 7 : 0) * 256 + seg * 32);
  for (int it = 0; it < 8; ++it) {
    const int tile = dir ? 7 - it : it, t0 = tile * 256 + seg * 32;
    { LAS unsigned char* raw = (LAS unsigned char*)abuf;
#pragma unroll
      for (int i = 0; i < 5; ++i) { const int row = i * 8 + (lane >> 3); if (row < 35) *(LAS u32x4*)(raw + row * 144 + (lane & 7) * 16) = pre[i]; }
      if (it < 7) LRU_LOAD_RAW((dir ? 6 - it : it + 1) * 256 + seg * 32);
#pragma unroll
      for (int cc = 0; cc < 4; ++cc) { const int ch0 = 32 * hi + 8 * cc;
        f32x8 acc = lds_ld8(cwl + 4 * 64 + ch0);
#pragma unroll
        for (int k = 0; k < 4; ++k) { const bf16x8 v = *(LAS const bf16x8*)(raw + (r32 + k) * 144 + ch0 * 2); const f32x8 w = lds_ld8(cwl + k * 64 + ch0);
#pragma unroll
          for (int j = 0; j < 8; ++j) acc[j] += w[j] * bf2f(v[j]); }
        lds_st8(xcu + r32 * 68 + ch0, acc); } }
    bf16x8 af[4];
#pragma unroll
    for (int s = 0; s < 4; ++s) af[s] = pack8(lds_ld8(xcu + r32 * 68 + 16 * s + 8 * hi));
#pragma unroll
    for (int nb = 0; nb < 2; ++nb) {
      f32x16 acca = {}, accx = {};
#pragma unroll
      for (int s = 0; s < 4; ++s) { acca = __builtin_amdgcn_mfma_f32_32x32x16_bf16(af[s], Bf[0][nb][s], acca, 0, 0, 0); accx = __builtin_amdgcn_mfma_f32_32x32x16_bf16(af[s], Bf[1][nb][s], accx, 0, 0, 0); }
#pragma unroll
      for (int rg = 0; rg < 16; ++rg) { const int tk = crow(rg, hi), ch = 32 * nb + r32;
        const float xc = xcu[tk * 68 + ch];
        const float ga = acca[rg] + ba[nb], gx = accx[rg] + bx[nb];
        const float r = __builtin_amdgcn_rcpf(1.f + __builtin_amdgcn_exp2f(-ga * L2E)), ii = __builtin_amdgcn_rcpf(1.f + __builtin_amdgcn_exp2f(-gx * L2E));
        const float a = __builtin_amdgcn_exp2f(-cl2[nb] * r);
        const float u = __builtin_amdgcn_sqrtf(fmaxf(fmaf(-a, a, 1.f), 0.f)) * ii * xc;
        abuf[tk * 64 + ch] = a; xcu[tk * 68 + ch] = u; }
    }
    { float P = 1.f, H = 0.f;
#pragma unroll
      for (int hb = 0; hb < 2; ++hb) { float av[16], uv[16];
#pragma unroll
        for (int j = 0; j < 16; ++j) { const int tk = dir ? 31 - (16 * hb + j) : 16 * hb + j; av[j] = abuf[tk * 64 + lane]; uv[j] = xcu[tk * 68 + lane]; }
#pragma unroll
        for (int j = 0; j < 16; ++j) { const int tk = dir ? 31 - (16 * hb + j) : 16 * hb + j; H = av[j] * H + uv[j]; P *= av[j]; abuf[tk * 64 + lane] = P; xcu[tk * 68 + lane] = H; } }
      LAS float* tt = tot + (((it & 1) * 8 + seg) * 128);
      tt[lane] = P; tt[64 + lane] = H; }
    __syncthreads();
    float cin = hc;
    { float c = hc;
#pragma unroll
      for (int j = 0; j < 8; ++j) { const int sg = dir ? 7 - j : j; const LAS float* tt = tot + (((it & 1) * 8 + sg) * 128);
        const float Pj = tt[lane], Hj = tt[64 + lane]; if (sg == seg) cin = c; c = Pj * c + Hj; }
      hc = c; }
#pragma unroll 8
    for (int tk = 0; tk < 32; ++tk) __hip_atomic_store(ybase + (size_t)(t0 + tk) * 512 + lane, xcu[tk * 68 + lane] + abuf[tk * 64 + lane] * cin, __ATOMIC_RELAXED, __HIP_MEMORY_SCOPE_AGENT);
  }
  asm volatile("s_waitcnt vmcnt(0)" ::: "memory"); __syncthreads();
  volatile LAS unsigned* misc = (volatile LAS unsigned*)(lds + LDS_MISC);
  if (tid == 0) misc[1] = __hip_atomic_fetch_add(p.pair_cnt + (b * 8 + n), 1u, __ATOMIC_RELAXED, __HIP_MEMORY_SCOPE_AGENT);
  __syncthreads();
  const unsigned arrived = misc[1];
  if (arrived == 1u) {
    __builtin_amdgcn_fence(__ATOMIC_ACQUIRE, "agent");
    const float* yf = p.ys + (size_t)(b * SEQ) * 512 + 64 * n; const float* yb = yf + (size_t)T_ * 512;
    const bf16_t* gr = p.proj + (size_t)(b * SEQ) * INW + 2048 + 64 * n; bf16_t* mo = p.mix + (size_t)(b * SEQ) * DM + 512 + 64 * n;
#pragma unroll 8
    for (int idx = tid; idx < SEQ * 8; idx += 512) { const int t = idx >> 3, c8 = (idx & 7) * 8;
      const f32x8 a = *(const f32x8*)(yf + (size_t)t * 512 + c8), bb = *(const f32x8*)(yb + (size_t)t * 512 + c8); const bf16x8 g = *(const bf16x8*)(gr + (size_t)t * INW + c8);
      f32x8 o;
#pragma unroll
      for (int j = 0; j < 8; ++j) o[j] = gelu_tanh(bf2f(g[j])) * (a[j] + bb[j]) * EXP_LRUSCALE;
      *(bf16x8*)(mo + (size_t)t * DM + c8) = pack8(o); } }
  __syncthreads();
}
#undef LRU_LOAD_RAW
}
template <bool UPMAP>
__device__ __forceinline__ void p0_transpose_item(const float* __restrict__ W, int K, int N, bf16_t* WT, const float* __restrict__ kscale, LAS float* scr, int item, int lane) {
    const int nblk = N / 32, kb = item / nblk, nb = item % nblk, k0 = 64 * kb, n0 = 32 * nb;
#pragma unroll
    for (int i = 0; i < 32; ++i) { const int kk = 2 * i + (lane >> 5); float w = W[(size_t)(k0 + kk) * N + n0 + (lane & 31)]; if (kscale) w *= kscale[k0 + kk]; scr[kk * 33 + (lane & 31)] = w; }
    asm volatile("s_waitcnt lgkmcnt(0)" ::: "memory");
    const int c = lane & 7;
#pragma unroll
    for (int j = 0; j < 4; ++j) { const int n = (lane >> 3) + 8 * j; const LAS float* s = scr + (8 * c) * 33 + n;
        u32x4 o; o.x = cvtpk(s[0 * 33], s[1 * 33]); o.y = cvtpk(s[2 * 33], s[3 * 33]); o.z = cvtpk(s[4 * 33], s[5 * 33]); o.w = cvtpk(s[6 * 33], s[7 * 33]);
        int row = n0 + n;
        if (UPMAP) { const int f = row < FF ? row : row - FF; row = (f >> 7) * 256 + (row < FF ? 0 : 128) + (f & 127); }
        *(u32x4*)(WT + (size_t)row * K + k0 + 8 * c) = o; }
    asm volatile("s_waitcnt lgkmcnt(0)" ::: "memory");
}

#define XB_TMO      128
#define XB_XCNT(j)  (256  + 64 * (j))
#define XB_XSUB(j)  (1280 + 64 * (j))
#define XB_XGEN(j)  (2304 + 64 * (j))
#define XB_TOP      3328
#define XB_TOPGEN   3392
#define XCD_BAR_WORDS 3456
#define XB_SPIN_CAP (1u << 18)

__device__ __forceinline__ unsigned xb_ld(unsigned* p)              { return __hip_atomic_load(p, __ATOMIC_RELAXED, __HIP_MEMORY_SCOPE_AGENT); }
__device__ __forceinline__ unsigned xb_add(unsigned* p, unsigned v) { return __hip_atomic_fetch_add(p, v, __ATOMIC_RELAXED, __HIP_MEMORY_SCOPE_AGENT); }
__device__ __forceinline__ unsigned xb_xcc_id() { return (unsigned)__builtin_amdgcn_s_getreg((3 << 11) | 20) & 0xFu; }
#define XB_SPIN(cond, bar) do { unsigned _sp = 0; while (cond) { __builtin_amdgcn_s_sleep(1); \
    if ((++_sp & 255u) == 0u) { if (xb_ld(&(bar)[XB_TMO])) break; if (_sp > XB_SPIN_CAP) { atomicAdd(&(bar)[XB_TMO], 1u); break; } } } } while (0)

struct XcdBarrier {
    unsigned* bar; unsigned x;
    volatile LAS unsigned* st;
};

__device__ __forceinline__ XcdBarrier xcd_barrier_post(unsigned* bar, volatile LAS unsigned* st) {
    XcdBarrier b; b.bar = bar; b.x = xb_xcc_id(); b.st = st;
    if (threadIdx.x == 0) (void)xb_add(&bar[XB_XCNT(b.x)], 1u);
    return b;
}
__device__ __forceinline__ void xcd_barrier_complete(unsigned* bar, unsigned x, unsigned& nloc, unsigned& nx) {
    const unsigned G = gridDim.x * gridDim.y * gridDim.z;
    unsigned sum, cnt, mine, sp = 0u;
    for (;;) {
        sum = 0u; cnt = 0u; mine = 0u;
#pragma unroll
        for (unsigned j = 0; j < 16; ++j) { const unsigned c = xb_ld(&bar[XB_XCNT(j)]); sum += c; cnt += (c > 0u) ? 1u : 0u; mine = (j == x) ? c : mine; }
        if (sum == G) break;
        __builtin_amdgcn_s_sleep(1);
        if ((++sp & 255u) == 0u) { if (xb_ld(&bar[XB_TMO])) break; if (sp > XB_SPIN_CAP) { atomicAdd(&bar[XB_TMO], 1u); break; } }
    }
    nloc = mine > 0u ? mine : 1u; nx = cnt > 0u ? cnt : 1u;
}

__device__ __forceinline__ void xcd_barrier(const XcdBarrier& b) {
    asm volatile("s_waitcnt vmcnt(0)" ::: "memory");
    __syncthreads();
    if (threadIdx.x == 0) {
        unsigned* bar = b.bar;
        __builtin_amdgcn_s_waitcnt(0);
        unsigned nloc = b.st[0], nx = b.st[1];
        if (nloc == 0u) { xcd_barrier_complete(bar, b.x, nloc, nx); b.st[0] = nloc; b.st[1] = nx; }
        const unsigned old = xb_add(&bar[XB_XSUB(b.x)], 1u);
        const unsigned gen = old / nloc;
        if (old + 1u == (gen + 1u) * nloc) {
            __builtin_amdgcn_fence(__ATOMIC_RELEASE, "agent");
            asm volatile("s_waitcnt vmcnt(0)" ::: "memory");
            const unsigned og = xb_add(&bar[XB_TOP], 1u);
            const unsigned tg = og / nx;
            if (og + 1u == (tg + 1u) * nx) xb_add(&bar[XB_TOPGEN], 1u);
            else XB_SPIN(xb_ld(&bar[XB_TOPGEN]) == tg, bar);
            __builtin_amdgcn_fence(__ATOMIC_ACQUIRE, "agent");
            xb_add(&bar[XB_XGEN(b.x)], 1u);
            asm volatile("s_waitcnt vmcnt(0)" ::: "memory");
        } else {
            XB_SPIN(xb_ld(&bar[XB_XGEN(b.x)]) == gen, bar);
            __builtin_amdgcn_fence(__ATOMIC_ACQUIRE, "agent");
            asm volatile("s_waitcnt vmcnt(0)" ::: "memory");
        }
    }
    __syncthreads();
}

#ifndef PHMASK
#define PHMASK 127
#endif
struct Args { const float* in[22]; float* out; unsigned char* ws; };

__global__ void __launch_bounds__(512, 2) hymba_fwd(Args args) {
    extern __shared__ __attribute__((aligned(16))) unsigned char lds_raw[];
    LAS unsigned char* lds = (LAS unsigned char*)lds_raw;
    cg::grid_group grid = cg::this_grid();
    const int G = gridDim.x, bx = blockIdx.x;
    if (threadIdx.x < 32) ((volatile LAS unsigned*)(lds + LDS_MISC))[threadIdx.x] = 0u;
    __syncthreads();
    unsigned* barw = (unsigned*)(args.ws + WS_BAR);
    unsigned char* ws = args.ws;
    const float* x = args.in[0];
    unsigned* queue = (unsigned*)(ws + WS_QUEUE);
    float* ss1 = (float*)(ws + WS_SS1); float* ss2 = (float*)(ws + WS_SS2); float* rs0 = (float*)(ws + WS_RS0);
    bf16_t* Win_t = (bf16_t*)(ws + WS_WIN); bf16_t* Wout_t = (bf16_t*)(ws + WS_WOUT); bf16_t* Wup_t = (bf16_t*)(ws + WS_WUP); bf16_t* Wdn_t = (bf16_t*)(ws + WS_WDN);
    bf16_t* XB = (bf16_t*)(ws + WS_XB); bf16_t* PROJ = (bf16_t*)(ws + WS_PROJ); bf16_t* MIX = (bf16_t*)(ws + WS_MIX); bf16_t* ACT = (bf16_t*)(ws + WS_ACT);
    float* YS = (float*)(ws + WS_YS);

#if (PHMASK >> 0) & 1
    for (int rep = 0; rep < EXP_REP_P0; ++rep) {
        int tl = threadIdx.x; asm volatile("" : "+v"(tl)); const int tid = tl, lane = tl & 63, wave = __builtin_amdgcn_readfirstlane(tl >> 6);
        const int gw = bx * 8 + wave, NGW = G * 8;
        for (int i = bx * 512 + tid; i < (int)(WS_ZERO_BYTES / 4); i += G * 512) if (i < (int)(WS_RS0 / 4) || i >= (int)(WS_BAR / 4)) ((unsigned*)ws)[i] = 0u;
        LAS float* scr = (LAS float*)(lds + wave * 16384);
        constexpr int I_IN = (DM / 64) * (INW / 32);
        for (int it = gw; it < I_IN; it += NGW) p0_transpose_item<false>(args.in[2], DM, INW, Win_t, args.in[1], scr, it, lane);
        for (int m0 = gw; m0 < T_; m0 += 2 * NGW) {
            const int m1 = m0 + NGW;
            const f32x4* xa = (const f32x4*)(x + (size_t)m0 * DM) + lane; const f32x4* xb2 = (const f32x4*)(x + (size_t)(m1 < T_ ? m1 : m0) * DM) + lane;
            f32x4 va[4], vb[4]; float sa = 0.f, sb = 0.f;
#pragma unroll
            for (int j = 0; j < 4; ++j) { va[j] = xa[64 * j]; vb[j] = xb2[64 * j]; }
#pragma unroll
            for (int j = 0; j < 4; ++j) { sa += (va[j][0] * va[j][0] + va[j][1] * va[j][1]) + (va[j][2] * va[j][2] + va[j][3] * va[j][3]); sb += (vb[j][0] * vb[j][0] + vb[j][1] * vb[j][1]) + (vb[j][2] * vb[j][2] + vb[j][3] * vb[j][3]); }
            sa = wave_sum(sa); sb = wave_sum(sb);
            u32x2* oa = (u32x2*)(XB + (size_t)m0 * DM) + lane;
#pragma unroll
            for (int j = 0; j < 4; ++j) { u32x2 w; w.x = cvtpk(va[j][0], va[j][1]); w.y = cvtpk(va[j][2], va[j][3]); oa[64 * j] = w; }
            if (lane == 0) rs0[m0] = __builtin_amdgcn_rsqf(sa * (1.f / DM) + EPS);
            if (m1 < T_) { u32x2* ob = (u32x2*)(XB + (size_t)m1 * DM) + lane;
#pragma unroll
                for (int j = 0; j < 4; ++j) { u32x2 w; w.x = cvtpk(vb[j][0], vb[j][1]); w.y = cvtpk(vb[j][2], vb[j][3]); ob[64 * j] = w; }
                if (lane == 0) rs0[m1] = __builtin_amdgcn_rsqf(sb * (1.f / DM) + EPS); }
        }
    }
#endif
    grid.sync();
    const XcdBarrier xbar = xcd_barrier_post(barw, (volatile LAS unsigned*)(lds + LDS_MISC) + 8);

    for (int rep = 0; rep < EXP_EXTRA_SYNC; ++rep) xcd_barrier(xbar);
#if (PHMASK >> 1) & 1
    for (int rep = 0; rep < EXP_REP_P1; ++rep) {
        pg8::Gemm g{XB, Win_t, T_, INW, DM, 256}; pg8::StaticOrder S; S.init(T_, INW, G, bx);
        pg8::EpiProj E{PROJ, INW, rs0};
        pg8::gemm_phase<pg8::EpiProj, pg8::StaticOrder, true, true>(lds, g, S, E);
    }
#endif
    xcd_barrier(xbar);

#if (PHMASK >> 2) & 1
    {
        int tl = threadIdx.x; asm volatile("" : "+v"(tl)); const int tid = tl;
        float lam;
        { float d1 = 0.f, d2 = 0.f;
          for (int i = 0; i < 64; ++i) { d1 += args.in[3][i] * args.in[4][i]; d2 += args.in[5][i] * args.in[6][i]; }
          lam = __expf(d1) - __expf(d2) + 0.2f; }
        lru::Params lp{PROJ, YS, MIX, (unsigned*)(ws + WS_LCNT), args.in[8], args.in[9], args.in[10], args.in[11], args.in[12], args.in[13], args.in[14]};
        volatile LAS unsigned* misc = (volatile LAS unsigned*)(lds + LDS_MISC);
#ifndef NO_LRU
        for (int rep = 0; rep < EXP_REP_LRU; ++rep)
        for (;;) {
            if (tid == 0) misc[0] = atomicAdd(queue + rep * 128, 1u);
            __syncthreads();
            const int item = (int)misc[0];
            __syncthreads();
            if (item >= 128) break;
            lru::lru_item(item, lp, lds);
        }
#endif
#ifndef NO_ATT
        for (int rep = 0; rep < EXP_REP_ATT; ++rep)
        for (;;) {
            if (tid == 0) misc[0] = atomicAdd(queue + 64 + rep * 128, 1u);
            __syncthreads();
            const int item = (int)misc[0];
            __syncthreads();
            if (item >= 512) break;
            att::attn_unit(item, PROJ, MIX, args.in[7], lam, (char*)lds_raw);
        }
#endif
        {
            constexpr int I_OUT = (DM / 64) * (DM / 32), I_UP = (DM / 64) * (FF2 / 32), NF = (I_OUT + I_UP) / 8;
            const int lane = tid & 63, wave = __builtin_amdgcn_readfirstlane(tid >> 6);
            LAS float* scr = (LAS float*)(lds + wave * 16384);
            for (;;) {
                if (tid == 0) misc[0] = atomicAdd(queue + 320, 1u);
                __syncthreads();
                const int item = (int)misc[0];
                __syncthreads();
                if (item >= NF) break;
                int r = item * 8 + wave;
                if (r < I_OUT) p0_transpose_item<false>(args.in[15], DM, DM, Wout_t, nullptr, scr, r, lane);
                else p0_transpose_item<true>(args.in[17], DM, FF2, Wup_t, args.in[16], scr, r - I_OUT, lane);
            }
        }
    }
#endif
    xcd_barrier(xbar);

#if (PHMASK >> 3) & 1
    {
        pg8::Gemm g{MIX, Wout_t, T_, DM, DM, 256}; pg8::StaticOrder S; S.init(T_, DM, G, bx);
        pg8::EpiResBf E{XB, ss1, (LAS float*)(lds + LDS_EDGE)};
        pg8::gemm_phase<pg8::EpiResBf, pg8::StaticOrder, true, true>(lds, g, S, E);
    }
#endif
    xcd_barrier(xbar);

#if (PHMASK >> 4) & 1
    for (int rep = 0; rep < EXP_REP_P4; ++rep) {
        pg8::Gemm g{XB - DM, Wup_t, 65 * 256, FF2, DM, 254}; pg8::StaticOrder S; S.init(65 * 256, FF2, G, bx);
        pg8::EpiUp E{ACT, ss1, args.in[18], args.in[19], (LAS float*)(lds + LDS_EDGE)};
        pg8::gemm_phase<pg8::EpiUp, pg8::StaticOrder, true, true>(lds, g, S, E);
    }
    {
        constexpr int I_DN = (FF / 64) * (DM / 32), NF4 = I_DN / 8;
        int tl = threadIdx.x; asm volatile("" : "+v"(tl)); const int tid = tl, lane = tid & 63, wave = __builtin_amdgcn_readfirstlane(tid >> 6);
        volatile LAS unsigned* misc = (volatile LAS unsigned*)(lds + LDS_MISC); LAS float* scr = (LAS float*)(lds + wave * 16384);
        for (;;) {
            if (tid == 0) misc[0] = atomicAdd(queue + 384, 1u);
            __syncthreads();
            const int item = (int)misc[0];
            __syncthreads();
            if (item >= NF4) break;
            p0_transpose_item<false>(args.in[20], FF, DM, Wdn_t, nullptr, scr, item * 8 + wave, lane);
        }
    }
#endif
    xcd_barrier(xbar);

#if (PHMASK >> 5) & 1
    {
        pg8::Gemm g{ACT, Wdn_t, T_, DM, FF, 256}; pg8::StaticOrder S; S.init(T_, DM, G, bx);
        pg8::EpiResNorm E{XB, args.out, ss2, (unsigned*)(ws + WS_PCNT), args.in[21], (LAS float*)(lds + LDS_EDGE)};
        pg8::gemm_phase<pg8::EpiResNorm, pg8::StaticOrder, true, true>(lds, g, S, E);
    }
#endif

}

extern "C" void kernel_launch(void* const* d_in, const int* in_sizes, int n_in, void* d_out, int out_size, void* d_ws, size_t ws_size, hipStream_t stream) {
    static int grid = 0;
    if (grid == 0) {
        if (n_in != 22 || out_size != T_ * DM || ws_size < WS_END) { fprintf(stderr, "kernel_launch: unexpected shapes (n_in %d out %d ws %zu)\n", n_in, out_size, ws_size); grid = -1; return; }
        int dev = 0, cus = 0, per_cu = 0;
        (void)hipGetDevice(&dev); (void)hipDeviceGetAttribute(&cus, hipDeviceAttributeMultiprocessorCount, dev);
        if (hipFuncSetAttribute((const void*)hymba_fwd, hipFuncAttributeMaxDynamicSharedMemorySize, LDS_BYTES) != hipSuccess) { fprintf(stderr, "kernel_launch: hipFuncSetAttribute failed\n"); grid = -1; return; }
        if (hipOccupancyMaxActiveBlocksPerMultiprocessor(&per_cu, (const void*)hymba_fwd, 512, LDS_BYTES) != hipSuccess || per_cu < 1) per_cu = 1;
        (void)hipGetLastError();
        grid = cus * 1;
        if (grid != 256) { fprintf(stderr, "kernel_launch: built for a 256-CU device (got %d)\n", cus); grid = 256; }
    }
    if (grid < 0) return;
    Args a{};
    for (int i = 0; i < 22; ++i) a.in[i] = (const float*)d_in[i];
    a.out = (float*)d_out; a.ws = (unsigned char*)d_ws;
    void* kargs[] = {&a};
    hipError_t e = hipLaunchCooperativeKernel((const void*)hymba_fwd, dim3(grid), dim3(512), kargs, LDS_BYTES, stream);
    if (e != hipSuccess) fprintf(stderr, "cooperative launch failed: %s (grid %d)\n", hipGetErrorString(e), grid);
}
```

```cpp
#include <hip/hip_runtime.h>
#include <hip/hip_cooperative_groups.h>
#include <cstdint>
#include <cstdio>
namespace cg = cooperative_groups;
#ifndef EXP_REP_LRU
#define EXP_REP_LRU 1
#endif
#ifndef EXP_REP_ATT
#define EXP_REP_ATT 1
#endif
#ifndef EXP_REP_P1
#define EXP_REP_P1 1
#endif
#ifndef EXP_REP_P4
#define EXP_REP_P4 1
#endif
#ifndef EXP_REP_P0
#define EXP_REP_P0 1
#endif
#ifndef EXP_EXTRA_SYNC
#define EXP_EXTRA_SYNC 0
#endif
#ifndef EXP_REP_P3
#define EXP_REP_P3 1
#endif
#ifndef EXP_REP_P5
#define EXP_REP_P5 1
#endif
#ifndef EXP_MIXSCALE
#define EXP_MIXSCALE 1.f
#endif
#ifndef EXP_FFNSCALE
#define EXP_FFNSCALE 1.f
#endif
#ifndef EXP_ATTSCALE
#define EXP_ATTSCALE 1.f
#endif
#ifndef EXP_LRUSCALE
#define EXP_LRUSCALE 1.f
#endif

#define LAS __attribute__((address_space(3)))
typedef short bf16x8 __attribute__((ext_vector_type(8)));
typedef short s16x4 __attribute__((ext_vector_type(4)));
typedef float f32x2 __attribute__((ext_vector_type(2)));
typedef float f32x4 __attribute__((ext_vector_type(4)));
typedef float f32x8 __attribute__((ext_vector_type(8)));
typedef float f32x16 __attribute__((ext_vector_type(16)));
typedef unsigned u32x2 __attribute__((ext_vector_type(2)));
typedef unsigned u32x4 __attribute__((ext_vector_type(4)));

constexpr int T_ = 16384, DM = 1024, SEQ = 2048, INW = 2560, FF = 2816, FF2 = 5632;
constexpr float EPS = 1e-6f, L2E = 1.4426950408889634f;
constexpr size_t MiB = 1u << 20;
constexpr size_t WS_BAR = 262144;
constexpr size_t WS_PCNT = 327680;
constexpr size_t WS_LCNT = 360448;
constexpr size_t WS_ZERO_BYTES = 393216;
constexpr size_t WS_QUEUE = 0, WS_SS1 = 65536, WS_SS2 = 131072, WS_RS0 = 196608;
constexpr size_t WS_WIN = 1 * MiB, WS_WOUT = 6 * MiB, WS_WUP = 8 * MiB, WS_WDN = 19 * MiB;
constexpr size_t WS_XB = 26 * MiB;
constexpr size_t WS_PROJ = 59 * MiB;
constexpr size_t WS_MIX = 139 * MiB;
constexpr size_t WS_YS = 171 * MiB;
constexpr size_t WS_ACT = 59 * MiB;
constexpr size_t WS_END = 235 * MiB;
constexpr int LDS_EDGE = 131072, LDS_TOT = 135168, LDS_CW = 143360, LDS_MISC = 145408, LDS_BYTES = 147456;

__device__ __forceinline__ unsigned cvtpk(float lo, float hi) { unsigned r; asm volatile("v_cvt_pk_bf16_f32 %0, %1, %2" : "=v"(r) : "v"(lo), "v"(hi)); return r; }
__device__ __forceinline__ float bf2f(short s) { return __uint_as_float(((unsigned)(unsigned short)s) << 16); }
__device__ __forceinline__ bf16x8 pack8(f32x8 x) { u32x4 w = {cvtpk(x[0], x[1]), cvtpk(x[2], x[3]), cvtpk(x[4], x[5]), cvtpk(x[6], x[7])}; return __builtin_bit_cast(bf16x8, w); }
__device__ __forceinline__ float gelu_tanh(float x) {
    const float e = __builtin_amdgcn_exp2f(-2.302208198f * x * (1.f + 0.044715f * x * x));
    return x * __builtin_amdgcn_rcpf(1.f + e);
}
__device__ __forceinline__ float wave_sum(float v) {
#pragma unroll
    for (int o = 1; o < 64; o <<= 1) v += __shfl_xor(v, o);
    return v;
}
typedef unsigned short bf16_t;
namespace pg8 {
#define PG8_LAS __attribute__((address_space(3)))
constexpr int BM = 256, BK = 64, HALF = 128, HTB = HALF * BK * 2  , STAGE_BYTES = 8 * HTB, NXCD = 8, WGM = 8;

__host__ __device__ __forceinline__ int lds_byte(int r, int c) { const int st = (r >> 4) * 2 + (c >> 5), rr = r & 15, cc = c & 31, ob = rr * 64 + cc * 2; return st * 1024 + (ob ^ (((ob >> 9) & 1) << 5)); }
__host__ __device__ __forceinline__ void stage_rc(int b, int& R, int& C) { const int st = b / 1024, sb = b % 1024, swz = sb ^ (((sb >> 9) & 1) << 5); R = (st >> 1) * 16 + swz / 64; C = (st & 1) * 32 + (swz % 64) / 2; }
__host__ __device__ __forceinline__ int perm32(int rho) { const int n = rho >> 4, i = rho & 15; return 8 * (i >> 2) + 4 * n + (i & 3); }

struct Unit { int pm, pn; };
struct Gemm { const bf16_t* A; const bf16_t* Bt; int M, N, K, a_rows; };

struct StaticOrder {
    int nM, nN, nwg, G, c;
    __host__ __device__ void init(int M, int N, int G_, int c_) { nM = M / BM; nN = N / BM; nwg = nM * nN; G = G_; c = c_; }
    __host__ __device__ bool next(int i, Unit& u) const {
        const long L = (long)i * G + c; if (L >= nwg) return false;
        int wgid = (int)L; { const int q = nwg / NXCD, r = nwg % NXCD, xcd = wgid % NXCD, off = wgid / NXCD; wgid = (xcd < r ? xcd * (q + 1) : r * (q + 1) + (xcd - r) * q) + off; }
        const int nig = WGM * nN, gid = wgid / nig, fm = gid * WGM, gsz = (nM - fm) < WGM ? (nM - fm) : WGM;
        u.pm = fm + ((wgid % nig) % gsz); u.pn = (wgid % nig) / gsz; return true;
    }
    __device__ __forceinline__ void a_ready(const Unit&) const {}
    __device__ __forceinline__ void done(const Unit&) const {}
};
struct EpiProj {
    static constexpr bool PERM = true, AFTER_DRAIN = false;
    bf16_t* O; int ldc; const float* rs;
    __device__ __forceinline__ void operator()(f32x4 (&acc)[2][2][4][2], const Unit& u, int wr, int wc, int fr, int fq) const {
        const int row0 = u.pm * BM + wr * 64 + fr, col0 = u.pn * BM + wc * 32 + 8 * fq;
#pragma unroll
        for (int ai = 0; ai < 2; ++ai)
#pragma unroll
            for (int m = 0; m < 4; ++m) { const int row = row0 + ai * HALF + m * 16; const float s = rs[row]; bf16_t* rowp = O + (size_t)row * ldc + col0;
#pragma unroll
                for (int bj = 0; bj < 2; ++bj) { const f32x4 v0 = acc[ai][bj][m][0] * s, v1 = acc[ai][bj][m][1] * s;
                    u32x4 w; w.x = cvtpk(v0[0], v0[1]); w.y = cvtpk(v0[2], v0[3]); w.z = cvtpk(v1[0], v1[1]); w.w = cvtpk(v1[2], v1[3]);
                    *(u32x4*)(rowp + bj * HALF) = w; } }
    }
};
struct EpiRes {
    static constexpr bool PERM = false, AFTER_DRAIN = false;
    const float* base; float* out; bf16_t* xb; float* ss; float ascale;
    __device__ __forceinline__ void operator()(f32x4 (&acc)[2][2][4][2], const Unit& u, int wr, int wc, int fr, int fq) const {
        const int row0 = u.pm * BM + wr * 64 + fr, col0 = u.pn * BM + wc * 32 + 4 * fq;
#pragma unroll
        for (int ai = 0; ai < 2; ++ai)
#pragma unroll
            for (int m = 0; m < 4; ++m) { const int row = row0 + ai * HALF + m * 16; const size_t off = (size_t)row * 1024 + col0; float sq = 0.f;
#pragma unroll
                for (int bj = 0; bj < 2; ++bj)
#pragma unroll
                    for (int n = 0; n < 2; ++n) { const size_t o2 = off + bj * HALF + n * 16; const f32x4 b = *(const f32x4*)(base + o2); const f32x4 o = b + acc[ai][bj][m][n] * ascale;
                        *(f32x4*)(out + o2) = o; sq += (o[0] * o[0] + o[1] * o[1]) + (o[2] * o[2] + o[3] * o[3]);
                        if (xb) { u32x2 w; w.x = cvtpk(o[0], o[1]); w.y = cvtpk(o[2], o[3]); *(u32x2*)(xb + o2) = w; } }
                sq += __shfl_xor(sq, 16); sq += __shfl_xor(sq, 32);
                if (fq == 0) atomicAdd(ss + row, sq); }
    }
};
__device__ __forceinline__ float bflo(unsigned w) { return __uint_as_float(w << 16); }
__device__ __forceinline__ float bfhi(unsigned w) { return __uint_as_float(w & 0xffff0000u); }
struct EpiResBf {
    static constexpr bool PERM = false, AFTER_DRAIN = false;
    bf16_t* xb; float* ss; PG8_LAS float* red;
    __device__ __forceinline__ void operator()(f32x4 (&acc)[2][2][4][2], const Unit& u, int wr, int wc, int fr, int fq) const {
        const int row0 = u.pm * BM + wr * 64 + fr, col0 = u.pn * BM + wc * 32 + 4 * fq;
#pragma unroll
        for (int ai = 0; ai < 2; ++ai)
#pragma unroll
            for (int m = 0; m < 4; ++m) { const int row = row0 + ai * HALF + m * 16; const size_t off = (size_t)row * 1024 + col0; float sq = 0.f;
#pragma unroll
                for (int bj = 0; bj < 2; ++bj)
#pragma unroll
                    for (int n = 0; n < 2; ++n) { const size_t o2 = off + bj * HALF + n * 16; const u32x2 bw = *(const u32x2*)(xb + o2); const f32x4 b = {bflo(bw.x), bfhi(bw.x), bflo(bw.y), bfhi(bw.y)}; const f32x4 o = b + acc[ai][bj][m][n];
                        u32x2 w; w.x = cvtpk(o[0], o[1]); w.y = cvtpk(o[2], o[3]); *(u32x2*)(xb + o2) = w;
                        const float r0 = bflo(w.x), r1 = bfhi(w.x), r2 = bflo(w.y), r3 = bfhi(w.y); sq += (r0 * r0 + r1 * r1) + (r2 * r2 + r3 * r3); }
                sq += __shfl_xor(sq, 16); sq += __shfl_xor(sq, 32);
                if (fq == 0) red[wc * 256 + ai * HALF + wr * 64 + m * 16 + fr] = sq; }
        asm volatile("s_waitcnt lgkmcnt(0)" ::: "memory"); __builtin_amdgcn_s_barrier(); asm volatile("" ::: "memory");
        if (threadIdx.x < 256) { const int r = threadIdx.x; atomicAdd(ss + u.pm * BM + r, (red[r] + red[256 + r]) + (red[512 + r] + red[768 + r])); }
    }
};
struct EpiResNorm {
    static constexpr bool PERM = false, AFTER_DRAIN = false;
    const bf16_t* base; float* out; float* ss; unsigned* cnt; const float* gain; PG8_LAS float* red;
    __device__ __forceinline__ void operator()(f32x4 (&acc)[2][2][4][2], const Unit& u, int wr, int wc, int fr, int fq) const {
        const int row0 = u.pm * BM + wr * 64 + fr, col0 = u.pn * BM + wc * 32 + 4 * fq;
#pragma unroll
        for (int ai = 0; ai < 2; ++ai)
#pragma unroll
            for (int m = 0; m < 4; ++m) { const int row = row0 + ai * HALF + m * 16; const size_t off = (size_t)row * 1024 + col0; float sq = 0.f;
#pragma unroll
                for (int bj = 0; bj < 2; ++bj)
#pragma unroll
                    for (int n = 0; n < 2; ++n) { const u32x2 bw = *(const u32x2*)(base + off + bj * HALF + n * 16); const f32x4 b = {bflo(bw.x), bfhi(bw.x), bflo(bw.y), bfhi(bw.y)}; const f32x4 o = b + acc[ai][bj][m][n];
                        acc[ai][bj][m][n] = o; sq += (o[0] * o[0] + o[1] * o[1]) + (o[2] * o[2] + o[3] * o[3]); }
                sq += __shfl_xor(sq, 16); sq += __shfl_xor(sq, 32);
                if (fq == 0) red[wc * 256 + ai * HALF + wr * 64 + m * 16 + fr] = sq; }
        asm volatile("s_waitcnt lgkmcnt(0)" ::: "memory"); __builtin_amdgcn_s_barrier(); asm volatile("" ::: "memory");
        unsigned* pc = cnt + 64 * u.pm;
        if (threadIdx.x < 256) { const int r = threadIdx.x;
            __hip_atomic_fetch_add(ss + u.pm * BM + r, (red[r] + red[256 + r]) + (red[512 + r] + red[768 + r]), __ATOMIC_RELAXED, __HIP_MEMORY_SCOPE_AGENT);
            asm volatile("s_waitcnt vmcnt(0)" ::: "memory");
            if ((threadIdx.x & 63) == 0) __hip_atomic_fetch_add(pc, 1u, __ATOMIC_RELAXED, __HIP_MEMORY_SCOPE_AGENT); }
        if (threadIdx.x < 64) { unsigned sp = 0;
            while ((unsigned)__builtin_amdgcn_readfirstlane(__hip_atomic_load(pc, __ATOMIC_RELAXED, __HIP_MEMORY_SCOPE_AGENT)) < 16u) { __builtin_amdgcn_s_sleep(2); if (++sp > (1u << 22)) break; }
            __builtin_amdgcn_fence(__ATOMIC_ACQUIRE, "agent"); }
        asm volatile("s_waitcnt vmcnt(0) lgkmcnt(0)" ::: "memory"); __builtin_amdgcn_s_barrier(); asm volatile("" ::: "memory");
        f32x4 gv[2][2];
#pragma unroll
        for (int bj = 0; bj < 2; ++bj)
#pragma unroll
            for (int n = 0; n < 2; ++n) gv[bj][n] = *(const f32x4*)(gain + col0 + bj * HALF + n * 16);
#pragma unroll
        for (int ai = 0; ai < 2; ++ai)
#pragma unroll
            for (int m = 0; m < 4; ++m) { const int row = row0 + ai * HALF + m * 16; const size_t off = (size_t)row * 1024 + col0;
                const float rs = __builtin_amdgcn_rsqf(__hip_atomic_load(ss + row, __ATOMIC_RELAXED, __HIP_MEMORY_SCOPE_AGENT) * (1.f / 1024.f) + EPS);
#pragma unroll
                for (int bj = 0; bj < 2; ++bj)
#pragma unroll
                    for (int n = 0; n < 2; ++n) *(f32x4*)(out + off + bj * HALF + n * 16) = acc[ai][bj][m][n] * rs * gv[bj][n]; }
    }
};
__device__ __forceinline__ f32x4 dpp_shr1(f32x4 c, f32x4 old) { float r0 = old[0], r1 = old[1], r2 = old[2], r3 = old[3];
    asm("s_nop 1\n\tv_mov_b32_dpp %0, %4 row_shr:1 row_mask:0xf bank_mask:0xf\n\tv_mov_b32_dpp %1, %5 row_shr:1 row_mask:0xf bank_mask:0xf\n\tv_mov_b32_dpp %2, %6 row_shr:1 row_mask:0xf bank_mask:0xf\n\tv_mov_b32_dpp %3, %7 row_shr:1 row_mask:0xf bank_mask:0xf"
        : "+&v"(r0), "+&v"(r1), "+&v"(r2), "+&v"(r3) : "v"(c[0]), "v"(c[1]), "v"(c[2]), "v"(c[3]));
    return (f32x4){r0, r1, r2, r3}; }
__device__ __forceinline__ f32x4 dpp_shl1(f32x4 c, f32x4 old) { float r0 = old[0], r1 = old[1], r2 = old[2], r3 = old[3];
    asm("s_nop 1\n\tv_mov_b32_dpp %0, %4 row_shl:1 row_mask:0xf bank_mask:0xf\n\tv_mov_b32_dpp %1, %5 row_shl:1 row_mask:0xf bank_mask:0xf\n\tv_mov_b32_dpp %2, %6 row_shl:1 row_mask:0xf bank_mask:0xf\n\tv_mov_b32_dpp %3, %7 row_shl:1 row_mask:0xf bank_mask:0xf"
        : "+&v"(r0), "+&v"(r1), "+&v"(r2), "+&v"(r3) : "v"(c[0]), "v"(c[1]), "v"(c[2]), "v"(c[3]));
    return (f32x4){r0, r1, r2, r3}; }
__device__ __forceinline__ f32x4 dpp_mirror(f32x4 c) { float r0, r1, r2, r3;
    asm("s_nop 1\n\tv_mov_b32_dpp %0, %4 row_mirror row_mask:0xf bank_mask:0xf\n\tv_mov_b32_dpp %1, %5 row_mirror row_mask:0xf bank_mask:0xf\n\tv_mov_b32_dpp %2, %6 row_mirror row_mask:0xf bank_mask:0xf\n\tv_mov_b32_dpp %3, %7 row_mirror row_mask:0xf bank_mask:0xf"
        : "=&v"(r0), "=&v"(r1), "=&v"(r2), "=&v"(r3) : "v"(c[0]), "v"(c[1]), "v"(c[2]), "v"(c[3]));
    return (f32x4){r0, r1, r2, r3}; }
struct EpiUp {
    static constexpr bool PERM = true, AFTER_DRAIN = false;
    bf16_t* act; const float* ss1; const float* cw; const float* cb; PG8_LAS float* edge;
    __device__ __forceinline__ void operator()(f32x4 (&acc)[2][2][4][2], const Unit& u, int wr, int wc, int fr, int fq) const {
        const int tbase = u.pm * 254 - 1;
        const bool bnd = ((tbase + 1) >> 11) != ((tbase + 256) >> 11) || ((tbase + 1) & (SEQ - 1)) == 0 || tbase < 0;
#pragma unroll
        for (int ai = 0; ai < 2; ++ai)
#pragma unroll
            for (int m = 0; m < 4; ++m) { const int t = tbase + ai * HALF + wr * 64 + m * 16 + fr; float s = 0.f;
                if (t >= 0 && t < T_) s = __builtin_amdgcn_rsqf(ss1[t] * (1.f / 1024.f) + EPS);
#pragma unroll
                for (int bj = 0; bj < 2; ++bj)
#pragma unroll
                    for (int n = 0; n < 2; ++n) acc[ai][bj][m][n] *= s; }
        const int colw = wc * 32 + 4 * fq;
        if (fr == 0 || fr == 15) { const int e = (fr == 15) ? 1 : 0;
#pragma unroll
            for (int ai = 0; ai < 2; ++ai) { const int g = 2 * ai + wr;
#pragma unroll
                for (int bj = 0; bj < 2; ++bj)
#pragma unroll
                    for (int n = 0; n < 2; ++n) *(PG8_LAS f32x4*)(edge + ((g * 2 + e) * 256 + 128 * bj + colw + 16 * n)) = e ? acc[ai][bj][3][n] : acc[ai][bj][0][n]; } }
        asm volatile("s_waitcnt lgkmcnt(0)" ::: "memory"); __builtin_amdgcn_s_barrier(); asm volatile("" ::: "memory");
        u32x2 stash[2][4];
#pragma unroll
        for (int n = 0; n < 2; ++n) {
            const int f = u.pn * 128 + wc * 32 + 8 * fq + 4 * n;
            f32x4 w0[2], w1[2], w2[2], bb[2];
#pragma unroll
            for (int bj = 0; bj < 2; ++bj) { const int c = f + bj * FF; w0[bj] = *(const f32x4*)(cw + c); w1[bj] = *(const f32x4*)(cw + FF2 + c); w2[bj] = *(const f32x4*)(cw + 2 * FF2 + c); bb[bj] = *(const f32x4*)(cb + c); }
#pragma unroll
            for (int ai = 0; ai < 2; ++ai) { const int g = 2 * ai + wr;
#pragma unroll
                for (int m = 0; m < 4; ++m) { const int R = ai * HALF + wr * 64 + m * 16 + fr, t = tbase + R, tp = t & (SEQ - 1);
                    f32x4 uu[2];
#pragma unroll
                    for (int bj = 0; bj < 2; ++bj) { const f32x4 cur = acc[ai][bj][m][n]; f32x4 upe, dne;
                        if (m > 0) upe = dpp_mirror(acc[ai][bj][m - 1][n]); else upe = (g > 0) ? *(PG8_LAS const f32x4*)(edge + (((g - 1) * 2 + 1) * 256 + 128 * bj + colw + 16 * n)) : (f32x4){0.f, 0.f, 0.f, 0.f};
                        if (m < 3) dne = dpp_mirror(acc[ai][bj][m + 1][n]); else dne = (g < 3) ? *(PG8_LAS const f32x4*)(edge + (((g + 1) * 2 + 0) * 256 + 128 * bj + colw + 16 * n)) : (f32x4){0.f, 0.f, 0.f, 0.f};
                        f32x4 up = dpp_shr1(cur, upe), dn = dpp_shl1(cur, dne);
                        if (bnd) {
                            if (tp == 0) up = (f32x4){0.f, 0.f, 0.f, 0.f};
                            if (tp == SEQ - 1) dn = (f32x4){0.f, 0.f, 0.f, 0.f}; }
                        uu[bj] = bb[bj] + w0[bj] * up + w1[bj] * cur + w2[bj] * dn; }
                    { u32x2 w; w.x = cvtpk(gelu_tanh(uu[0][0]) * uu[1][0], gelu_tanh(uu[0][1]) * uu[1][1]); w.y = cvtpk(gelu_tanh(uu[0][2]) * uu[1][2], gelu_tanh(uu[0][3]) * uu[1][3]);
                        if (n == 0) stash[ai][m] = w;
                        else if (R >= 1 && R <= 254 && t < T_) *(u32x4*)(act + (size_t)t * FF + (f - 4)) = (u32x4){stash[ai][m].x, stash[ai][m].y, w.x, w.y}; } } }
        }
    }
};
template <class Epi, class Sched, bool ALIGN_EPI = false, bool SP2 = false>
__device__ __forceinline__ void gemm_phase(PG8_LAS unsigned char* lds, const Gemm g, const Sched& S, const Epi& E) {
    int tid_l = threadIdx.x; asm volatile("" : "+v"(tid_l));
    const int tid = tid_l, wid = __builtin_amdgcn_readfirstlane(tid >> 6), lane = tid & 63, wr = wid >> 2, wc = wid & 3, fr = lane & 15, fq = lane >> 4;
    const int K = g.K, nt = K / BK;
    unsigned voffA[2], voffB[2];
#pragma unroll
    for (int i = 0; i < 2; ++i) { int R, C; stage_rc(tid * 16 + i * 8192, R, C); const int Rb = Epi::PERM ? ((R & ~31) + perm32(R & 31)) : R;
        voffA[i] = (unsigned)(R * K + C) * 2u; voffB[i] = (unsigned)(Rb * K + C) * 2u; }
    const size_t kstep = (size_t)(BK * 2);
    const size_t hstep = (size_t)HALF * K * 2;
    const size_t tstep = 2 * hstep; const size_t tstepA = (size_t)g.a_rows * K * 2;
    const unsigned ldsw = (unsigned)wid * 1024u;
    const int aoff = lds_byte(wr * 64 + fr, fq * 8), boff = lds_byte(wc * 32 + fr, fq * 8);
#define PG8_SA(b, h) (((b) * 2 + (h)) * HTB)
#define PG8_SB(b, h) ((4 + (b) * 2 + (h)) * HTB)
#define PG8_STAGE(bufoff, gbase, voff) do { _Pragma("unroll") for (int _i = 0; _i < 2; ++_i) \
        __builtin_amdgcn_global_load_lds((const unsigned*)((const char*)(gbase) + (voff)[_i]), (PG8_LAS unsigned*)(lds + (bufoff) + ldsw + _i * 8192), 16, 0, 0); } while (0)
#define PG8_LDA(dst, b, h) do { _Pragma("unroll") for (int m = 0; m < 4; ++m) _Pragma("unroll") for (int k = 0; k < 2; ++k) dst[m][k] = *(const PG8_LAS bf16x8*)(lds + PG8_SA(b, h) + aoff + m * 2048 + k * 1024); } while (0)
#define PG8_LDB(dst, b, h) do { _Pragma("unroll") for (int n = 0; n < 2; ++n) _Pragma("unroll") for (int k = 0; k < 2; ++k) dst[n][k] = *(const PG8_LAS bf16x8*)(lds + PG8_SB(b, h) + boff + n * 2048 + k * 1024); } while (0)
#define PG8_MMA(ai, bj, At, Bt) do { __builtin_amdgcn_s_setprio(1); _Pragma("unroll") for (int m = 0; m < 4; ++m) _Pragma("unroll") for (int n = 0; n < 2; ++n) _Pragma("unroll") for (int k = 0; k < 2; ++k) \
        acc[ai][bj][m][n] = __builtin_amdgcn_mfma_f32_16x16x32_bf16(Bt[n][k], At[m][k], acc[ai][bj][m][n], 0, 0, 0); __builtin_amdgcn_s_setprio(0); } while (0)
#define PG8_WAIT_V(n) asm volatile("s_waitcnt vmcnt(" #n ")" ::: "memory")
#define PG8_WAIT_L(n) asm volatile("s_waitcnt lgkmcnt(" #n ")" ::: "memory")
#define PG8_BAR __builtin_amdgcn_s_barrier()
#define PG8_SCHED __builtin_amdgcn_sched_barrier(0)
    Unit cur, nxt; int ui = 0;
    if (!S.next(0, cur)) return;
    f32x4 acc[2][2][4][2];
#pragma unroll
    for (int a = 0; a < 2; ++a)
#pragma unroll
        for (int b = 0; b < 2; ++b)
#pragma unroll
            for (int m = 0; m < 4; ++m)
#pragma unroll
                for (int n = 0; n < 2; ++n) acc[a][b][m][n] = (f32x4){0.f, 0.f, 0.f, 0.f};
    bf16x8 At[4][2], B0[2][2], B1[2][2];
    const char* cA = (const char*)g.A + (size_t)cur.pm * tstepA; const char* cB = (const char*)g.Bt + (size_t)cur.pn * tstep;
    S.a_ready(cur);
    if constexpr (SP2) {
        PG8_STAGE(PG8_SB(0, 0), cB, voffB); PG8_STAGE(PG8_SB(0, 1), cB + hstep, voffB); PG8_STAGE(PG8_SA(0, 0), cA, voffA); PG8_STAGE(PG8_SA(0, 1), cA + hstep, voffA);
        if (wr == 1) PG8_BAR;
        PG8_WAIT_V(2); PG8_BAR;
        PG8_STAGE(PG8_SB(1, 0), cB + kstep, voffB); PG8_STAGE(PG8_SA(1, 0), cA + kstep, voffA); PG8_STAGE(PG8_SB(1, 1), cB + hstep + kstep, voffB);
        PG8_WAIT_V(6); PG8_BAR;
    } else {
        PG8_STAGE(PG8_SB(0, 0), cB, voffB); PG8_STAGE(PG8_SA(0, 0), cA, voffA); PG8_STAGE(PG8_SB(0, 1), cB + hstep, voffB); PG8_STAGE(PG8_SA(0, 1), cA + hstep, voffA);
        if (wr == 1) PG8_BAR;
        PG8_WAIT_V(4); PG8_BAR;
        PG8_STAGE(PG8_SB(1, 0), cB + kstep, voffB); PG8_STAGE(PG8_SA(1, 0), cA + kstep, voffA); PG8_STAGE(PG8_SB(1, 1), cB + hstep + kstep, voffB);
        PG8_WAIT_V(6); PG8_BAR;
    }
    for (;;) {
        const bool has_next = S.next(ui + 1, nxt);
        const char* nA = has_next ? (const char*)g.A + (size_t)nxt.pm * tstepA : cA; const char* nB = has_next ? (const char*)g.Bt + (size_t)nxt.pn * tstep : cB;
        for (int t = 0; t < nt; t += 2) {
            const bool last = (t == nt - 2);
            const char* a1 = cA + (size_t)(t + 1) * kstep;
            const char* a2 = last ? nA : cA + (size_t)(t + 2) * kstep; const char* b2 = last ? nB : cB + (size_t)(t + 2) * kstep;
            const char* a3 = a2 + kstep; const char* b3 = b2 + kstep;
            if (last && has_next) S.a_ready(nxt);
            if constexpr (SP2) {
            PG8_LDB(B0, 0, 0); PG8_LDB(B1, 0, 1); PG8_SCHED; PG8_LDA(At, 0, 0); PG8_STAGE(PG8_SA(1, 1), a1 + hstep, voffA);
            PG8_WAIT_V(8); PG8_WAIT_L(0); PG8_BAR; PG8_MMA(0, 0, At, B0); PG8_MMA(0, 1, At, B1); PG8_BAR; PG8_SCHED;
            PG8_LDA(At, 0, 1); PG8_STAGE(PG8_SB(0, 0), b2, voffB); PG8_STAGE(PG8_SB(0, 1), b2 + hstep, voffB); PG8_STAGE(PG8_SA(0, 0), a2, voffA);
            PG8_WAIT_V(8); PG8_WAIT_L(0); PG8_BAR; PG8_MMA(1, 0, At, B0); PG8_MMA(1, 1, At, B1); PG8_BAR; PG8_SCHED;
            PG8_LDB(B0, 1, 0); PG8_LDB(B1, 1, 1); PG8_SCHED; PG8_LDA(At, 1, 0); PG8_STAGE(PG8_SA(0, 1), a2 + hstep, voffA);
            PG8_WAIT_V(8); PG8_WAIT_L(0); PG8_BAR; PG8_MMA(0, 0, At, B0); PG8_MMA(0, 1, At, B1); PG8_BAR; PG8_SCHED;
            PG8_LDA(At, 1, 1); PG8_STAGE(PG8_SB(1, 0), b3, voffB); PG8_STAGE(PG8_SB(1, 1), b3 + hstep, voffB); PG8_STAGE(PG8_SA(1, 0), a3, voffA);
            PG8_WAIT_V(8); PG8_WAIT_L(0); PG8_BAR; PG8_MMA(1, 0, At, B0); PG8_MMA(1, 1, At, B1); PG8_BAR; PG8_SCHED;
            } else {
            PG8_LDB(B0, 0, 0); PG8_SCHED; PG8_LDA(At, 0, 0); PG8_STAGE(PG8_SA(1, 1), a1 + hstep, voffA);
            PG8_WAIT_L(8); PG8_BAR; PG8_WAIT_L(0); PG8_MMA(0, 0, At, B0); PG8_BAR; PG8_SCHED;
            PG8_LDB(B1, 0, 1); PG8_STAGE(PG8_SB(0, 0), b2, voffB);
            PG8_BAR; PG8_WAIT_L(0); PG8_MMA(0, 1, At, B1); PG8_BAR;
            PG8_LDA(At, 0, 1); PG8_STAGE(PG8_SA(0, 0), a2, voffA);
            PG8_BAR; PG8_WAIT_L(0); PG8_MMA(1, 0, At, B0); PG8_BAR; PG8_SCHED;
            PG8_STAGE(PG8_SB(0, 1), b2 + hstep, voffB);
            PG8_WAIT_V(6); PG8_BAR; PG8_MMA(1, 1, At, B1); PG8_BAR;
            PG8_LDB(B0, 1, 0); PG8_SCHED; PG8_LDA(At, 1, 0); PG8_STAGE(PG8_SA(0, 1), a2 + hstep, voffA);
            PG8_WAIT_L(8); PG8_BAR; PG8_WAIT_L(0); PG8_MMA(0, 0, At, B0); PG8_BAR; PG8_SCHED;
            PG8_LDB(B1, 1, 1); PG8_STAGE(PG8_SB(1, 0), b3, voffB);
            PG8_BAR; PG8_WAIT_L(0); PG8_MMA(0, 1, At, B1); PG8_BAR;
            PG8_LDA(At, 1, 1); PG8_STAGE(PG8_SA(1, 0), a3, voffA);
            PG8_BAR; PG8_WAIT_L(0); PG8_MMA(1, 0, At, B0); PG8_BAR; PG8_SCHED;
            PG8_STAGE(PG8_SB(1, 1), b3 + hstep, voffB);
            PG8_WAIT_V(6); PG8_BAR; PG8_MMA(1, 1, At, B1); PG8_BAR;
            }
        }
        if constexpr (ALIGN_EPI) { if (wr == 0) PG8_BAR; }
        if constexpr (!Epi::AFTER_DRAIN) { E(acc, cur, wr, wc, fr, fq); S.done(cur); }
        if (!has_next) break;
#pragma unroll
        for (int a = 0; a < 2; ++a)
#pragma unroll
            for (int b = 0; b < 2; ++b)
#pragma unroll
                for (int m = 0; m < 4; ++m)
#pragma unroll
                    for (int n = 0; n < 2; ++n) acc[a][b][m][n] = (f32x4){0.f, 0.f, 0.f, 0.f};
        cur = nxt; cA = nA; cB = nB; ++ui;
        if constexpr (ALIGN_EPI) { if (wr == 1) PG8_BAR; }
    }
    PG8_WAIT_V(0);
    if constexpr (!ALIGN_EPI) { if (wr == 0) PG8_BAR; }
    PG8_BAR;
    if constexpr (Epi::AFTER_DRAIN) { E.fused(acc, cur, wr, wc, fr, fq, lds, wid, lane); S.done(cur); }
#undef PG8_SA
#undef PG8_SB
#undef PG8_STAGE
#undef PG8_LDA
#undef PG8_LDB
#undef PG8_MMA
#undef PG8_WAIT_V
#undef PG8_WAIT_L
#undef PG8_BAR
#undef PG8_SCHED
}
}
namespace att {
constexpr int LD = INW, KVBLK = 64;
constexpr size_t SHM_V = KVBLK * 128 * 2, SHM_K = KVBLK * 128 * 2;
constexpr float THR2 = 8.f * L2E;
#define KSWZ(row, colB) ((row) * 256 + ((colB) ^ (((row) & 7) << 4)))
#define SBAR() __builtin_amdgcn_sched_barrier(0)
__device__ __forceinline__ int crow(int r, int hi) { return (r & 3) + 8 * (r >> 2) + 4 * hi; }
__device__ __forceinline__ void partialSM(f32x16& p0, f32x16& p1, float& m_reg, float& mn, float& alpha, float dqs, float sl2) {
  constexpr float C = 0.125f * L2E;
#pragma unroll
  for (int r = 0; r < 16; ++r) { const float k0 = (float)((r & 3) + 8 * (r >> 2));
    p0[r] = fmaf(p0[r], C, -fabsf(fmaf(sl2, -k0, dqs))); p1[r] = fmaf(p1[r], C, -fabsf(fmaf(sl2, -(k0 + 32.f), dqs))); }
  float pmax = p0[0];
#pragma unroll
  for (int r = 1; r < 16; ++r) pmax = fmaxf(pmax, p0[r]);
#pragma unroll
  for (int r = 0; r < 16; ++r) pmax = fmaxf(pmax, p1[r]);
  { auto rr = __builtin_amdgcn_permlane32_swap(__float_as_uint(pmax), __float_as_uint(pmax), false, false);
    pmax = fmaxf(__uint_as_float(rr[0]), __uint_as_float(rr[1])); }
  if (__builtin_expect(__all(pmax - m_reg <= THR2), 1)) { mn = m_reg; alpha = 1.f; }
  else { mn = fmaxf(m_reg, pmax); alpha = __builtin_amdgcn_exp2f(m_reg - mn); m_reg = mn; }
#pragma unroll
  for (int r = 0; r < 16; ++r) { p0[r] -= mn; p1[r] -= mn; }
#pragma unroll
  for (int r = 0; r < 16; ++r) p0[r] = __builtin_amdgcn_exp2f(p0[r]);
}
__device__ __forceinline__ void partialSM1(f32x16& p0, f32x16& p1, float& m_reg, float& mn, float& alpha, float dqs, float sl2, int side) {
  constexpr float C = 0.125f * L2E;
  const float sg = side > 0 ? -sl2 : sl2, D0 = side > 0 ? (m_reg + dqs) : (m_reg - dqs);
  const f32x2 sg2 = {sg, sg}, C2 = {C, C}, Da = {D0, D0}, Db = {fmaf(sg, 32.f, D0), fmaf(sg, 32.f, D0)};
#pragma unroll
  for (int r = 0; r < 16; r += 2) {
    const f32x2 kk = {(float)((r & 3) + 8 * (r >> 2)), (float)(((r + 1) & 3) + 8 * ((r + 1) >> 2))};
    const f32x2 b0 = __builtin_elementwise_fma(sg2, kk, Da), b1 = __builtin_elementwise_fma(sg2, kk, Db);
    const f32x2 x0 = __builtin_elementwise_fma((f32x2){p0[r], p0[r + 1]}, C2, -b0), x1 = __builtin_elementwise_fma((f32x2){p1[r], p1[r + 1]}, C2, -b1);
    p0[r] = x0[0]; p0[r + 1] = x0[1]; p1[r] = x1[0]; p1[r + 1] = x1[1]; }
  float pmax = p0[0];
#pragma unroll
  for (int r = 1; r < 16; ++r) pmax = fmaxf(pmax, p0[r]);
#pragma unroll
  for (int r = 0; r < 16; ++r) pmax = fmaxf(pmax, p1[r]);
  { auto rr = __builtin_amdgcn_permlane32_swap(__float_as_uint(pmax), __float_as_uint(pmax), false, false);
    pmax = fmaxf(__uint_as_float(rr[0]), __uint_as_float(rr[1])); }
  if (__builtin_expect(__all(pmax <= THR2), 1)) { mn = m_reg; alpha = 1.f; }
  else { const float pm = fmaxf(pmax, 0.f); mn = m_reg + pm; alpha = __builtin_amdgcn_exp2f(-pm); m_reg = mn;
#pragma unroll
    for (int r = 0; r < 16; ++r) { p0[r] -= pm; p1[r] -= pm; } }
#pragma unroll
  for (int r = 0; r < 16; ++r) p0[r] = __builtin_amdgcn_exp2f(p0[r]);
}
__device__ __forceinline__ void finishSM(f32x16& p0, f32x16& p1, float alpha, float& l_reg, bf16x8& pa0, bf16x8& pa1, bf16x8& pa2, bf16x8& pa3) {
#pragma unroll
  for (int r = 0; r < 16; ++r) p1[r] = __builtin_amdgcn_exp2f(p1[r]);
  f32x2 ps2 = {0.f, 0.f};
#pragma unroll
  for (int r = 0; r < 16; r += 2) ps2 += (f32x2){p0[r], p0[r + 1]};
#pragma unroll
  for (int r = 0; r < 16; r += 2) ps2 += (f32x2){p1[r], p1[r + 1]};
  float ps = ps2[0] + ps2[1];
  { auto rr = __builtin_amdgcn_permlane32_swap(__float_as_uint(ps), __float_as_uint(ps), false, false);
    ps = __uint_as_float(rr[0]) + __uint_as_float(rr[1]); }
  l_reg = l_reg * alpha + ps;
#define PK4(P, BASE, OUT) do { unsigned a0 = cvtpk(P[BASE + 0], P[BASE + 1]), a1 = cvtpk(P[BASE + 2], P[BASE + 3]);   \
    unsigned b0 = cvtpk(P[BASE + 4], P[BASE + 5]), b1 = cvtpk(P[BASE + 6], P[BASE + 7]);                              \
    auto r0 = __builtin_amdgcn_permlane32_swap(a0, b0, false, false); auto r1 = __builtin_amdgcn_permlane32_swap(a1, b1, false, false); \
    u32x4 w = {r0[0], r1[0], r0[1], r1[1]}; OUT = __builtin_bit_cast(bf16x8, w); } while (0)
  PK4(p0, 0, pa0); PK4(p0, 8, pa1); PK4(p1, 0, pa2); PK4(p1, 8, pa3);
#undef PK4
}
__device__ __forceinline__ void qkt(f32x16& p0, f32x16& p1, const char* Ks, const bf16x8* qr, int r32, int hi, int c) {
  p0 = f32x16{}; p1 = f32x16{};
#pragma unroll
  for (int d0 = 0; d0 < 4; ++d0) { const int cb = (c * 64 + d0 * 16 + hi * 8) * 2;
    bf16x8 b0 = *reinterpret_cast<const bf16x8*>(Ks + KSWZ(r32, cb));
    bf16x8 b1 = *reinterpret_cast<const bf16x8*>(Ks + KSWZ(32 + r32, cb));
    p0 = __builtin_amdgcn_mfma_f32_32x32x16_bf16(b0, qr[d0], p0, 0, 0, 0);
    p1 = __builtin_amdgcn_mfma_f32_32x32x16_bf16(b1, qr[d0], p1, 0, 0, 0); }
}
__device__ __forceinline__ int v_st(int k, int c) { const int kk = (k & ~0xC) | ((k & 4) << 1) | ((k & 8) >> 1); return ((kk >> 3) * 4 + (c >> 5)) * 512 + ((kk & 7) * 32 + (c & 31)) * 2; }
__device__ __forceinline__ int v_rd_base(int lane) { return ((lane & 3) << 3) | (((lane >> 2) & 3) << 6) | (((lane >> 4) & 1) << 5) | (((lane >> 5) & 1) << 8); }
constexpr int v_rd_off(int d0, int ks, int half) { return d0 * 512 + ks * 4096 + half * 2048; }
template <int OFF> __device__ __forceinline__ s16x4 tr_read(int vb) {
  s16x4 r; asm volatile("ds_read_b64_tr_b16 %0, %1 offset:%2" : "=&v"(r) : "v"(vb), "i"(OFF) : "memory"); return r;
}
template <int D0> __device__ __forceinline__ void pv_one(f32x16& od, int vb, bf16x8 pa0, bf16x8 pa1, bf16x8 pa2, bf16x8 pa3) {
  const s16x4 l0 = tr_read<v_rd_off(D0, 0, 0)>(vb), h0 = tr_read<v_rd_off(D0, 0, 1)>(vb), l1 = tr_read<v_rd_off(D0, 1, 0)>(vb), h1 = tr_read<v_rd_off(D0, 1, 1)>(vb);
  const s16x4 l2 = tr_read<v_rd_off(D0, 2, 0)>(vb), h2 = tr_read<v_rd_off(D0, 2, 1)>(vb), l3 = tr_read<v_rd_off(D0, 3, 0)>(vb), h3 = tr_read<v_rd_off(D0, 3, 1)>(vb);
  asm volatile("s_waitcnt lgkmcnt(0)" ::: "memory"); SBAR();
#define PK(L, H) (bf16x8){L[0], L[1], L[2], L[3], H[0], H[1], H[2], H[3]}
  od = __builtin_amdgcn_mfma_f32_32x32x16_bf16(pa0, PK(l0, h0), od, 0, 0, 0);
  od = __builtin_amdgcn_mfma_f32_32x32x16_bf16(pa1, PK(l1, h1), od, 0, 0, 0);
  od = __builtin_amdgcn_mfma_f32_32x32x16_bf16(pa2, PK(l2, h2), od, 0, 0, 0);
  od = __builtin_amdgcn_mfma_f32_32x32x16_bf16(pa3, PK(l3, h3), od, 0, 0, 0);
#undef PK
}
__device__ __forceinline__ void pv_d0(f32x16* o, int vb, bf16x8 pa0, bf16x8 pa1, bf16x8 pa2, bf16x8 pa3) {
  pv_one<0>(o[0], vb, pa0, pa1, pa2, pa3); pv_one<1>(o[1], vb, pa0, pa1, pa2, pa3); pv_one<2>(o[2], vb, pa0, pa1, pa2, pa3); pv_one<3>(o[3], vb, pa0, pa1, pa2, pa3);
}
__device__ __forceinline__ void pv_sm1(f32x16* o, int vb, bf16x8 pa0, bf16x8 pa1, bf16x8 pa2, bf16x8 pa3, f32x16& p0, f32x16& p1, float& m_reg, float& mn, float& alpha, float dqs, float sl2, int side) {
  constexpr float C = 0.125f * L2E;
  const float sg = side > 0 ? -sl2 : sl2, D0 = side > 0 ? (m_reg + dqs) : (m_reg - dqs);
  const f32x2 sg2 = {sg, sg}, C2 = {C, C}, Da = {D0, D0}, Db = {fmaf(sg, 32.f, D0), fmaf(sg, 32.f, D0)};
  pv_one<0>(o[0], vb, pa0, pa1, pa2, pa3);
#pragma unroll
  for (int r = 0; r < 16; r += 2) { const f32x2 kk = {(float)((r & 3) + 8 * (r >> 2)), (float)(((r + 1) & 3) + 8 * ((r + 1) >> 2))};
    const f32x2 x0 = __builtin_elementwise_fma((f32x2){p0[r], p0[r + 1]}, C2, -__builtin_elementwise_fma(sg2, kk, Da)); p0[r] = x0[0]; p0[r + 1] = x0[1]; }
  pv_one<1>(o[1], vb, pa0, pa1, pa2, pa3);
#pragma unroll
  for (int r = 0; r < 16; r += 2) { const f32x2 kk = {(float)((r & 3) + 8 * (r >> 2)), (float)(((r + 1) & 3) + 8 * ((r + 1) >> 2))};
    const f32x2 x1 = __builtin_elementwise_fma((f32x2){p1[r], p1[r + 1]}, C2, -__builtin_elementwise_fma(sg2, kk, Db)); p1[r] = x1[0]; p1[r + 1] = x1[1]; }
  pv_one<2>(o[2], vb, pa0, pa1, pa2, pa3);
  float pmax = p0[0];
#pragma unroll
  for (int r = 1; r < 16; ++r) pmax = fmaxf(pmax, p0[r]);
#pragma unroll
  for (int r = 0; r < 16; ++r) pmax = fmaxf(pmax, p1[r]);
  { auto rr = __builtin_amdgcn_permlane32_swap(__float_as_uint(pmax), __float_as_uint(pmax), false, false);
    pmax = fmaxf(__uint_as_float(rr[0]), __uint_as_float(rr[1])); }
  if (__builtin_expect(__all(pmax <= THR2), 1)) { mn = m_reg; alpha = 1.f; }
  else { const float pm = fmaxf(pmax, 0.f); mn = m_reg + pm; alpha = __builtin_amdgcn_exp2f(-pm); m_reg = mn;
#pragma unroll
    for (int r = 0; r < 16; ++r) { p0[r] -= pm; p1[r] -= pm; } }
  pv_one<3>(o[3], vb, pa0, pa1, pa2, pa3);
#pragma unroll
  for (int r = 0; r < 16; ++r) p0[r] = __builtin_amdgcn_exp2f(p0[r]);
}
constexpr int XS = 132;

__device__ __forceinline__ void attn_unit(int unit, const bf16_t* __restrict__ proj, bf16_t* __restrict__ mix, const float* __restrict__ subln_g, float lam, char* lds) {
  const int b = unit >> 6, h = (unit >> 4) & 3, qb = unit & 15;
  int tid_l = threadIdx.x; asm volatile("" : "+v"(tid_l));
  const int tid = tid_l, wid = tid >> 6, lane = tid & 63, r32 = lane & 31, hi = lane >> 5, c = wid >> 2, wq = wid & 3;
  const int q0 = qb * 128;
  const bf16_t* Qb = proj + (size_t)(b * SEQ + q0) * LD + h * 128 + c * 64;
  const bf16_t* Kh = proj + (size_t)(b * SEQ) * LD + 512 + h * 128;
  const bf16_t* Vh = proj + (size_t)(b * SEQ) * LD + 1024 + h * 128;
  char* V_lds = lds; char* K_lds = lds + 3 * SHM_V;
  float* ws = (float*)(lds + 3 * SHM_V + 3 * SHM_K) + wid * 64; float* li_l = ws; float* al_l = ws + 32;
  float m_reg = -1e30f, l_reg = 0; f32x16 o[4] = {}; bf16x8 qr[4];
  const bf16_t* Qw = Qb + (size_t)(wq * 32 + r32) * LD + hi * 8;
#pragma unroll
  for (int d0 = 0; d0 < 4; ++d0) qr[d0] = *reinterpret_cast<const bf16x8*>(Qw + d0 * 16);
  const float sl2 = __builtin_amdgcn_exp2f(-2.f * (float)(h + 1)) * L2E;
  float dqs = sl2 * (float)(q0 + wq * 32 + r32 - 4 * hi);
  const int sr = tid >> 4, sc = (tid & 15) * 8, vst0 = v_st(sr, sc), vst1 = v_st(32 + sr, sc);
  const int vb0 = (int)(uintptr_t)V_lds + v_rd_base(lane);
  struct { bf16x8 vs0, vs1, ks0, ks1; } sr_[1];
#define SLOAD(i, k0) do { sr_[i].vs0 = *(const bf16x8*)(&Vh[(size_t)((k0) + sr) * LD + sc]); sr_[i].vs1 = *(const bf16x8*)(&Vh[(size_t)((k0) + 32 + sr) * LD + sc]); \
    sr_[i].ks0 = *(const bf16x8*)(&Kh[(size_t)((k0) + sr) * LD + sc]); sr_[i].ks1 = *(const bf16x8*)(&Kh[(size_t)((k0) + 32 + sr) * LD + sc]); } while (0)
#define SWRITE(bb, i) do { *(bf16x8*)(V_lds + (bb) * SHM_V + vst0) = sr_[i].vs0;          \
    *(bf16x8*)(V_lds + (bb) * SHM_V + vst1) = sr_[i].vs1; int kc = sc * 2;               \
    *(bf16x8*)(K_lds + (bb) * SHM_K + KSWZ(sr, kc)) = sr_[i].ks0;                       \
    *(bf16x8*)(K_lds + (bb) * SHM_K + KSWZ(32 + sr, kc)) = sr_[i].ks1; } while (0)
#define SWAIT() asm volatile("s_waitcnt vmcnt(0)" ::: "memory")
#define RESC(a) do { if (__any((a) < 1.f)) { if (hi == 0) al_l[r32] = (a); asm volatile("s_waitcnt lgkmcnt(0)" ::: "memory"); \
    _Pragma("unroll") for (int d = 0; d < 4; ++d) _Pragma("unroll") for (int r = 0; r < 16; ++r) o[d][r] *= al_l[crow(r, hi)]; } } while (0)
  f32x16 pA0, pA1, pB0, pB1; float mnA, mnB, alA, alB; bf16x8 pa0, pa1, pa2, pa3; constexpr int NT = SEQ / KVBLK;
  const int jd = 2 * qb; const float dq0 = dqs;
#define TK(j) ((((j) + jd) & (NT - 1)) * KVBLK)
#define DQS(j) fmaf(-sl2, (float)TK(j), dq0)
  SLOAD(0, TK(0)); asm volatile("s_waitcnt vmcnt(0)" ::: "memory"); SWRITE(0, 0);
  SLOAD(0, TK(1)); asm volatile("s_waitcnt vmcnt(0)" ::: "memory"); SWRITE(1, 0); __syncthreads();
  qkt(pA0, pA1, K_lds, qr, r32, hi, c); partialSM(pA0, pA1, m_reg, mnA, alA, DQS(0), sl2);
  const int qw0 = q0 + wq * 32;
  int cb = 0;
#define ATT_STEP(PC0, PC1, ALC, PN0, PN1, MNN, ALN, J) do { const int nb_ = (cb == 2) ? 0 : cb + 1, wb_ = (nb_ == 2) ? 0 : nb_ + 1; \
    SBAR(); qkt(PN0, PN1, K_lds + nb_ * SHM_K, qr, r32, hi, c); \
    finishSM(PC0, PC1, ALC, l_reg, pa0, pa1, pa2, pa3); SBAR(); \
    if ((J) + 2 < NT) SLOAD(0, TK((J) + 2)); SBAR(); \
    { const int kn_ = TK((J) + 1); const float dqs = DQS((J) + 1); const int side_ = (kn_ + KVBLK - 1 < qw0) ? 1 : ((kn_ > qw0 + 31) ? -1 : 0); \
      if (side_ != 0) pv_sm1(o, vb0 + cb * (int)SHM_V, pa0, pa1, pa2, pa3, PN0, PN1, m_reg, MNN, ALN, dqs, sl2, side_); \
      else { pv_d0(o, vb0 + cb * (int)SHM_V, pa0, pa1, pa2, pa3); partialSM(PN0, PN1, m_reg, MNN, ALN, dqs, sl2); } } \
    if ((J) + 2 < NT) { SWAIT(); SWRITE(wb_, 0); } \
    RESC(ALN); __syncthreads(); cb = nb_; } while (0)
  for (int j = 0; j + 2 < NT; j += 2) {
    ATT_STEP(pA0, pA1, alA, pB0, pB1, mnB, alB, j);
    ATT_STEP(pB0, pB1, alB, pA0, pA1, mnA, alA, j + 1);
  }
  ATT_STEP(pA0, pA1, alA, pB0, pB1, mnB, alB, NT - 2);
  finishSM(pB0, pB1, alB, l_reg, pa0, pa1, pa2, pa3); SBAR();
  pv_d0(o, vb0 + cb * (int)SHM_V, pa0, pa1, pa2, pa3);
#undef ATT_STEP
#undef TK
#undef DQS
  if (hi == 0) li_l[r32] = l_reg; asm volatile("s_waitcnt lgkmcnt(0)" ::: "memory");
  float rli[16];
#pragma unroll
  for (int r = 0; r < 16; ++r) rli[r] = __builtin_amdgcn_rcpf(li_l[crow(r, hi)]);
  asm volatile("s_waitcnt vmcnt(0)" ::: "memory");
  __syncthreads();
  float* X = (float*)lds + c * (128 * XS);
#pragma unroll
  for (int r = 0; r < 16; ++r) { const int orow = wq * 32 + crow(r, hi);
#pragma unroll
    for (int d0 = 0; d0 < 4; ++d0) X[orow * XS + d0 * 32 + r32] = o[d0][r] * rli[r]; }
  __syncthreads();
  { const int row = tid >> 2, q = tid & 3; const float* X1 = (const float*)lds + row * XS + q * 32; const float* X2 = X1 + 128 * XS;
    f32x4 v[8]; float ss = 0.f;
#pragma unroll
    for (int i = 0; i < 8; ++i) { const int ii = (i + 4 * (q >> 1)) & 7; const f32x4 a = *(const f32x4*)(X1 + 4 * ii), bb = *(const f32x4*)(X2 + 4 * ii);
      v[i] = a - lam * bb; ss += (v[i][0] * v[i][0] + v[i][1] * v[i][1]) + (v[i][2] * v[i][2] + v[i][3] * v[i][3]); }
    ss += __shfl_xor(ss, 1); ss += __shfl_xor(ss, 2);
    const float rn = __builtin_amdgcn_rsqf(ss * (1.f / 128.f) + EPS) * 0.8f * EXP_ATTSCALE;
    bf16_t* orow = mix + (size_t)(b * SEQ + q0 + row) * DM + h * 128 + q * 32;
#pragma unroll
    for (int i = 0; i < 8; i += 2) { const int i0 = (i + 4 * (q >> 1)) & 7;
      const f32x4 g0 = *(const f32x4*)(subln_g + q * 32 + 4 * i0), g1 = *(const f32x4*)(subln_g + q * 32 + 4 * i0 + 4);
      const f32x4 a = v[i] * rn * g0, bb = v[i + 1] * rn * g1;
      u32x4 w = {cvtpk(a[0], a[1]), cvtpk(a[2], a[3]), cvtpk(bb[0], bb[1]), cvtpk(bb[2], bb[3])};
      *(u32x4*)(orow + 4 * i0) = w; } }
  __syncthreads();
#undef SLOAD
#undef SWRITE
#undef SWAIT
#undef RESC
}
}
namespace lru {
__device__ __forceinline__ int crow(int r, int hi) { return (r & 3) + 8 * (r >> 2) + 4 * hi; }
__device__ __forceinline__ f32x8 lds_ld8(const LAS float* p) { const f32x4 a = *(const LAS f32x4*)p, b = *(const LAS f32x4*)(p + 4); return (f32x8){a[0], a[1], a[2], a[3], b[0], b[1], b[2], b[3]}; }
__device__ __forceinline__ void lds_st8(LAS float* p, f32x8 v) { *(LAS f32x4*)p = (f32x4){v[0], v[1], v[2], v[3]}; *(LAS f32x4*)(p + 4) = (f32x4){v[4], v[5], v[6], v[7]}; }
struct Params { const bf16_t* proj; float* ys; bf16_t* mix; unsigned* pair_cnt; const float *conv_w, *conv_b, *w_a, *b_a, *w_x, *b_x, *lambda; };
__device__ __forceinline__ void lru_item(int item, const Params& p, LAS unsigned char* lds) {
  int tid_l = threadIdx.x; asm volatile("" : "+v"(tid_l));
  const int tid = tid_l, wid = __builtin_amdgcn_readfirstlane(tid >> 6), lane = tid & 63, r32 = lane & 31, hi = lane >> 5;
  const int dir = item & 1, seg = wid, b = item >> 4, n = (item >> 1) & 7;
  LAS float* xcu = (LAS float*)(lds + wid * 16896);
  LAS float* abuf = (LAS float*)(lds + wid * 16896 + 8704);
  LAS float* tot = (LAS float*)(lds + LDS_TOT);
  LAS float* cwl = (LAS float*)(lds + LDS_CW);
  if (tid < 320) { const int k = tid >> 6, ch = tid & 63; cwl[tid] = (k < 4) ? p.conv_w[k * 512 + 64 * n + ch] : p.conv_b[64 * n + ch]; }
  bf16x8 Bf[2][2][4];
#pragma unroll
  for (int g = 0; g < 2; ++g) { const float* W = (g == 0 ? p.w_a : p.w_x) + (size_t)((dir * 8 + n) * 64) * 64;
#pragma unroll
    for (int nb = 0; nb < 2; ++nb)
#pragma unroll
      for (int s = 0; s < 4; ++s) { f32x8 w;
#pragma unroll
        for (int j = 0; j < 8; ++j) w[j] = W[(16 * s + 8 * hi + j) * 64 + 32 * nb + r32];
        Bf[g][nb][s] = pack8(w); } }
  float ba[2], bx[2], cl2[2];
#pragma unroll
  for (int nb = 0; nb < 2; ++nb) { const int ch = dir * 512 + 64 * n + 32 * nb + r32; ba[nb] = p.b_a[ch]; bx[nb] = p.b_x[ch];
    const float lam = p.lambda[ch]; const float sp = (lam > 15.f) ? __expf(-lam) : log1pf(__expf(-lam));
    cl2[nb] = 8.f * sp * L2E; }
  float hc = 0.f;
  __syncthreads();
  const bf16_t* xr_base = p.proj + (size_t)(b * SEQ) * INW + 1536 + 64 * n;
  float* ybase = p.ys + (size_t)dir * T_ * 512 + (size_t)(b * SEQ) * 512 + 64 * n;
  u32x4 pre[5];
#define LRU_LOAD_RAW(T0) do { _Pragma("unroll") for (int i = 0; i < 5; ++i) { const int row = i * 8 + (lane >> 3), tt = (T0) - 2 + row; pre[i] = (u32x4){0u, 0u, 0u, 0u}; \
      if (row < 35 && tt >= 0 && tt < SEQ) pre[i] = *(const u32x4*)(xr_base + (size_t)tt * INW + (lane & 7) * 8); } } while (0)
  LRU_LOAD_RAW((dir ? 7 : 0) * 256 + seg * 32);
  for (int it = 0; it < 8; ++it) {
    const int tile = dir ? 7 - it : it, t0 = tile * 256 + seg * 32;
    { LAS unsigned char* raw = (LAS unsigned char*)abuf;
#pragma unroll
      for (int i = 0; i < 5; ++i) { const int row = i * 8 + (lane >> 3); if (row < 35) *(LAS u32x4*)(raw + row * 144 + (lane & 7) * 16) = pre[i]; }
      if (it < 7) LRU_LOAD_RAW((dir ? 6 - it : it + 1) * 256 + seg * 32);
#pragma unroll
      for (int cc = 0; cc < 4; ++cc) { const int ch0 = 32 * hi + 8 * cc;
        f32x8 acc = lds_ld8(cwl + 4 * 64 + ch0);
#pragma unroll
        for (int k = 0; k < 4; ++k) { const bf16x8 v = *(LAS const bf16x8*)(raw + (r32 + k) * 144 + ch0 * 2); const f32x8 w = lds_ld8(cwl + k * 64 + ch0);
#pragma unroll
          for (int j = 0; j < 8; ++j) acc[j] += w[j] * bf2f(v[j]); }
        lds_st8(xcu + r32 * 68 + ch0, acc); } }
    bf16x8 af[4];
#pragma unroll
    for (int s = 0; s < 4; ++s) af[s] = pack8(lds_ld8(xcu + r32 * 68 + 16 * s + 8 * hi));
#pragma unroll
    for (int nb = 0; nb < 2; ++nb) {
      f32x16 acca = {}, accx = {};
#pragma unroll
      for (int s = 0; s < 4; ++s) { acca = __builtin_amdgcn_mfma_f32_32x32x16_bf16(af[s], Bf[0][nb][s], acca, 0, 0, 0); accx = __builtin_amdgcn_mfma_f32_32x32x16_bf16(af[s], Bf[1][nb][s], accx, 0, 0, 0); }
#pragma unroll
      for (int rg = 0; rg < 16; ++rg) { const int tk = crow(rg, hi), ch = 32 * nb + r32;
        const float xc = xcu[tk * 68 + ch];
        const float ga = acca[rg] + ba[nb], gx = accx[rg] + bx[nb];
        const float r = __builtin_amdgcn_rcpf(1.f + __builtin_amdgcn_exp2f(-ga * L2E)), ii = __builtin_amdgcn_rcpf(1.f + __builtin_amdgcn_exp2f(-gx * L2E));
        const float a = __builtin_amdgcn_exp2f(-cl2[nb] * r);
        const float u = __builtin_amdgcn_sqrtf(fmaxf(fmaf(-a, a, 1.f), 0.f)) * ii * xc;
        abuf[tk * 64 + ch] = a; xcu[tk * 68 + ch] = u; }
    }
    { float P = 1.f, H = 0.f;
#pragma unroll 8
      for (int j = 0; j < 32; ++j) { const int tk = dir ? 31 - j : j; const float a = abuf[tk * 64 + lane], u = xcu[tk * 68 + lane];
        H = a * H + u; P *= a; abuf[tk * 64 + lane] = P; xcu[tk * 68 + lane] = H; }
      LAS float* tt = tot + (((it & 1) * 8 + seg) * 128);
      tt[lane] = P; tt[64 + lane] = H; }
    __syncthreads();
    float cin = hc;
    { float c = hc;
#pragma unroll
      for (int j = 0; j < 8; ++j) { const int sg = dir ? 7 - j : j; const LAS float* tt = tot + (((it & 1) * 8 + sg) * 128);
        const float Pj = tt[lane], Hj = tt[64 + lane]; if (sg == seg) cin = c; c = Pj * c + Hj; }
      hc = c; }
#pragma unroll 8
    for (int tk = 0; tk < 32; ++tk) __hip_atomic_store(ybase + (size_t)(t0 + tk) * 512 + lane, xcu[tk * 68 + lane] + abuf[tk * 64 + lane] * cin, __ATOMIC_RELAXED, __HIP_MEMORY_SCOPE_AGENT);
  }
  asm volatile("s_waitcnt vmcnt(0)" ::: "memory"); __syncthreads();
  volatile LAS unsigned* misc = (volatile LAS unsigned*)(lds + LDS_MISC);
  if (tid == 0) misc[1] = __hip_atomic_fetch_add(p.pair_cnt + (b * 8 + n), 1u, __ATOMIC_RELAXED, __HIP_MEMORY_SCOPE_AGENT);
  __syncthreads();
  const unsigned arrived = misc[1];
  if (arrived == 1u) {
    __builtin_amdgcn_fence(__ATOMIC_ACQUIRE, "agent");
    const float* yf = p.ys + (size_t)(b * SEQ) * 512 + 64 * n; const float* yb = yf + (size_t)T_ * 512;
    const bf16_t* gr = p.proj + (size_t)(b * SEQ) * INW + 2048 + 64 * n; bf16_t* mo = p.mix + (size_t)(b * SEQ) * DM + 512 + 64 * n;
#pragma unroll 8
    for (int idx = tid; idx < SEQ * 8; idx += 512) { const int t = idx >> 3, c8 = (idx & 7) * 8;
      const f32x8 a = *(const f32x8*)(yf + (size_t)t * 512 + c8), bb = *(const f32x8*)(yb + (size_t)t * 512 + c8); const bf16x8 g = *(const bf16x8*)(gr + (size_t)t * INW + c8);
      f32x8 o;
#pragma unroll
      for (int j = 0; j < 8; ++j) o[j] = gelu_tanh(bf2f(g[j])) * (a[j] + bb[j]) * EXP_LRUSCALE;
      *(bf16x8*)(mo + (size_t)t * DM + c8) = pack8(o); } }
  __syncthreads();
}
#undef LRU_LOAD_RAW
}
template <bool UPMAP>
__device__ __forceinline__ void p0_transpose_item(const float* __restrict__ W, int K, int N, bf16_t* WT, const float* __restrict__ kscale, LAS float* scr, int item, int lane) {
    const int nblk = N / 32, kb = item / nblk, nb = item % nblk, k0 = 64 * kb, n0 = 32 * nb;
#pragma unroll
    for (int i = 0; i < 32; ++i) { const int kk = 2 * i + (lane >> 5); float w = W[(size_t)(k0 + kk) * N + n0 + (lane & 31)]; if (kscale) w *= kscale[k0 + kk]; scr[kk * 33 + (lane & 31)] = w; }
    asm volatile("s_waitcnt lgkmcnt(0)" ::: "memory");
    const int c = lane & 7;
#pragma unroll
    for (int j = 0; j < 4; ++j) { const int n = (lane >> 3) + 8 * j; const LAS float* s = scr + (8 * c) * 33 + n;
        u32x4 o; o.x = cvtpk(s[0 * 33], s[1 * 33]); o.y = cvtpk(s[2 * 33], s[3 * 33]); o.z = cvtpk(s[4 * 33], s[5 * 33]); o.w = cvtpk(s[6 * 33], s[7 * 33]);
        int row = n0 + n;
        if (UPMAP) { const int f = row < FF ? row : row - FF; row = (f >> 7) * 256 + (row < FF ? 0 : 128) + (f & 127); }
        *(u32x4*)(WT + (size_t)row * K + k0 + 8 * c) = o; }
    asm volatile("s_waitcnt lgkmcnt(0)" ::: "memory");
}

#define XB_TMO      128
#define XB_XCNT(j)  (256  + 64 * (j))
#define XB_XSUB(j)  (1280 + 64 * (j))
#define XB_XGEN(j)  (2304 + 64 * (j))
#define XB_TOP      3328
#define XB_TOPGEN   3392
#define XCD_BAR_WORDS 3456
#define XB_SPIN_CAP (1u << 18)

__device__ __forceinline__ unsigned xb_ld(unsigned* p)              { return __hip_atomic_load(p, __ATOMIC_RELAXED, __HIP_MEMORY_SCOPE_AGENT); }
__device__ __forceinline__ unsigned xb_add(unsigned* p, unsigned v) { return __hip_atomic_fetch_add(p, v, __ATOMIC_RELAXED, __HIP_MEMORY_SCOPE_AGENT); }
__device__ __forceinline__ unsigned xb_xcc_id() { return (unsigned)__builtin_amdgcn_s_getreg((3 << 11) | 20) & 0xFu; }
#define XB_SPIN(cond, bar) do { unsigned _sp = 0; while (cond) { __builtin_amdgcn_s_sleep(1); \
    if ((++_sp & 255u) == 0u) { if (xb_ld(&(bar)[XB_TMO])) break; if (_sp > XB_SPIN_CAP) { atomicAdd(&(bar)[XB_TMO], 1u); break; } } } } while (0)

struct XcdBarrier {
    unsigned* bar; unsigned x;
    volatile LAS unsigned* st;
};

__device__ __forceinline__ XcdBarrier xcd_barrier_post(unsigned* bar, volatile LAS unsigned* st) {
    XcdBarrier b; b.bar = bar; b.x = xb_xcc_id(); b.st = st;
    if (threadIdx.x == 0) (void)xb_add(&bar[XB_XCNT(b.x)], 1u);
    return b;
}
__device__ __forceinline__ void xcd_barrier_complete(unsigned* bar, unsigned x, unsigned& nloc, unsigned& nx) {
    const unsigned G = gridDim.x * gridDim.y * gridDim.z;
    unsigned sum, cnt, mine, sp = 0u;
    for (;;) {
        sum = 0u; cnt = 0u; mine = 0u;
#pragma unroll
        for (unsigned j = 0; j < 16; ++j) { const unsigned c = xb_ld(&bar[XB_XCNT(j)]); sum += c; cnt += (c > 0u) ? 1u : 0u; mine = (j == x) ? c : mine; }
        if (sum == G) break;
        __builtin_amdgcn_s_sleep(1);
        if ((++sp & 255u) == 0u) { if (xb_ld(&bar[XB_TMO])) break; if (sp > XB_SPIN_CAP) { atomicAdd(&bar[XB_TMO], 1u); break; } }
    }
    nloc = mine > 0u ? mine : 1u; nx = cnt > 0u ? cnt : 1u;
}

__device__ __forceinline__ void xcd_barrier(const XcdBarrier& b) {
    asm volatile("s_waitcnt vmcnt(0)" ::: "memory");
    __syncthreads();
    if (threadIdx.x == 0) {
        unsigned* bar = b.bar;
        __builtin_amdgcn_s_waitcnt(0);
        unsigned nloc = b.st[0], nx = b.st[1];
        if (nloc == 0u) { xcd_barrier_complete(bar, b.x, nloc, nx); b.st[0] = nloc; b.st[1] = nx; }
        const unsigned old = xb_add(&bar[XB_XSUB(b.x)], 1u);
        const unsigned gen = old / nloc;
        if (old + 1u == (gen + 1u) * nloc) {
            __builtin_amdgcn_fence(__ATOMIC_RELEASE, "agent");
            asm volatile("s_waitcnt vmcnt(0)" ::: "memory");
            const unsigned og = xb_add(&bar[XB_TOP], 1u);
            const unsigned tg = og / nx;
            if (og + 1u == (tg + 1u) * nx) xb_add(&bar[XB_TOPGEN], 1u);
            else XB_SPIN(xb_ld(&bar[XB_TOPGEN]) == tg, bar);
            __builtin_amdgcn_fence(__ATOMIC_ACQUIRE, "agent");
            xb_add(&bar[XB_XGEN(b.x)], 1u);
            asm volatile("s_waitcnt vmcnt(0)" ::: "memory");
        } else {
            XB_SPIN(xb_ld(&bar[XB_XGEN(b.x)]) == gen, bar);
            __builtin_amdgcn_fence(__ATOMIC_ACQUIRE, "agent");
            asm volatile("s_waitcnt vmcnt(0)" ::: "memory");
        }
    }
    __syncthreads();
}

#ifndef PHMASK
#define PHMASK 127
#endif
struct Args { const float* in[22]; float* out; unsigned char* ws; };

__global__ void __launch_bounds__(512, 2) hymba_fwd(Args args) {
    extern __shared__ __attribute__((aligned(16))) unsigned char lds_raw[];
    LAS unsigned char* lds = (LAS unsigned char*)lds_raw;
    cg::grid_group grid = cg::this_grid();
    const int G = gridDim.x, bx = blockIdx.x;
    if (threadIdx.x < 32) ((volatile LAS unsigned*)(lds + LDS_MISC))[threadIdx.x] = 0u;
    __syncthreads();
    unsigned* barw = (unsigned*)(args.ws + WS_BAR);
    unsigned char* ws = args.ws;
    const float* x = args.in[0];
    unsigned* queue = (unsigned*)(ws + WS_QUEUE);
    float* ss1 = (float*)(ws + WS_SS1); float* ss2 = (float*)(ws + WS_SS2); float* rs0 = (float*)(ws + WS_RS0);
    bf16_t* Win_t = (bf16_t*)(ws + WS_WIN); bf16_t* Wout_t = (bf16_t*)(ws + WS_WOUT); bf16_t* Wup_t = (bf16_t*)(ws + WS_WUP); bf16_t* Wdn_t = (bf16_t*)(ws + WS_WDN);
    bf16_t* XB = (bf16_t*)(ws + WS_XB); bf16_t* PROJ = (bf16_t*)(ws + WS_PROJ); bf16_t* MIX = (bf16_t*)(ws + WS_MIX); bf16_t* ACT = (bf16_t*)(ws + WS_ACT);
    float* YS = (float*)(ws + WS_YS);

#if (PHMASK >> 0) & 1
    for (int rep = 0; rep < EXP_REP_P0; ++rep) {
        int tl = threadIdx.x; asm volatile("" : "+v"(tl)); const int tid = tl, lane = tl & 63, wave = __builtin_amdgcn_readfirstlane(tl >> 6);
        const int gw = bx * 8 + wave, NGW = G * 8;
        for (int i = bx * 512 + tid; i < (int)(WS_ZERO_BYTES / 4); i += G * 512) if (i < (int)(WS_RS0 / 4) || i >= (int)(WS_BAR / 4)) ((unsigned*)ws)[i] = 0u;
        LAS float* scr = (LAS float*)(lds + wave * 16384);
        constexpr int I_IN = (DM / 64) * (INW / 32);
        for (int it = gw; it < I_IN; it += NGW) p0_transpose_item<false>(args.in[2], DM, INW, Win_t, args.in[1], scr, it, lane);
        for (int m0 = gw; m0 < T_; m0 += 2 * NGW) {
            const int m1 = m0 + NGW;
            const f32x4* xa = (const f32x4*)(x + (size_t)m0 * DM) + lane; const f32x4* xb2 = (const f32x4*)(x + (size_t)(m1 < T_ ? m1 : m0) * DM) + lane;
            f32x4 va[4], vb[4]; float sa = 0.f, sb = 0.f;
#pragma unroll
            for (int j = 0; j < 4; ++j) { va[j] = xa[64 * j]; vb[j] = xb2[64 * j]; }
#pragma unroll
            for (int j = 0; j < 4; ++j) { sa += (va[j][0] * va[j][0] + va[j][1] * va[j][1]) + (va[j][2] * va[j][2] + va[j][3] * va[j][3]); sb += (vb[j][0] * vb[j][0] + vb[j][1] * vb[j][1]) + (vb[j][2] * vb[j][2] + vb[j][3] * vb[j][3]); }
            sa = wave_sum(sa); sb = wave_sum(sb);
            u32x2* oa = (u32x2*)(XB + (size_t)m0 * DM) + lane;
#pragma unroll
            for (int j = 0; j < 4; ++j) { u32x2 w; w.x = cvtpk(va[j][0], va[j][1]); w.y = cvtpk(va[j][2], va[j][3]); oa[64 * j] = w; }
            if (lane == 0) rs0[m0] = __builtin_amdgcn_rsqf(sa * (1.f / DM) + EPS);
            if (m1 < T_) { u32x2* ob = (u32x2*)(XB + (size_t)m1 * DM) + lane;
#pragma unroll
                for (int j = 0; j < 4; ++j) { u32x2 w; w.x = cvtpk(vb[j][0], vb[j][1]); w.y = cvtpk(vb[j][2], vb[j][3]); ob[64 * j] = w; }
                if (lane == 0) rs0[m1] = __builtin_amdgcn_rsqf(sb * (1.f / DM) + EPS); }
        }
    }
#endif
    grid.sync();
    const XcdBarrier xbar = xcd_barrier_post(barw, (volatile LAS unsigned*)(lds + LDS_MISC) + 8);

    for (int rep = 0; rep < EXP_EXTRA_SYNC; ++rep) xcd_barrier(xbar);
#if (PHMASK >> 1) & 1
    for (int rep = 0; rep < EXP_REP_P1; ++rep) {
        pg8::Gemm g{XB, Win_t, T_, INW, DM, 256}; pg8::StaticOrder S; S.init(T_, INW, G, bx);
        pg8::EpiProj E{PROJ, INW, rs0};
        pg8::gemm_phase<pg8::EpiProj, pg8::StaticOrder, true, true>(lds, g, S, E);
    }
#endif
    xcd_barrier(xbar);

#if (PHMASK >> 2) & 1
    {
        int tl = threadIdx.x; asm volatile("" : "+v"(tl)); const int tid = tl;
        float lam;
        { float d1 = 0.f, d2 = 0.f;
          for (int i = 0; i < 64; ++i) { d1 += args.in[3][i] * args.in[4][i]; d2 += args.in[5][i] * args.in[6][i]; }
          lam = __expf(d1) - __expf(d2) + 0.2f; }
        lru::Params lp{PROJ, YS, MIX, (unsigned*)(ws + WS_LCNT), args.in[8], args.in[9], args.in[10], args.in[11], args.in[12], args.in[13], args.in[14]};
        volatile LAS unsigned* misc = (volatile LAS unsigned*)(lds + LDS_MISC);
#ifndef NO_LRU
        for (int rep = 0; rep < EXP_REP_LRU; ++rep)
        for (;;) {
            if (tid == 0) misc[0] = atomicAdd(queue + rep * 128, 1u);
            __syncthreads();
            const int item = (int)misc[0];
            __syncthreads();
            if (item >= 128) break;
            lru::lru_item(item, lp, lds);
        }
#endif
#ifndef NO_ATT
        for (int rep = 0; rep < EXP_REP_ATT; ++rep)
        for (;;) {
            if (tid == 0) misc[0] = atomicAdd(queue + 64 + rep * 128, 1u);
            __syncthreads();
            const int item = (int)misc[0];
            __syncthreads();
            if (item >= 512) break;
            att::attn_unit(item, PROJ, MIX, args.in[7], lam, (char*)lds_raw);
        }
#endif
        {
            constexpr int I_OUT = (DM / 64) * (DM / 32), I_UP = (DM / 64) * (FF2 / 32), NF = (I_OUT + I_UP) / 8;
            const int lane = tid & 63, wave = __builtin_amdgcn_readfirstlane(tid >> 6);
            LAS float* scr = (LAS float*)(lds + wave * 16384);
            for (;;) {
                if (tid == 0) misc[0] = atomicAdd(queue + 320, 1u);
                __syncthreads();
                const int item = (int)misc[0];
                __syncthreads();
                if (item >= NF) break;
                int r = item * 8 + wave;
                if (r < I_OUT) p0_transpose_item<false>(args.in[15], DM, DM, Wout_t, nullptr, scr, r, lane);
                else p0_transpose_item<true>(args.in[17], DM, FF2, Wup_t, args.in[16], scr, r - I_OUT, lane);
            }
        }
    }
#endif
    xcd_barrier(xbar);

#if (PHMASK >> 3) & 1
    {
        pg8::Gemm g{MIX, Wout_t, T_, DM, DM, 256}; pg8::StaticOrder S; S.init(T_, DM, G, bx);
        pg8::EpiResBf E{XB, ss1, (LAS float*)(lds + LDS_EDGE)};
        pg8::gemm_phase<pg8::EpiResBf, pg8::StaticOrder, true, true>(lds, g, S, E);
    }
#endif
    xcd_barrier(xbar);

#if (PHMASK >> 4) & 1
    for (int rep = 0; rep < EXP_REP_P4; ++rep) {
        pg8::Gemm g{XB - DM, Wup_t, 65 * 256, FF2, DM, 254}; pg8::StaticOrder S; S.init(65 * 256, FF2, G, bx);
        pg8::EpiUp E{ACT, ss1, args.in[18], args.in[19], (LAS float*)(lds + LDS_EDGE)};
        pg8::gemm_phase<pg8::EpiUp, pg8::StaticOrder, true, true>(lds, g, S, E);
    }
    {
        constexpr int I_DN = (FF / 64) * (DM / 32), NF4 = I_DN / 8;
        int tl = threadIdx.x; asm volatile("" : "+v"(tl)); const int tid = tl, lane = tid & 63, wave = __builtin_amdgcn_readfirstlane(tid >> 6);
        volatile LAS unsigned* misc = (volatile LAS unsigned*)(lds + LDS_MISC); LAS float* scr = (LAS float*)(lds + wave * 16384);
        for (;;) {
            if (tid == 0) misc[0] = atomicAdd(queue + 384, 1u);
            __syncthreads();
            const int item = (int)misc[0];
            __syncthreads();
            if (item >= NF4) break;
            p0_transpose_item<false>(args.in[20], FF, DM, Wdn_t, nullptr, scr, item * 8 + wave, lane);
        }
    }
#endif
    xcd_barrier(xbar);

#if (PHMASK >> 5) & 1
    {
        pg8::Gemm g{ACT, Wdn_t, T_, DM, FF, 256}; pg8::StaticOrder S; S.init(T_, DM, G, bx);
        pg8::EpiResNorm E{XB, args.out, ss2, (unsigned*)(ws + WS_PCNT), args.in[21], (LAS float*)(lds + LDS_EDGE)};
        pg8::gemm_phase<pg8::EpiResNorm, pg8::StaticOrder, true, true>(lds, g, S, E);
    }
#endif

}

extern "C" void kernel_launch(void* const* d_in, const int* in_sizes, int n_in, void* d_out, int out_size, void* d_ws, size_t ws_size, hipStream_t stream) {
    static int grid = 0;
    if (grid == 0) {
        if (n_in != 22 || out_size != T_ * DM || ws_size < WS_END) { fprintf(stderr, "kernel_launch: unexpected shapes (n_in %d out %d ws %zu)\n", n_in, out_size, ws_size); grid = -1; return; }
        int dev = 0, cus = 0, per_cu = 0;
        (void)hipGetDevice(&dev); (void)hipDeviceGetAttribute(&cus, hipDeviceAttributeMultiprocessorCount, dev);
        if (hipFuncSetAttribute((const void*)hymba_fwd, hipFuncAttributeMaxDynamicSharedMemorySize, LDS_BYTES) != hipSuccess) { fprintf(stderr, "kernel_launch: hipFuncSetAttribute failed\n"); grid = -1; return; }
        if (hipOccupancyMaxActiveBlocksPerMultiprocessor(&per_cu, (const void*)hymba_fwd, 512, LDS_BYTES) != hipSuccess || per_cu < 1) per_cu = 1;
        (void)hipGetLastError();
        grid = cus * 1;
        if (grid != 256) { fprintf(stderr, "kernel_launch: built for a 256-CU device (got %d)\n", cus); grid = 256; }
    }
    if (grid < 0) return;
    Args a{};
    for (int i = 0; i < 22; ++i) a.in[i] = (const float*)d_in[i];
    a.out = (float*)d_out; a.ws = (unsigned char*)d_ws;
    void* kargs[] = {&a};
    hipError_t e = hipLaunchCooperativeKernel((const void*)hymba_fwd, dim3(grid), dim3(512), kargs, LDS_BYTES, stream);
    if (e != hipSuccess) fprintf(stderr, "cooperative launch failed: %s (grid %d)\n", hipGetErrorString(e), grid);
}
```

```cpp
#include <hip/hip_runtime.h>
#include <hip/hip_cooperative_groups.h>
#include <cstdint>
#include <cstdio>
namespace cg = cooperative_groups;
#ifndef EXP_REP_LRU
#define EXP_REP_LRU 1
#endif
#ifndef EXP_REP_ATT
#define EXP_REP_ATT 1
#endif
#ifndef EXP_REP_P1
#define EXP_REP_P1 1
#endif
#ifndef EXP_REP_P4
#define EXP_REP_P4 1
#endif
#ifndef EXP_REP_P0
#define EXP_REP_P0 1
#endif
#ifndef EXP_EXTRA_SYNC
#define EXP_EXTRA_SYNC 0
#endif
#ifndef EXP_REP_P3
#define EXP_REP_P3 1
#endif
#ifndef EXP_REP_P5
#define EXP_REP_P5 1
#endif
#ifndef EXP_MIXSCALE
#define EXP_MIXSCALE 1.f
#endif
#ifndef EXP_FFNSCALE
#define EXP_FFNSCALE 1.f
#endif
#ifndef EXP_ATTSCALE
#define EXP_ATTSCALE 1.f
#endif
#ifndef EXP_LRUSCALE
#define EXP_LRUSCALE 1.f
#endif

#define LAS __attribute__((address_space(3)))
typedef short bf16x8 __attribute__((ext_vector_type(8)));
typedef short s16x4 __attribute__((ext_vector_type(4)));
typedef float f32x2 __attribute__((ext_vector_type(2)));
typedef float f32x4 __attribute__((ext_vector_type(4)));
typedef float f32x8 __attribute__((ext_vector_type(8)));
typedef float f32x16 __attribute__((ext_vector_type(16)));
typedef unsigned u32x2 __attribute__((ext_vector_type(2)));
typedef unsigned u32x4 __attribute__((ext_vector_type(4)));

constexpr int T_ = 16384, DM = 1024, SEQ = 2048, INW = 2560, FF = 2816, FF2 = 5632;
constexpr float EPS = 1e-6f, L2E = 1.4426950408889634f;
constexpr size_t MiB = 1u << 20;
constexpr size_t WS_BAR = 262144;
constexpr size_t WS_PCNT = 327680;
constexpr size_t WS_LCNT = 360448;
constexpr size_t WS_ZERO_BYTES = 393216;
constexpr size_t WS_QUEUE = 0, WS_SS1 = 65536, WS_SS2 = 131072, WS_RS0 = 196608;
constexpr size_t WS_WIN = 1 * MiB, WS_WOUT = 6 * MiB, WS_WUP = 8 * MiB, WS_WDN = 19 * MiB;
constexpr size_t WS_XB = 26 * MiB;
constexpr size_t WS_PROJ = 59 * MiB;
constexpr size_t WS_MIX = 139 * MiB;
constexpr size_t WS_YS = 171 * MiB;
constexpr size_t WS_ACT = 59 * MiB;
constexpr size_t WS_END = 235 * MiB;
constexpr int LDS_EDGE = 131072, LDS_TOT = 135168, LDS_CW = 143360, LDS_MISC = 145408, LDS_BYTES = 147456;

__device__ __forceinline__ unsigned cvtpk(float lo, float hi) { unsigned r; asm volatile("v_cvt_pk_bf16_f32 %0, %1, %2" : "=v"(r) : "v"(lo), "v"(hi)); return r; }
__device__ __forceinline__ float bf2f(short s) { return __uint_as_float(((unsigned)(unsigned short)s) << 16); }
__device__ __forceinline__ bf16x8 pack8(f32x8 x) { u32x4 w = {cvtpk(x[0], x[1]), cvtpk(x[2], x[3]), cvtpk(x[4], x[5]), cvtpk(x[6], x[7])}; return __builtin_bit_cast(bf16x8, w); }
__device__ __forceinline__ float gelu_tanh(float x) {
    const float e = __builtin_amdgcn_exp2f(-2.302208198f * x * (1.f + 0.044715f * x * x));
    return x * __builtin_amdgcn_rcpf(1.f + e);
}
__device__ __forceinline__ float wave_sum(float v) {
#pragma unroll
    for (int o = 1; o < 64; o <<= 1) v += __shfl_xor(v, o);
    return v;
}
typedef unsigned short bf16_t;
namespace pg8 {
#define PG8_LAS __attribute__((address_space(3)))
constexpr int BM = 256, BK = 64, HALF = 128, HTB = HALF * BK * 2  , STAGE_BYTES = 8 * HTB, NXCD = 8, WGM = 8;

__host__ __device__ __forceinline__ int lds_byte(int r, int c) { const int st = (r >> 4) * 2 + (c >> 5), rr = r & 15, cc = c & 31, ob = rr * 64 + cc * 2; return st * 1024 + (ob ^ (((ob >> 9) & 1) << 5)); }
__host__ __device__ __forceinline__ void stage_rc(int b, int& R, int& C) { const int st = b / 1024, sb = b % 1024, swz = sb ^ (((sb >> 9) & 1) << 5); R = (st >> 1) * 16 + swz / 64; C = (st & 1) * 32 + (swz % 64) / 2; }
__host__ __device__ __forceinline__ int perm32(int rho) { const int n = rho >> 4, i = rho & 15; return 8 * (i >> 2) + 4 * n + (i & 3); }

struct Unit { int pm, pn; };
struct Gemm { const bf16_t* A; const bf16_t* Bt; int M, N, K, a_rows; };

struct StaticOrder {
    int nM, nN, nwg, G, c;
    __host__ __device__ void init(int M, int N, int G_, int c_) { nM = M / BM; nN = N / BM; nwg = nM * nN; G = G_; c = c_; }
    __host__ __device__ bool next(int i, Unit& u) const {
        const long L = (long)i * G + c; if (L >= nwg) return false;
        int wgid = (int)L; { const int q = nwg / NXCD, r = nwg % NXCD, xcd = wgid % NXCD, off = wgid / NXCD; wgid = (xcd < r ? xcd * (q + 1) : r * (q + 1) + (xcd - r) * q) + off; }
        const int nig = WGM * nN, gid = wgid / nig, fm = gid * WGM, gsz = (nM - fm) < WGM ? (nM - fm) : WGM;
        u.pm = fm + ((wgid % nig) % gsz); u.pn = (wgid % nig) / gsz; return true;
    }
    __device__ __forceinline__ void a_ready(const Unit&) const {}
    __device__ __forceinline__ void done(const Unit&) const {}
};
struct EpiProj {
    static constexpr bool PERM = true, AFTER_DRAIN = false;
    bf16_t* O; int ldc; const float* rs;
    __device__ __forceinline__ void operator()(f32x4 (&acc)[2][2][4][2], const Unit& u, int wr, int wc, int fr, int fq) const {
        const int row0 = u.pm * BM + wr * 64 + fr, col0 = u.pn * BM + wc * 32 + 8 * fq;
#pragma unroll
        for (int ai = 0; ai < 2; ++ai)
#pragma unroll
            for (int m = 0; m < 4; ++m) { const int row = row0 + ai * HALF + m * 16; const float s = rs[row]; bf16_t* rowp = O + (size_t)row * ldc + col0;
#pragma unroll
                for (int bj = 0; bj < 2; ++bj) { const f32x4 v0 = acc[ai][bj][m][0] * s, v1 = acc[ai][bj][m][1] * s;
                    u32x4 w; w.x = cvtpk(v0[0], v0[1]); w.y = cvtpk(v0[2], v0[3]); w.z = cvtpk(v1[0], v1[1]); w.w = cvtpk(v1[2], v1[3]);
                    *(u32x4*)(rowp + bj * HALF) = w; } }
    }
};
struct EpiRes {
    static constexpr bool PERM = false, AFTER_DRAIN = false;
    const float* base; float* out; bf16_t* xb; float* ss; float ascale;
    __device__ __forceinline__ void operator()(f32x4 (&acc)[2][2][4][2], const Unit& u, int wr, int wc, int fr, int fq) const {
        const int row0 = u.pm * BM + wr * 64 + fr, col0 = u.pn * BM + wc * 32 + 4 * fq;
#pragma unroll
        for (int ai = 0; ai < 2; ++ai)
#pragma unroll
            for (int m = 0; m < 4; ++m) { const int row = row0 + ai * HALF + m * 16; const size_t off = (size_t)row * 1024 + col0; float sq = 0.f;
#pragma unroll
                for (int bj = 0; bj < 2; ++bj)
#pragma unroll
                    for (int n = 0; n < 2; ++n) { const size_t o2 = off + bj * HALF + n * 16; const f32x4 b = *(const f32x4*)(base + o2); const f32x4 o = b + acc[ai][bj][m][n] * ascale;
                        *(f32x4*)(out + o2) = o; sq += (o[0] * o[0] + o[1] * o[1]) + (o[2] * o[2] + o[3] * o[3]);
                        if (xb) { u32x2 w; w.x = cvtpk(o[0], o[1]); w.y = cvtpk(o[2], o[3]); *(u32x2*)(xb + o2) = w; } }
                sq += __shfl_xor(sq, 16); sq += __shfl_xor(sq, 32);
                if (fq == 0) atomicAdd(ss + row, sq); }
    }
};
__device__ __forceinline__ float bflo(unsigned w) { return __uint_as_float(w << 16); }
__device__ __forceinline__ float bfhi(unsigned w) { return __uint_as_float(w & 0xffff0000u); }
struct EpiResBf {
    static constexpr bool PERM = true, AFTER_DRAIN = false;
    bf16_t* xb; float* ss; PG8_LAS float* red;
    __device__ __forceinline__ void operator()(f32x4 (&acc)[2][2][4][2], const Unit& u, int wr, int wc, int fr, int fq) const {
        const int row0 = u.pm * BM + wr * 64 + fr, col0 = u.pn * BM + wc * 32 + 8 * fq;
#pragma unroll
        for (int ai = 0; ai < 2; ++ai)
#pragma unroll
            for (int m = 0; m < 4; ++m) { const int row = row0 + ai * HALF + m * 16; const size_t off = (size_t)row * 1024 + col0; float sq = 0.f;
#pragma unroll
                for (int bj = 0; bj < 2; ++bj) { const size_t o2 = off + bj * HALF; const u32x4 bw = *(const u32x4*)(xb + o2);
                    const f32x4 o0 = (f32x4){bflo(bw.x), bfhi(bw.x), bflo(bw.y), bfhi(bw.y)} + acc[ai][bj][m][0], o1 = (f32x4){bflo(bw.z), bfhi(bw.z), bflo(bw.w), bfhi(bw.w)} + acc[ai][bj][m][1];
                    u32x4 w; w.x = cvtpk(o0[0], o0[1]); w.y = cvtpk(o0[2], o0[3]); w.z = cvtpk(o1[0], o1[1]); w.w = cvtpk(o1[2], o1[3]); *(u32x4*)(xb + o2) = w;
                    const float r0 = bflo(w.x), r1 = bfhi(w.x), r2 = bflo(w.y), r3 = bfhi(w.y), r4 = bflo(w.z), r5 = bfhi(w.z), r6 = bflo(w.w), r7 = bfhi(w.w);
                    sq += ((r0 * r0 + r1 * r1) + (r2 * r2 + r3 * r3)) + ((r4 * r4 + r5 * r5) + (r6 * r6 + r7 * r7)); }
                sq += __shfl_xor(sq, 16); sq += __shfl_xor(sq, 32);
                if (fq == 0) red[wc * 256 + ai * HALF + wr * 64 + m * 16 + fr] = sq; }
        asm volatile("s_waitcnt lgkmcnt(0)" ::: "memory"); __builtin_amdgcn_s_barrier(); asm volatile("" ::: "memory");
        if (threadIdx.x < 256) { const int r = threadIdx.x; atomicAdd(ss + u.pm * BM + r, (red[r] + red[256 + r]) + (red[512 + r] + red[768 + r])); }
    }
};
struct EpiResNorm {
    static constexpr bool PERM = true, AFTER_DRAIN = false;
    const bf16_t* base; float* out; float* ss; unsigned* cnt; const float* gain; PG8_LAS float* red;
    __device__ __forceinline__ void operator()(f32x4 (&acc)[2][2][4][2], const Unit& u, int wr, int wc, int fr, int fq) const {
        const int row0 = u.pm * BM + wr * 64 + fr, col0 = u.pn * BM + wc * 32 + 8 * fq;
#pragma unroll
        for (int ai = 0; ai < 2; ++ai)
#pragma unroll
            for (int m = 0; m < 4; ++m) { const int row = row0 + ai * HALF + m * 16; const size_t off = (size_t)row * 1024 + col0; float sq = 0.f;
#pragma unroll
                for (int bj = 0; bj < 2; ++bj) { const u32x4 bw = *(const u32x4*)(base + off + bj * HALF);
                    const f32x4 o0 = (f32x4){bflo(bw.x), bfhi(bw.x), bflo(bw.y), bfhi(bw.y)} + acc[ai][bj][m][0], o1 = (f32x4){bflo(bw.z), bfhi(bw.z), bflo(bw.w), bfhi(bw.w)} + acc[ai][bj][m][1];
                    acc[ai][bj][m][0] = o0; acc[ai][bj][m][1] = o1;
                    sq += ((o0[0] * o0[0] + o0[1] * o0[1]) + (o0[2] * o0[2] + o0[3] * o0[3])) + ((o1[0] * o1[0] + o1[1] * o1[1]) + (o1[2] * o1[2] + o1[3] * o1[3])); }
                sq += __shfl_xor(sq, 16); sq += __shfl_xor(sq, 32);
                if (fq == 0) red[wc * 256 + ai * HALF + wr * 64 + m * 16 + fr] = sq; }
        asm volatile("s_waitcnt lgkmcnt(0)" ::: "memory"); __builtin_amdgcn_s_barrier(); asm volatile("" ::: "memory");
        unsigned* pc = cnt + 64 * u.pm;
        if (threadIdx.x < 256) { const int r = threadIdx.x;
            __hip_atomic_fetch_add(ss + u.pm * BM + r, (red[r] + red[256 + r]) + (red[512 + r] + red[768 + r]), __ATOMIC_RELAXED, __HIP_MEMORY_SCOPE_AGENT);
            asm volatile("s_waitcnt vmcnt(0)" ::: "memory");
            if ((threadIdx.x & 63) == 0) __hip_atomic_fetch_add(pc, 1u, __ATOMIC_RELAXED, __HIP_MEMORY_SCOPE_AGENT); }
        if (threadIdx.x < 64) { unsigned sp = 0;
            while ((unsigned)__builtin_amdgcn_readfirstlane(__hip_atomic_load(pc, __ATOMIC_RELAXED, __HIP_MEMORY_SCOPE_AGENT)) < 16u) { __builtin_amdgcn_s_sleep(2); if (++sp > (1u << 22)) break; }
            __builtin_amdgcn_fence(__ATOMIC_ACQUIRE, "agent"); }
        asm volatile("s_waitcnt vmcnt(0) lgkmcnt(0)" ::: "memory"); __builtin_amdgcn_s_barrier(); asm volatile("" ::: "memory");
        f32x4 gv[2][2];
#pragma unroll
        for (int bj = 0; bj < 2; ++bj)
#pragma unroll
            for (int n = 0; n < 2; ++n) gv[bj][n] = *(const f32x4*)(gain + col0 + bj * HALF + n * 4);
#pragma unroll
        for (int ai = 0; ai < 2; ++ai)
#pragma unroll
            for (int m = 0; m < 4; ++m) { const int row = row0 + ai * HALF + m * 16; const size_t off = (size_t)row * 1024 + col0;
                const float rs = __builtin_amdgcn_rsqf(__hip_atomic_load(ss + row, __ATOMIC_RELAXED, __HIP_MEMORY_SCOPE_AGENT) * (1.f / 1024.f) + EPS);
#pragma unroll
                for (int bj = 0; bj < 2; ++bj)
#pragma unroll
                    for (int n = 0; n < 2; ++n) *(f32x4*)(out + off + bj * HALF + n * 4) = acc[ai][bj][m][n] * rs * gv[bj][n]; }
    }
};
__device__ __forceinline__ f32x4 dpp_shr1(f32x4 c, f32x4 old) { float r0 = old[0], r1 = old[1], r2 = old[2], r3 = old[3];
    asm("s_nop 1\n\tv_mov_b32_dpp %0, %4 row_shr:1 row_mask:0xf bank_mask:0xf\n\tv_mov_b32_dpp %1, %5 row_shr:1 row_mask:0xf bank_mask:0xf\n\tv_mov_b32_dpp %2, %6 row_shr:1 row_mask:0xf bank_mask:0xf\n\tv_mov_b32_dpp %3, %7 row_shr:1 row_mask:0xf bank_mask:0xf"
        : "+&v"(r0), "+&v"(r1), "+&v"(r2), "+&v"(r3) : "v"(c[0]), "v"(c[1]), "v"(c[2]), "v"(c[3]));
    return (f32x4){r0, r1, r2, r3}; }
__device__ __forceinline__ f32x4 dpp_shl1(f32x4 c, f32x4 old) { float r0 = old[0], r1 = old[1], r2 = old[2], r3 = old[3];
    asm("s_nop 1\n\tv_mov_b32_dpp %0, %4 row_shl:1 row_mask:0xf bank_mask:0xf\n\tv_mov_b32_dpp %1, %5 row_shl:1 row_mask:0xf bank_mask:0xf\n\tv_mov_b32_dpp %2, %6 row_shl:1 row_mask:0xf bank_mask:0xf\n\tv_mov_b32_dpp %3, %7 row_shl:1 row_mask:0xf bank_mask:0xf"
        : "+&v"(r0), "+&v"(r1), "+&v"(r2), "+&v"(r3) : "v"(c[0]), "v"(c[1]), "v"(c[2]), "v"(c[3]));
    return (f32x4){r0, r1, r2, r3}; }
__device__ __forceinline__ f32x4 dpp_mirror(f32x4 c) { float r0, r1, r2, r3;
    asm("s_nop 1\n\tv_mov_b32_dpp %0, %4 row_mirror row_mask:0xf bank_mask:0xf\n\tv_mov_b32_dpp %1, %5 row_mirror row_mask:0xf bank_mask:0xf\n\tv_mov_b32_dpp %2, %6 row_mirror row_mask:0xf bank_mask:0xf\n\tv_mov_b32_dpp %3, %7 row_mirror row_mask:0xf bank_mask:0xf"
        : "=&v"(r0), "=&v"(r1), "=&v"(r2), "=&v"(r3) : "v"(c[0]), "v"(c[1]), "v"(c[2]), "v"(c[3]));
    return (f32x4){r0, r1, r2, r3}; }
struct EpiUp {
    static constexpr bool PERM = true, AFTER_DRAIN = false;
    bf16_t* act; const float* ss1; const float* cw; const float* cb; PG8_LAS float* edge;
    __device__ __forceinline__ void operator()(f32x4 (&acc)[2][2][4][2], const Unit& u, int wr, int wc, int fr, int fq) const {
        const int tbase = u.pm * 254 - 1;
        const bool bnd = ((tbase + 1) >> 11) != ((tbase + 256) >> 11) || ((tbase + 1) & (SEQ - 1)) == 0 || tbase < 0;
#pragma unroll
        for (int ai = 0; ai < 2; ++ai)
#pragma unroll
            for (int m = 0; m < 4; ++m) { const int t = tbase + ai * HALF + wr * 64 + m * 16 + fr; float s = 0.f;
                if (t >= 0 && t < T_) s = __builtin_amdgcn_rsqf(ss1[t] * (1.f / 1024.f) + EPS);
#pragma unroll
                for (int bj = 0; bj < 2; ++bj)
#pragma unroll
                    for (int n = 0; n < 2; ++n) acc[ai][bj][m][n] *= s; }
        const int colw = wc * 32 + 4 * fq;
        if (fr == 0 || fr == 15) { const int e = (fr == 15) ? 1 : 0;
#pragma unroll
            for (int ai = 0; ai < 2; ++ai) { const int g = 2 * ai + wr;
#pragma unroll
                for (int bj = 0; bj < 2; ++bj)
#pragma unroll
                    for (int n = 0; n < 2; ++n) *(PG8_LAS f32x4*)(edge + ((g * 2 + e) * 256 + 128 * bj + colw + 16 * n)) = e ? acc[ai][bj][3][n] : acc[ai][bj][0][n]; } }
        asm volatile("s_waitcnt lgkmcnt(0)" ::: "memory"); __builtin_amdgcn_s_barrier(); asm volatile("" ::: "memory");
        u32x2 stash[2][4];
#pragma unroll
        for (int n = 0; n < 2; ++n) {
            const int f = u.pn * 128 + wc * 32 + 8 * fq + 4 * n;
            f32x4 w0[2], w1[2], w2[2], bb[2];
#pragma unroll
            for (int bj = 0; bj < 2; ++bj) { const int c = f + bj * FF; w0[bj] = *(const f32x4*)(cw + c); w1[bj] = *(const f32x4*)(cw + FF2 + c); w2[bj] = *(const f32x4*)(cw + 2 * FF2 + c); bb[bj] = *(const f32x4*)(cb + c); }
#pragma unroll
            for (int ai = 0; ai < 2; ++ai) { const int g = 2 * ai + wr;
#pragma unroll
                for (int m = 0; m < 4; ++m) { const int R = ai * HALF + wr * 64 + m * 16 + fr, t = tbase + R, tp = t & (SEQ - 1);
                    f32x4 uu[2];
#pragma unroll
                    for (int bj = 0; bj < 2; ++bj) { const f32x4 cur = acc[ai][bj][m][n]; f32x4 upe, dne;
                        if (m > 0) upe = dpp_mirror(acc[ai][bj][m - 1][n]); else upe = (g > 0) ? *(PG8_LAS const f32x4*)(edge + (((g - 1) * 2 + 1) * 256 + 128 * bj + colw + 16 * n)) : (f32x4){0.f, 0.f, 0.f, 0.f};
                        if (m < 3) dne = dpp_mirror(acc[ai][bj][m + 1][n]); else dne = (g < 3) ? *(PG8_LAS const f32x4*)(edge + (((g + 1) * 2 + 0) * 256 + 128 * bj + colw + 16 * n)) : (f32x4){0.f, 0.f, 0.f, 0.f};
                        f32x4 up = dpp_shr1(cur, upe), dn = dpp_shl1(cur, dne);
                        if (bnd) {
                            if (tp == 0) up = (f32x4){0.f, 0.f, 0.f, 0.f};
                            if (tp == SEQ - 1) dn = (f32x4){0.f, 0.f, 0.f, 0.f}; }
                        uu[bj] = bb[bj] + w0[bj] * up + w1[bj] * cur + w2[bj] * dn; }
                    { u32x2 w; w.x = cvtpk(gelu_tanh(uu[0][0]) * uu[1][0], gelu_tanh(uu[0][1]) * uu[1][1]); w.y = cvtpk(gelu_tanh(uu[0][2]) * uu[1][2], gelu_tanh(uu[0][3]) * uu[1][3]);
                        if (n == 0) stash[ai][m] = w;
                        else if (R >= 1 && R <= 254 && t < T_) *(u32x4*)(act + (size_t)t * FF + (f - 4)) = (u32x4){stash[ai][m].x, stash[ai][m].y, w.x, w.y}; } } }
        }
    }
};
template <class Epi, class Sched, bool ALIGN_EPI = false, bool SP2 = false>
__device__ __forceinline__ void gemm_phase(PG8_LAS unsigned char* lds, const Gemm g, const Sched& S, const Epi& E) {
    int tid_l = threadIdx.x; asm volatile("" : "+v"(tid_l));
    const int tid = tid_l, wid = __builtin_amdgcn_readfirstlane(tid >> 6), lane = tid & 63, wr = wid >> 2, wc = wid & 3, fr = lane & 15, fq = lane >> 4;
    const int K = g.K, nt = K / BK;
    unsigned voffA[2], voffB[2];
#pragma unroll
    for (int i = 0; i < 2; ++i) { int R, C; stage_rc(tid * 16 + i * 8192, R, C); const int Rb = Epi::PERM ? ((R & ~31) + perm32(R & 31)) : R;
        voffA[i] = (unsigned)(R * K + C) * 2u; voffB[i] = (unsigned)(Rb * K + C) * 2u; }
    const size_t kstep = (size_t)(BK * 2);
    const size_t hstep = (size_t)HALF * K * 2;
    const size_t tstep = 2 * hstep; const size_t tstepA = (size_t)g.a_rows * K * 2;
    const unsigned ldsw = (unsigned)wid * 1024u;
    const int aoff = lds_byte(wr * 64 + fr, fq * 8), boff = lds_byte(wc * 32 + fr, fq * 8);
#define PG8_SA(b, h) (((b) * 2 + (h)) * HTB)
#define PG8_SB(b, h) ((4 + (b) * 2 + (h)) * HTB)
#define PG8_STAGE(bufoff, gbase, voff) do { _Pragma("unroll") for (int _i = 0; _i < 2; ++_i) \
        __builtin_amdgcn_global_load_lds((const unsigned*)((const char*)(gbase) + (voff)[_i]), (PG8_LAS unsigned*)(lds + (bufoff) + ldsw + _i * 8192), 16, 0, 0); } while (0)
#define PG8_LDA(dst, b, h) do { _Pragma("unroll") for (int m = 0; m < 4; ++m) _Pragma("unroll") for (int k = 0; k < 2; ++k) dst[m][k] = *(const PG8_LAS bf16x8*)(lds + PG8_SA(b, h) + aoff + m * 2048 + k * 1024); } while (0)
#define PG8_LDB(dst, b, h) do { _Pragma("unroll") for (int n = 0; n < 2; ++n) _Pragma("unroll") for (int k = 0; k < 2; ++k) dst[n][k] = *(const PG8_LAS bf16x8*)(lds + PG8_SB(b, h) + boff + n * 2048 + k * 1024); } while (0)
#define PG8_MMA(ai, bj, At, Bt) do { __builtin_amdgcn_s_setprio(1); _Pragma("unroll") for (int m = 0; m < 4; ++m) _Pragma("unroll") for (int n = 0; n < 2; ++n) _Pragma("unroll") for (int k = 0; k < 2; ++k) \
        acc[ai][bj][m][n] = __builtin_amdgcn_mfma_f32_16x16x32_bf16(Bt[n][k], At[m][k], acc[ai][bj][m][n], 0, 0, 0); __builtin_amdgcn_s_setprio(0); } while (0)
#define PG8_WAIT_V(n) asm volatile("s_waitcnt vmcnt(" #n ")" ::: "memory")
#define PG8_WAIT_L(n) asm volatile("s_waitcnt lgkmcnt(" #n ")" ::: "memory")
#define PG8_BAR __builtin_amdgcn_s_barrier()
#define PG8_SCHED __builtin_amdgcn_sched_barrier(0)
    Unit cur, nxt; int ui = 0;
    if (!S.next(0, cur)) return;
    f32x4 acc[2][2][4][2];
#pragma unroll
    for (int a = 0; a < 2; ++a)
#pragma unroll
        for (int b = 0; b < 2; ++b)
#pragma unroll
            for (int m = 0; m < 4; ++m)
#pragma unroll
                for (int n = 0; n < 2; ++n) acc[a][b][m][n] = (f32x4){0.f, 0.f, 0.f, 0.f};
    bf16x8 At[4][2], B0[2][2], B1[2][2];
    const char* cA = (const char*)g.A + (size_t)cur.pm * tstepA; const char* cB = (const char*)g.Bt + (size_t)cur.pn * tstep;
    S.a_ready(cur);
    if constexpr (SP2) {
        PG8_STAGE(PG8_SB(0, 0), cB, voffB); PG8_STAGE(PG8_SB(0, 1), cB + hstep, voffB); PG8_STAGE(PG8_SA(0, 0), cA, voffA); PG8_STAGE(PG8_SA(0, 1), cA + hstep, voffA);
        if (wr == 1) PG8_BAR;
        PG8_WAIT_V(2); PG8_BAR;
        PG8_STAGE(PG8_SB(1, 0), cB + kstep, voffB); PG8_STAGE(PG8_SA(1, 0), cA + kstep, voffA); PG8_STAGE(PG8_SB(1, 1), cB + hstep + kstep, voffB);
        PG8_WAIT_V(6); PG8_BAR;
    } else {
        PG8_STAGE(PG8_SB(0, 0), cB, voffB); PG8_STAGE(PG8_SA(0, 0), cA, voffA); PG8_STAGE(PG8_SB(0, 1), cB + hstep, voffB); PG8_STAGE(PG8_SA(0, 1), cA + hstep, voffA);
        if (wr == 1) PG8_BAR;
        PG8_WAIT_V(4); PG8_BAR;
        PG8_STAGE(PG8_SB(1, 0), cB + kstep, voffB); PG8_STAGE(PG8_SA(1, 0), cA + kstep, voffA); PG8_STAGE(PG8_SB(1, 1), cB + hstep + kstep, voffB);
        PG8_WAIT_V(6); PG8_BAR;
    }
    for (;;) {
        const bool has_next = S.next(ui + 1, nxt);
        const char* nA = has_next ? (const char*)g.A + (size_t)nxt.pm * tstepA : cA; const char* nB = has_next ? (const char*)g.Bt + (size_t)nxt.pn * tstep : cB;
        for (int t = 0; t < nt; t += 2) {
            const bool last = (t == nt - 2);
            const char* a1 = cA + (size_t)(t + 1) * kstep;
            const char* a2 = last ? nA : cA + (size_t)(t + 2) * kstep; const char* b2 = last ? nB : cB + (size_t)(t + 2) * kstep;
            const char* a3 = a2 + kstep; const char* b3 = b2 + kstep;
            if (last && has_next) S.a_ready(nxt);
            if constexpr (SP2) {
            PG8_LDB(B0, 0, 0); PG8_LDB(B1, 0, 1); PG8_SCHED; PG8_LDA(At, 0, 0); PG8_STAGE(PG8_SA(1, 1), a1 + hstep, voffA);
            PG8_WAIT_V(8); PG8_WAIT_L(0); PG8_BAR; PG8_MMA(0, 0, At, B0); PG8_MMA(0, 1, At, B1); PG8_BAR; PG8_SCHED;
            PG8_LDA(At, 0, 1); PG8_STAGE(PG8_SB(0, 0), b2, voffB); PG8_STAGE(PG8_SB(0, 1), b2 + hstep, voffB); PG8_STAGE(PG8_SA(0, 0), a2, voffA);
            PG8_WAIT_V(8); PG8_WAIT_L(0); PG8_BAR; PG8_MMA(1, 0, At, B0); PG8_MMA(1, 1, At, B1); PG8_BAR; PG8_SCHED;
            PG8_LDB(B0, 1, 0); PG8_LDB(B1, 1, 1); PG8_SCHED; PG8_LDA(At, 1, 0); PG8_STAGE(PG8_SA(0, 1), a2 + hstep, voffA);
            PG8_WAIT_V(8); PG8_WAIT_L(0); PG8_BAR; PG8_MMA(0, 0, At, B0); PG8_MMA(0, 1, At, B1); PG8_BAR; PG8_SCHED;
            PG8_LDA(At, 1, 1); PG8_STAGE(PG8_SB(1, 0), b3, voffB); PG8_STAGE(PG8_SB(1, 1), b3 + hstep, voffB); PG8_STAGE(PG8_SA(1, 0), a3, voffA);
            PG8_WAIT_V(8); PG8_WAIT_L(0); PG8_BAR; PG8_MMA(1, 0, At, B0); PG8_MMA(1, 1, At, B1); PG8_BAR; PG8_SCHED;
            } else {
            PG8_LDB(B0, 0, 0); PG8_SCHED; PG8_LDA(At, 0, 0); PG8_STAGE(PG8_SA(1, 1), a1 + hstep, voffA);
            PG8_WAIT_L(8); PG8_BAR; PG8_WAIT_L(0); PG8_MMA(0, 0, At, B0); PG8_BAR; PG8_SCHED;
            PG8_LDB(B1, 0, 1); PG8_STAGE(PG8_SB(0, 0), b2, voffB);
            PG8_BAR; PG8_WAIT_L(0); PG8_MMA(0, 1, At, B1); PG8_BAR;
            PG8_LDA(At, 0, 1); PG8_STAGE(PG8_SA(0, 0), a2, voffA);
            PG8_BAR; PG8_WAIT_L(0); PG8_MMA(1, 0, At, B0); PG8_BAR; PG8_SCHED;
            PG8_STAGE(PG8_SB(0, 1), b2 + hstep, voffB);
            PG8_WAIT_V(6); PG8_BAR; PG8_MMA(1, 1, At, B1); PG8_BAR;
            PG8_LDB(B0, 1, 0); PG8_SCHED; PG8_LDA(At, 1, 0); PG8_STAGE(PG8_SA(0, 1), a2 + hstep, voffA);
            PG8_WAIT_L(8); PG8_BAR; PG8_WAIT_L(0); PG8_MMA(0, 0, At, B0); PG8_BAR; PG8_SCHED;
            PG8_LDB(B1, 1, 1); PG8_STAGE(PG8_SB(1, 0), b3, voffB);
            PG8_BAR; PG8_WAIT_L(0); PG8_MMA(0, 1, At, B1); PG8_BAR;
            PG8_LDA(At, 1, 1); PG8_STAGE(PG8_SA(1, 0), a3, voffA);
            PG8_BAR; PG8_WAIT_L(0); PG8_MMA(1, 0, At, B0); PG8_BAR; PG8_SCHED;
            PG8_STAGE(PG8_SB(1, 1), b3 + hstep, voffB);
            PG8_WAIT_V(6); PG8_BAR; PG8_MMA(1, 1, At, B1); PG8_BAR;
            }
        }
        if constexpr (ALIGN_EPI) { if (wr == 0) PG8_BAR; }
        if constexpr (!Epi::AFTER_DRAIN) { E(acc, cur, wr, wc, fr, fq); S.done(cur); }
        if (!has_next) break;
#pragma unroll
        for (int a = 0; a < 2; ++a)
#pragma unroll
            for (int b = 0; b < 2; ++b)
#pragma unroll
                for (int m = 0; m < 4; ++m)
#pragma unroll
                    for (int n = 0; n < 2; ++n) acc[a][b][m][n] = (f32x4){0.f, 0.f, 0.f, 0.f};
        cur = nxt; cA = nA; cB = nB; ++ui;
        if constexpr (ALIGN_EPI) { if (wr == 1) PG8_BAR; }
    }
    PG8_WAIT_V(0);
    if constexpr (!ALIGN_EPI) { if (wr == 0) PG8_BAR; }
    PG8_BAR;
    if constexpr (Epi::AFTER_DRAIN) { E.fused(acc, cur, wr, wc, fr, fq, lds, wid, lane); S.done(cur); }
#undef PG8_SA
#undef PG8_SB
#undef PG8_STAGE
#undef PG8_LDA
#undef PG8_LDB
#undef PG8_MMA
#undef PG8_WAIT_V
#undef PG8_WAIT_L
#undef PG8_BAR
#undef PG8_SCHED
}
}
namespace att {
constexpr int LD = INW, KVBLK = 64;
constexpr size_t SHM_V = KVBLK * 128 * 2, SHM_K = KVBLK * 128 * 2;
constexpr float THR2 = 8.f * L2E;
#define KSWZ(row, colB) ((row) * 256 + ((colB) ^ (((row) & 7) << 4)))
#define SBAR() __builtin_amdgcn_sched_barrier(0)
__device__ __forceinline__ int crow(int r, int hi) { return (r & 3) + 8 * (r >> 2) + 4 * hi; }
__device__ __forceinline__ void partialSM(f32x16& p0, f32x16& p1, float& m_reg, float& mn, float& alpha, float dqs, float sl2) {
  constexpr float C = 0.125f * L2E;
#pragma unroll
  for (int r = 0; r < 16; ++r) { const float k0 = (float)((r & 3) + 8 * (r >> 2));
    p0[r] = fmaf(p0[r], C, -fabsf(fmaf(sl2, -k0, dqs))); p1[r] = fmaf(p1[r], C, -fabsf(fmaf(sl2, -(k0 + 32.f), dqs))); }
  float pmax = p0[0];
#pragma unroll
  for (int r = 1; r < 16; ++r) pmax = fmaxf(pmax, p0[r]);
#pragma unroll
  for (int r = 0; r < 16; ++r) pmax = fmaxf(pmax, p1[r]);
  { auto rr = __builtin_amdgcn_permlane32_swap(__float_as_uint(pmax), __float_as_uint(pmax), false, false);
    pmax = fmaxf(__uint_as_float(rr[0]), __uint_as_float(rr[1])); }
  if (__builtin_expect(__all(pmax - m_reg <= THR2), 1)) { mn = m_reg; alpha = 1.f; }
  else { mn = fmaxf(m_reg, pmax); alpha = __builtin_amdgcn_exp2f(m_reg - mn); m_reg = mn; }
#pragma unroll
  for (int r = 0; r < 16; ++r) { p0[r] -= mn; p1[r] -= mn; }
#pragma unroll
  for (int r = 0; r < 16; ++r) p0[r] = __builtin_amdgcn_exp2f(p0[r]);
}
__device__ __forceinline__ void partialSM1(f32x16& p0, f32x16& p1, float& m_reg, float& mn, float& alpha, float dqs, float sl2, int side) {
  constexpr float C = 0.125f * L2E;
  const float sg = side > 0 ? -sl2 : sl2, D0 = side > 0 ? (m_reg + dqs) : (m_reg - dqs);
  const f32x2 sg2 = {sg, sg}, C2 = {C, C}, Da = {D0, D0}, Db = {fmaf(sg, 32.f, D0), fmaf(sg, 32.f, D0)};
#pragma unroll
  for (int r = 0; r < 16; r += 2) {
    const f32x2 kk = {(float)((r & 3) + 8 * (r >> 2)), (float)(((r + 1) & 3) + 8 * ((r + 1) >> 2))};
    const f32x2 b0 = __builtin_elementwise_fma(sg2, kk, Da), b1 = __builtin_elementwise_fma(sg2, kk, Db);
    const f32x2 x0 = __builtin_elementwise_fma((f32x2){p0[r], p0[r + 1]}, C2, -b0), x1 = __builtin_elementwise_fma((f32x2){p1[r], p1[r + 1]}, C2, -b1);
    p0[r] = x0[0]; p0[r + 1] = x0[1]; p1[r] = x1[0]; p1[r + 1] = x1[1]; }
  float pmax = p0[0];
#pragma unroll
  for (int r = 1; r < 16; ++r) pmax = fmaxf(pmax, p0[r]);
#pragma unroll
  for (int r = 0; r < 16; ++r) pmax = fmaxf(pmax, p1[r]);
  { auto rr = __builtin_amdgcn_permlane32_swap(__float_as_uint(pmax), __float_as_uint(pmax), false, false);
    pmax = fmaxf(__uint_as_float(rr[0]), __uint_as_float(rr[1])); }
  if (__builtin_expect(__all(pmax <= THR2), 1)) { mn = m_reg; alpha = 1.f; }
  else { const float pm = fmaxf(pmax, 0.f); mn = m_reg + pm; alpha = __builtin_amdgcn_exp2f(-pm); m_reg = mn;
#pragma unroll
    for (int r = 0; r < 16; ++r) { p0[r] -= pm; p1[r] -= pm; } }
#pragma unroll
  for (int r = 0; r < 16; ++r) p0[r] = __builtin_amdgcn_exp2f(p0[r]);
}
__device__ __forceinline__ void finishSM(f32x16& p0, f32x16& p1, float alpha, float& l_reg, bf16x8& pa0, bf16x8& pa1, bf16x8& pa2, bf16x8& pa3) {
#pragma unroll
  for (int r = 0; r < 16; ++r) p1[r] = __builtin_amdgcn_exp2f(p1[r]);
  f32x2 ps2 = {0.f, 0.f};
#pragma unroll
  for (int r = 0; r < 16; r += 2) ps2 += (f32x2){p0[r], p0[r + 1]};
#pragma unroll
  for (int r = 0; r < 16; r += 2) ps2 += (f32x2){p1[r], p1[r + 1]};
  float ps = ps2[0] + ps2[1];
  { auto rr = __builtin_amdgcn_permlane32_swap(__float_as_uint(ps), __float_as_uint(ps), false, false);
    ps = __uint_as_float(rr[0]) + __uint_as_float(rr[1]); }
  l_reg = l_reg * alpha + ps;
#define PK4(P, BASE, OUT) do { unsigned a0 = cvtpk(P[BASE + 0], P[BASE + 1]), a1 = cvtpk(P[BASE + 2], P[BASE + 3]);   \
    unsigned b0 = cvtpk(P[BASE + 4], P[BASE + 5]), b1 = cvtpk(P[BASE + 6], P[BASE + 7]);                              \
    auto r0 = __builtin_amdgcn_permlane32_swap(a0, b0, false, false); auto r1 = __builtin_amdgcn_permlane32_swap(a1, b1, false, false); \
    u32x4 w = {r0[0], r1[0], r0[1], r1[1]}; OUT = __builtin_bit_cast(bf16x8, w); } while (0)
  PK4(p0, 0, pa0); PK4(p0, 8, pa1); PK4(p1, 0, pa2); PK4(p1, 8, pa3);
#undef PK4
}
__device__ __forceinline__ void qkt(f32x16& p0, f32x16& p1, const char* Ks, const bf16x8* qr, int r32, int hi, int c) {
  p0 = f32x16{}; p1 = f32x16{};
#pragma unroll
  for (int d0 = 0; d0 < 4; ++d0) { const int cb = (c * 64 + d0 * 16 + hi * 8) * 2;
    bf16x8 b0 = *reinterpret_cast<const bf16x8*>(Ks + KSWZ(r32, cb));
    bf16x8 b1 = *reinterpret_cast<const bf16x8*>(Ks + KSWZ(32 + r32, cb));
    p0 = __builtin_amdgcn_mfma_f32_32x32x16_bf16(b0, qr[d0], p0, 0, 0, 0);
    p1 = __builtin_amdgcn_mfma_f32_32x32x16_bf16(b1, qr[d0], p1, 0, 0, 0); }
}
__device__ __forceinline__ int v_st(int k, int c) { const int kk = (k & ~0xC) | ((k & 4) << 1) | ((k & 8) >> 1); return ((kk >> 3) * 4 + (c >> 5)) * 512 + ((kk & 7) * 32 + (c & 31)) * 2; }
__device__ __forceinline__ int v_rd_base(int lane) { return ((lane & 3) << 3) | (((lane >> 2) & 3) << 6) | (((lane >> 4) & 1) << 5) | (((lane >> 5) & 1) << 8); }
constexpr int v_rd_off(int d0, int ks, int half) { return d0 * 512 + ks * 4096 + half * 2048; }
template <int OFF> __device__ __forceinline__ s16x4 tr_read(int vb) {
  s16x4 r; asm volatile("ds_read_b64_tr_b16 %0, %1 offset:%2" : "=&v"(r) : "v"(vb), "i"(OFF) : "memory"); return r;
}
template <int D0> __device__ __forceinline__ void pv_one(f32x16& od, int vb, bf16x8 pa0, bf16x8 pa1, bf16x8 pa2, bf16x8 pa3) {
  const s16x4 l0 = tr_read<v_rd_off(D0, 0, 0)>(vb), h0 = tr_read<v_rd_off(D0, 0, 1)>(vb), l1 = tr_read<v_rd_off(D0, 1, 0)>(vb), h1 = tr_read<v_rd_off(D0, 1, 1)>(vb);
  const s16x4 l2 = tr_read<v_rd_off(D0, 2, 0)>(vb), h2 = tr_read<v_rd_off(D0, 2, 1)>(vb), l3 = tr_read<v_rd_off(D0, 3, 0)>(vb), h3 = tr_read<v_rd_off(D0, 3, 1)>(vb);
  asm volatile("s_waitcnt lgkmcnt(0)" ::: "memory"); SBAR();
#define PK(L, H) (bf16x8){L[0], L[1], L[2], L[3], H[0], H[1], H[2], H[3]}
  od = __builtin_amdgcn_mfma_f32_32x32x16_bf16(pa0, PK(l0, h0), od, 0, 0, 0);
  od = __builtin_amdgcn_mfma_f32_32x32x16_bf16(pa1, PK(l1, h1), od, 0, 0, 0);
  od = __builtin_amdgcn_mfma_f32_32x32x16_bf16(pa2, PK(l2, h2), od, 0, 0, 0);
  od = __builtin_amdgcn_mfma_f32_32x32x16_bf16(pa3, PK(l3, h3), od, 0, 0, 0);
#undef PK
}
__device__ __forceinline__ void pv_d0(f32x16* o, int vb, bf16x8 pa0, bf16x8 pa1, bf16x8 pa2, bf16x8 pa3) {
  pv_one<0>(o[0], vb, pa0, pa1, pa2, pa3); pv_one<1>(o[1], vb, pa0, pa1, pa2, pa3); pv_one<2>(o[2], vb, pa0, pa1, pa2, pa3); pv_one<3>(o[3], vb, pa0, pa1, pa2, pa3);
}
__device__ __forceinline__ void pv_sm1(f32x16* o, int vb, bf16x8 pa0, bf16x8 pa1, bf16x8 pa2, bf16x8 pa3, f32x16& p0, f32x16& p1, float& m_reg, float& mn, float& alpha, float dqs, float sl2, int side) {
  constexpr float C = 0.125f * L2E;
  const float sg = side > 0 ? -sl2 : sl2, D0 = side > 0 ? (m_reg + dqs) : (m_reg - dqs);
  const f32x2 sg2 = {sg, sg}, C2 = {C, C}, Da = {D0, D0}, Db = {fmaf(sg, 32.f, D0), fmaf(sg, 32.f, D0)};
  pv_one<0>(o[0], vb, pa0, pa1, pa2, pa3);
#pragma unroll
  for (int r = 0; r < 16; r += 2) { const f32x2 kk = {(float)((r & 3) + 8 * (r >> 2)), (float)(((r + 1) & 3) + 8 * ((r + 1) >> 2))};
    const f32x2 x0 = __builtin_elementwise_fma((f32x2){p0[r], p0[r + 1]}, C2, -__builtin_elementwise_fma(sg2, kk, Da)); p0[r] = x0[0]; p0[r + 1] = x0[1]; }
  pv_one<1>(o[1], vb, pa0, pa1, pa2, pa3);
#pragma unroll
  for (int r = 0; r < 16; r += 2) { const f32x2 kk = {(float)((r & 3) + 8 * (r >> 2)), (float)(((r + 1) & 3) + 8 * ((r + 1) >> 2))};
    const f32x2 x1 = __builtin_elementwise_fma((f32x2){p1[r], p1[r + 1]}, C2, -__builtin_elementwise_fma(sg2, kk, Db)); p1[r] = x1[0]; p1[r + 1] = x1[1]; }
  pv_one<2>(o[2], vb, pa0, pa1, pa2, pa3);
  float pmax = p0[0];
#pragma unroll
  for (int r = 1; r < 16; ++r) pmax = fmaxf(pmax, p0[r]);
#pragma unroll
  for (int r = 0; r < 16; ++r) pmax = fmaxf(pmax, p1[r]);
  { auto rr = __builtin_amdgcn_permlane32_swap(__float_as_uint(pmax), __float_as_uint(pmax), false, false);
    pmax = fmaxf(__uint_as_float(rr[0]), __uint_as_float(rr[1])); }
  if (__builtin_expect(__all(pmax <= THR2), 1)) { mn = m_reg; alpha = 1.f; }
  else { const float pm = fmaxf(pmax, 0.f); mn = m_reg + pm; alpha = __builtin_amdgcn_exp2f(-pm); m_reg = mn;
#pragma unroll
    for (int r = 0; r < 16; ++r) { p0[r] -= pm; p1[r] -= pm; } }
  pv_one<3>(o[3], vb, pa0, pa1, pa2, pa3);
#pragma unroll
  for (int r = 0; r < 16; ++r) p0[r] = __builtin_amdgcn_exp2f(p0[r]);
}
constexpr int XS = 132;

__device__ __forceinline__ void attn_unit(int unit, const bf16_t* __restrict__ proj, bf16_t* __restrict__ mix, const float* __restrict__ subln_g, float lam, char* lds) {
  const int b = unit >> 6, h = (unit >> 4) & 3, qb = unit & 15;
  int tid_l = threadIdx.x; asm volatile("" : "+v"(tid_l));
  const int tid = tid_l, wid = tid >> 6, lane = tid & 63, r32 = lane & 31, hi = lane >> 5, c = wid >> 2, wq = wid & 3;
  const int q0 = qb * 128;
  const bf16_t* Qb = proj + (size_t)(b * SEQ + q0) * LD + h * 128 + c * 64;
  const bf16_t* Kh = proj + (size_t)(b * SEQ) * LD + 512 + h * 128;
  const bf16_t* Vh = proj + (size_t)(b * SEQ) * LD + 1024 + h * 128;
  char* V_lds = lds; char* K_lds = lds + 3 * SHM_V;
  float* ws = (float*)(lds + 3 * SHM_V + 3 * SHM_K) + wid * 64; float* li_l = ws; float* al_l = ws + 32;
  float m_reg = -1e30f, l_reg = 0; f32x16 o[4] = {}; bf16x8 qr[4];
  const bf16_t* Qw = Qb + (size_t)(wq * 32 + r32) * LD + hi * 8;
#pragma unroll
  for (int d0 = 0; d0 < 4; ++d0) qr[d0] = *reinterpret_cast<const bf16x8*>(Qw + d0 * 16);
  const float sl2 = __builtin_amdgcn_exp2f(-2.f * (float)(h + 1)) * L2E;
  float dqs = sl2 * (float)(q0 + wq * 32 + r32 - 4 * hi);
  const int sr = tid >> 4, sc = (tid & 15) * 8, vst0 = v_st(sr, sc), vst1 = v_st(32 + sr, sc);
  const int vb0 = (int)(uintptr_t)V_lds + v_rd_base(lane);
  struct { bf16x8 vs0, vs1, ks0, ks1; } sr_[1];
#define SLOAD(i, k0) do { sr_[i].vs0 = *(const bf16x8*)(&Vh[(size_t)((k0) + sr) * LD + sc]); sr_[i].vs1 = *(const bf16x8*)(&Vh[(size_t)((k0) + 32 + sr) * LD + sc]); \
    sr_[i].ks0 = *(const bf16x8*)(&Kh[(size_t)((k0) + sr) * LD + sc]); sr_[i].ks1 = *(const bf16x8*)(&Kh[(size_t)((k0) + 32 + sr) * LD + sc]); } while (0)
#define SWRITE(bb, i) do { *(bf16x8*)(V_lds + (bb) * SHM_V + vst0) = sr_[i].vs0;          \
    *(bf16x8*)(V_lds + (bb) * SHM_V + vst1) = sr_[i].vs1; int kc = sc * 2;               \
    *(bf16x8*)(K_lds + (bb) * SHM_K + KSWZ(sr, kc)) = sr_[i].ks0;                       \
    *(bf16x8*)(K_lds + (bb) * SHM_K + KSWZ(32 + sr, kc)) = sr_[i].ks1; } while (0)
#define SWAIT() asm volatile("s_waitcnt vmcnt(0)" ::: "memory")
#define RESC(a) do { if (__any((a) < 1.f)) { if (hi == 0) al_l[r32] = (a); asm volatile("s_waitcnt lgkmcnt(0)" ::: "memory"); \
    _Pragma("unroll") for (int d = 0; d < 4; ++d) _Pragma("unroll") for (int r = 0; r < 16; ++r) o[d][r] *= al_l[crow(r, hi)]; } } while (0)
  f32x16 pA0, pA1, pB0, pB1; float mnA, mnB, alA, alB; bf16x8 pa0, pa1, pa2, pa3; constexpr int NT = SEQ / KVBLK;
  const int jd = 2 * qb; const float dq0 = dqs;
#define TK(j) ((((j) + jd) & (NT - 1)) * KVBLK)
#define DQS(j) fmaf(-sl2, (float)TK(j), dq0)
  SLOAD(0, TK(0)); asm volatile("s_waitcnt vmcnt(0)" ::: "memory"); SWRITE(0, 0);
  SLOAD(0, TK(1)); asm volatile("s_waitcnt vmcnt(0)" ::: "memory"); SWRITE(1, 0); __syncthreads();
  qkt(pA0, pA1, K_lds, qr, r32, hi, c); partialSM(pA0, pA1, m_reg, mnA, alA, DQS(0), sl2);
  const int qw0 = q0 + wq * 32;
  int cb = 0;
#define ATT_STEP(PC0, PC1, ALC, PN0, PN1, MNN, ALN, J) do { const int nb_ = (cb == 2) ? 0 : cb + 1, wb_ = (nb_ == 2) ? 0 : nb_ + 1; \
    SBAR(); qkt(PN0, PN1, K_lds + nb_ * SHM_K, qr, r32, hi, c); \
    finishSM(PC0, PC1, ALC, l_reg, pa0, pa1, pa2, pa3); SBAR(); \
    if ((J) + 2 < NT) SLOAD(0, TK((J) + 2)); SBAR(); \
    { const int kn_ = TK((J) + 1); const float dqs = DQS((J) + 1); const int side_ = (kn_ + KVBLK - 1 < qw0) ? 1 : ((kn_ > qw0 + 31) ? -1 : 0); \
      if (side_ != 0) pv_sm1(o, vb0 + cb * (int)SHM_V, pa0, pa1, pa2, pa3, PN0, PN1, m_reg, MNN, ALN, dqs, sl2, side_); \
      else { pv_d0(o, vb0 + cb * (int)SHM_V, pa0, pa1, pa2, pa3); partialSM(PN0, PN1, m_reg, MNN, ALN, dqs, sl2); } } \
    if ((J) + 2 < NT) { SWAIT(); SWRITE(wb_, 0); } \
    RESC(ALN); __syncthreads(); cb = nb_; } while (0)
  for (int j = 0; j + 2 < NT; j += 2) {
    ATT_STEP(pA0, pA1, alA, pB0, pB1, mnB, alB, j);
    ATT_STEP(pB0, pB1, alB, pA0, pA1, mnA, alA, j + 1);
  }
  ATT_STEP(pA0, pA1, alA, pB0, pB1, mnB, alB, NT - 2);
  finishSM(pB0, pB1, alB, l_reg, pa0, pa1, pa2, pa3); SBAR();
  pv_d0(o, vb0 + cb * (int)SHM_V, pa0, pa1, pa2, pa3);
#undef ATT_STEP
#undef TK
#undef DQS
  if (hi == 0) li_l[r32] = l_reg; asm volatile("s_waitcnt lgkmcnt(0)" ::: "memory");
  float rli[16];
#pragma unroll
  for (int r = 0; r < 16; ++r) rli[r] = __builtin_amdgcn_rcpf(li_l[crow(r, hi)]);
  asm volatile("s_waitcnt vmcnt(0)" ::: "memory");
  __syncthreads();
  float* X = (float*)lds + c * (128 * XS);
#pragma unroll
  for (int r = 0; r < 16; ++r) { const int orow = wq * 32 + crow(r, hi);
#pragma unroll
    for (int d0 = 0; d0 < 4; ++d0) X[orow * XS + d0 * 32 + r32] = o[d0][r] * rli[r]; }
  __syncthreads();
  { const int row = tid >> 2, q = tid & 3; const float* X1 = (const float*)lds + row * XS + q * 32; const float* X2 = X1 + 128 * XS;
    f32x4 v[8]; float ss = 0.f;
#pragma unroll
    for (int i = 0; i < 8; ++i) { const int ii = (i + 4 * (q >> 1)) & 7; const f32x4 a = *(const f32x4*)(X1 + 4 * ii), bb = *(const f32x4*)(X2 + 4 * ii);
      v[i] = a - lam * bb; ss += (v[i][0] * v[i][0] + v[i][1] * v[i][1]) + (v[i][2] * v[i][2] + v[i][3] * v[i][3]); }
    ss += __shfl_xor(ss, 1); ss += __shfl_xor(ss, 2);
    const float rn = __builtin_amdgcn_rsqf(ss * (1.f / 128.f) + EPS) * 0.8f * EXP_ATTSCALE;
    bf16_t* orow = mix + (size_t)(b * SEQ + q0 + row) * DM + h * 128 + q * 32;
#pragma unroll
    for (int i = 0; i < 8; i += 2) { const int i0 = (i + 4 * (q >> 1)) & 7;
      const f32x4 g0 = *(const f32x4*)(subln_g + q * 32 + 4 * i0), g1 = *(const f32x4*)(subln_g + q * 32 + 4 * i0 + 4);
      const f32x4 a = v[i] * rn * g0, bb = v[i + 1] * rn * g1;
      u32x4 w = {cvtpk(a[0], a[1]), cvtpk(a[2], a[3]), cvtpk(bb[0], bb[1]), cvtpk(bb[2], bb[3])};
      *(u32x4*)(orow + 4 * i0) = w; } }
  __syncthreads();
#undef SLOAD
#undef SWRITE
#undef SWAIT
#undef RESC
}
}
namespace lru {
__device__ __forceinline__ int crow(int r, int hi) { return (r & 3) + 8 * (r >> 2) + 4 * hi; }
__device__ __forceinline__ f32x8 lds_ld8(const LAS float* p) { const f32x4 a = *(const LAS f32x4*)p, b = *(const LAS f32x4*)(p + 4); return (f32x8){a[0], a[1], a[2], a[3], b[0], b[1], b[2], b[3]}; }
__device__ __forceinline__ void lds_st8(LAS float* p, f32x8 v) { *(LAS f32x4*)p = (f32x4){v[0], v[1], v[2], v[3]}; *(LAS f32x4*)(p + 4) = (f32x4){v[4], v[5], v[6], v[7]}; }
struct Params { const bf16_t* proj; float* ys; bf16_t* mix; unsigned* pair_cnt; const float *conv_w, *conv_b, *w_a, *b_a, *w_x, *b_x, *lambda; };
__device__ __forceinline__ void lru_item(int item, const Params& p, LAS unsigned char* lds) {
  int tid_l = threadIdx.x; asm volatile("" : "+v"(tid_l));
  const int tid = tid_l, wid = __builtin_amdgcn_readfirstlane(tid >> 6), lane = tid & 63, r32 = lane & 31, hi = lane >> 5;
  const int dir = item & 1, seg = wid, b = item >> 4, n = (item >> 1) & 7;
  LAS float* xcu = (LAS float*)(lds + wid * 16896);
  LAS float* abuf = (LAS float*)(lds + wid * 16896 + 8704);
  LAS float* tot = (LAS float*)(lds + LDS_TOT);
  LAS float* cwl = (LAS float*)(lds + LDS_CW);
  if (tid < 320) { const int k = tid >> 6, ch = tid & 63; cwl[tid] = (k < 4) ? p.conv_w[k * 512 + 64 * n + ch] : p.conv_b[64 * n + ch]; }
  bf16x8 Bf[2][2][4];
#pragma unroll
  for (int g = 0; g < 2; ++g) { const float* W = (g == 0 ? p.w_a : p.w_x) + (size_t)((dir * 8 + n) * 64) * 64;
#pragma unroll
    for (int nb = 0; nb < 2; ++nb)
#pragma unroll
      for (int s = 0; s < 4; ++s) { f32x8 w;
#pragma unroll
        for (int j = 0; j < 8; ++j) w[j] = W[(16 * s + 8 * hi + j) * 64 + 32 * nb + r32];
        Bf[g][nb][s] = pack8(w); } }
  float ba[2], bx[2], cl2[2];
#pragma unroll
  for (int nb = 0; nb < 2; ++nb) { const int ch = dir * 512 + 64 * n + 32 * nb + r32; ba[nb] = p.b_a[ch]; bx[nb] = p.b_x[ch];
    const float lam = p.lambda[ch]; const float sp = (lam > 15.f) ? __expf(-lam) : log1pf(__expf(-lam));
    cl2[nb] = 8.f * sp * L2E; }
  float hc = 0.f;
  __syncthreads();
  const bf16_t* xr_base = p.proj + (size_t)(b * SEQ) * INW + 1536 + 64 * n;
  float* ybase = p.ys + (size_t)dir * T_ * 512 + (size_t)(b * SEQ) * 512 + 64 * n;
  u32x4 pre[5];
#define LRU_LOAD_RAW(T0) do { _Pragma("unroll") for (int i = 0; i < 5; ++i) { const int row = i * 8 + (lane >> 3), tt = (T0) - 2 + row; pre[i] = (u32x4){0u, 0u, 0u, 0u}; \
      if (row < 35 && tt >= 0 && tt < SEQ) pre[i] = *(const u32x4*)(xr_base + (size_t)tt * INW + (lane & 7) * 8); } } while (0)
  LRU_LOAD_RAW((dir ? 7 : 0) * 256 + seg * 32);
  for (int it = 0; it < 8; ++it) {
    const int tile = dir ? 7 - it : it, t0 = tile * 256 + seg * 32;
    { LAS unsigned char* raw = (LAS unsigned char*)abuf;
#pragma unroll
      for (int i = 0; i < 5; ++i) { const int row = i * 8 + (lane >> 3); if (row < 35) *(LAS u32x4*)(raw + row * 144 + (lane & 7) * 16) = pre[i]; }
      if (it < 7) LRU_LOAD_RAW((dir ? 6 - it : it + 1) * 256 + seg * 32);
#pragma unroll
      for (int cc = 0; cc < 4; ++cc) { const int ch0 = 32 * hi + 8 * cc;
        f32x8 acc = lds_ld8(cwl + 4 * 64 + ch0);
#pragma unroll
        for (int k = 0; k < 4; ++k) { const bf16x8 v = *(LAS const bf16x8*)(raw + (r32 + k) * 144 + ch0 * 2); const f32x8 w = lds_ld8(cwl + k * 64 + ch0);
#pragma unroll
          for (int j = 0; j < 8; ++j) acc[j] += w[j] * bf2f(v[j]); }
        lds_st8(xcu + r32 * 68 + ch0, acc); } }
    bf16x8 af[4];
#pragma unroll
    for (int s = 0; s < 4; ++s) af[s] = pack8(lds_ld8(xcu + r32 * 68 + 16 * s + 8 * hi));
#pragma unroll
    for (int nb = 0; nb < 2; ++nb) {
      f32x16 acca = {}, accx = {};
#pragma unroll
      for (int s = 0; s < 4; ++s) { acca = __builtin_amdgcn_mfma_f32_32x32x16_bf16(af[s], Bf[0][nb][s], acca, 0, 0, 0); accx = __builtin_amdgcn_mfma_f32_32x32x16_bf16(af[s], Bf[1][nb][s], accx, 0, 0, 0); }
#pragma unroll
      for (int rg = 0; rg < 16; ++rg) { const int tk = crow(rg, hi), ch = 32 * nb + r32;
        const float xc = xcu[tk * 68 + ch];
        const float ga = acca[rg] + ba[nb], gx = accx[rg] + bx[nb];
        const float r = __builtin_amdgcn_rcpf(1.f + __builtin_amdgcn_exp2f(-ga * L2E)), ii = __builtin_amdgcn_rcpf(1.f + __builtin_amdgcn_exp2f(-gx * L2E));
        const float a = __builtin_amdgcn_exp2f(-cl2[nb] * r);
        const float u = __builtin_amdgcn_sqrtf(fmaxf(fmaf(-a, a, 1.f), 0.f)) * ii * xc;
        abuf[tk * 64 + ch] = a; xcu[tk * 68 + ch] = u; }
    }
    { float P = 1.f, H = 0.f;
#pragma unroll 8
      for (int j = 0; j < 32; ++j) { const int tk = dir ? 31 - j : j; const float a = abuf[tk * 64 + lane], u = xcu[tk * 68 + lane];
        H = a * H + u; P *= a; abuf[tk * 64 + lane] = P; xcu[tk * 68 + lane] = H; }
      LAS float* tt = tot + (((it & 1) * 8 + seg) * 128);
      tt[lane] = P; tt[64 + lane] = H; }
    __syncthreads();
    float cin = hc;
    { float c = hc;
#pragma unroll
      for (int j = 0; j < 8; ++j) { const int sg = dir ? 7 - j : j; const LAS float* tt = tot + (((it & 1) * 8 + sg) * 128);
        const float Pj = tt[lane], Hj = tt[64 + lane]; if (sg == seg) cin = c; c = Pj * c + Hj; }
      hc = c; }
#pragma unroll 8
    for (int tk = 0; tk < 32; ++tk) __hip_atomic_store(ybase + (size_t)(t0 + tk) * 512 + lane, xcu[tk * 68 + lane] + abuf[tk * 64 + lane] * cin, __ATOMIC_RELAXED, __HIP_MEMORY_SCOPE_AGENT);
  }
  asm volatile("s_waitcnt vmcnt(0)" ::: "memory"); __syncthreads();
  volatile LAS unsigned* misc = (volatile LAS unsigned*)(lds + LDS_MISC);
  if (tid == 0) misc[1] = __hip_atomic_fetch_add(p.pair_cnt + (b * 8 + n), 1u, __ATOMIC_RELAXED, __HIP_MEMORY_SCOPE_AGENT);
  __syncthreads();
  const unsigned arrived = misc[1];
  if (arrived == 1u) {
    __builtin_amdgcn_fence(__ATOMIC_ACQUIRE, "agent");
    const float* yf = p.ys + (size_t)(b * SEQ) * 512 + 64 * n; const float* yb = yf + (size_t)T_ * 512;
    const bf16_t* gr = p.proj + (size_t)(b * SEQ) * INW + 2048 + 64 * n; bf16_t* mo = p.mix + (size_t)(b * SEQ) * DM + 512 + 64 * n;
#pragma unroll 8
    for (int idx = tid; idx < SEQ * 8; idx += 512) { const int t = idx >> 3, c8 = (idx & 7) * 8;
      const f32x8 a = *(const f32x8*)(yf + (size_t)t * 512 + c8), bb = *(const f32x8*)(yb + (size_t)t * 512 + c8); const bf16x8 g = *(const bf16x8*)(gr + (size_t)t * INW + c8);
      f32x8 o;
#pragma unroll
      for (int j = 0; j < 8; ++j) o[j] = gelu_tanh(bf2f(g[j])) * (a[j] + bb[j]) * EXP_LRUSCALE;
      *(bf16x8*)(mo + (size_t)t * DM + c8) = pack8(o); } }
  __syncthreads();
}
#undef LRU_LOAD_RAW
}
template <bool UPMAP>
__device__ __forceinline__ void p0_transpose_item(const float* __restrict__ W, int K, int N, bf16_t* WT, const float* __restrict__ kscale, LAS float* scr, int item, int lane) {
    const int nblk = N / 32, kb = item / nblk, nb = item % nblk, k0 = 64 * kb, n0 = 32 * nb;
#pragma unroll
    for (int i = 0; i < 32; ++i) { const int kk = 2 * i + (lane >> 5); float w = W[(size_t)(k0 + kk) * N + n0 + (lane & 31)]; if (kscale) w *= kscale[k0 + kk]; scr[kk * 33 + (lane & 31)] = w; }
    asm volatile("s_waitcnt lgkmcnt(0)" ::: "memory");
    const int c = lane & 7;
#pragma unroll
    for (int j = 0; j < 4; ++j) { const int n = (lane >> 3) + 8 * j; const LAS float* s = scr + (8 * c) * 33 + n;
        u32x4 o; o.x = cvtpk(s[0 * 33], s[1 * 33]); o.y = cvtpk(s[2 * 33], s[3 * 33]); o.z = cvtpk(s[4 * 33], s[5 * 33]); o.w = cvtpk(s[6 * 33], s[7 * 33]);
        int row = n0 + n;
        if (UPMAP) { const int f = row < FF ? row : row - FF; row = (f >> 7) * 256 + (row < FF ? 0 : 128) + (f & 127); }
        *(u32x4*)(WT + (size_t)row * K + k0 + 8 * c) = o; }
    asm volatile("s_waitcnt lgkmcnt(0)" ::: "memory");
}

#define XB_TMO      128
#define XB_XCNT(j)  (256  + 64 * (j))
#define XB_XSUB(j)  (1280 + 64 * (j))
#define XB_XGEN(j)  (2304 + 64 * (j))
#define XB_TOP      3328
#define XB_TOPGEN   3392
#define XCD_BAR_WORDS 3456
#define XB_SPIN_CAP (1u << 18)

__device__ __forceinline__ unsigned xb_ld(unsigned* p)              { return __hip_atomic_load(p, __ATOMIC_RELAXED, __HIP_MEMORY_SCOPE_AGENT); }
__device__ __forceinline__ unsigned xb_add(unsigned* p, unsigned v) { return __hip_atomic_fetch_add(p, v, __ATOMIC_RELAXED, __HIP_MEMORY_SCOPE_AGENT); }
__device__ __forceinline__ unsigned xb_xcc_id() { return (unsigned)__builtin_amdgcn_s_getreg((3 << 11) | 20) & 0xFu; }
#define XB_SPIN(cond, bar) do { unsigned _sp = 0; while (cond) { __builtin_amdgcn_s_sleep(1); \
    if ((++_sp & 255u) == 0u) { if (xb_ld(&(bar)[XB_TMO])) break; if (_sp > XB_SPIN_CAP) { atomicAdd(&(bar)[XB_TMO], 1u); break; } } } } while (0)

struct XcdBarrier {
    unsigned* bar; unsigned x;
    volatile LAS unsigned* st;
};

__device__ __forceinline__ XcdBarrier xcd_barrier_post(unsigned* bar, volatile LAS unsigned* st) {
    XcdBarrier b; b.bar = bar; b.x = xb_xcc_id(); b.st = st;
    if (threadIdx.x == 0) (void)xb_add(&bar[XB_XCNT(b.x)], 1u);
    return b;
}
__device__ __forceinline__ void xcd_barrier_complete(unsigned* bar, unsigned x, unsigned& nloc, unsigned& nx) {
    const unsigned G = gridDim.x * gridDim.y * gridDim.z;
    unsigned sum, cnt, mine, sp = 0u;
    for (;;) {
        sum = 0u; cnt = 0u; mine = 0u;
#pragma unroll
        for (unsigned j = 0; j < 16; ++j) { const unsigned c = xb_ld(&bar[XB_XCNT(j)]); sum += c; cnt += (c > 0u) ? 1u : 0u; mine = (j == x) ? c : mine; }
        if (sum == G) break;
        __builtin_amdgcn_s_sleep(1);
        if ((++sp & 255u) == 0u) { if (xb_ld(&bar[XB_TMO])) break; if (sp > XB_SPIN_CAP) { atomicAdd(&bar[XB_TMO], 1u); break; } }
    }
    nloc = mine > 0u ? mine : 1u; nx = cnt > 0u ? cnt : 1u;
}

__device__ __forceinline__ void xcd_barrier(const XcdBarrier& b) {
    asm volatile("s_waitcnt vmcnt(0)" ::: "memory");
    __syncthreads();
    if (threadIdx.x == 0) {
        unsigned* bar = b.bar;
        __builtin_amdgcn_s_waitcnt(0);
        unsigned nloc = b.st[0], nx = b.st[1];
        if (nloc == 0u) { xcd_barrier_complete(bar, b.x, nloc, nx); b.st[0] = nloc; b.st[1] = nx; }
        const unsigned old = xb_add(&bar[XB_XSUB(b.x)], 1u);
        const unsigned gen = old / nloc;
        if (old + 1u == (gen + 1u) * nloc) {
            __builtin_amdgcn_fence(__ATOMIC_RELEASE, "agent");
            asm volatile("s_waitcnt vmcnt(0)" ::: "memory");
            const unsigned og = xb_add(&bar[XB_TOP], 1u);
            const unsigned tg = og / nx;
            if (og + 1u == (tg + 1u) * nx) xb_add(&bar[XB_TOPGEN], 1u);
            else XB_SPIN(xb_ld(&bar[XB_TOPGEN]) == tg, bar);
            __builtin_amdgcn_fence(__ATOMIC_ACQUIRE, "agent");
            xb_add(&bar[XB_XGEN(b.x)], 1u);
            asm volatile("s_waitcnt vmcnt(0)" ::: "memory");
        } else {
            XB_SPIN(xb_ld(&bar[XB_XGEN(b.x)]) == gen, bar);
            __builtin_amdgcn_fence(__ATOMIC_ACQUIRE, "agent");
            asm volatile("s_waitcnt vmcnt(0)" ::: "memory");
        }
    }
    __syncthreads();
}

#ifndef PHMASK
#define PHMASK 127
#endif
struct Args { const float* in[22]; float* out; unsigned char* ws; };

__global__ void __launch_bounds__(512, 2) hymba_fwd(Args args) {
    extern __shared__ __attribute__((aligned(16))) unsigned char lds_raw[];
    LAS unsigned char* lds = (LAS unsigned char*)lds_raw;
    cg::grid_group grid = cg::this_grid();
    const int G = gridDim.x, bx = blockIdx.x;
    if (threadIdx.x < 32) ((volatile LAS unsigned*)(lds + LDS_MISC))[threadIdx.x] = 0u;
    __syncthreads();
    unsigned* barw = (unsigned*)(args.ws + WS_BAR);
    unsigned char* ws = args.ws;
    const float* x = args.in[0];
    unsigned* queue = (unsigned*)(ws + WS_QUEUE);
    float* ss1 = (float*)(ws + WS_SS1); float* ss2 = (float*)(ws + WS_SS2); float* rs0 = (float*)(ws + WS_RS0);
    bf16_t* Win_t = (bf16_t*)(ws + WS_WIN); bf16_t* Wout_t = (bf16_t*)(ws + WS_WOUT); bf16_t* Wup_t = (bf16_t*)(ws + WS_WUP); bf16_t* Wdn_t = (bf16_t*)(ws + WS_WDN);
    bf16_t* XB = (bf16_t*)(ws + WS_XB); bf16_t* PROJ = (bf16_t*)(ws + WS_PROJ); bf16_t* MIX = (bf16_t*)(ws + WS_MIX); bf16_t* ACT = (bf16_t*)(ws + WS_ACT);
    float* YS = (float*)(ws + WS_YS);

#if (PHMASK >> 0) & 1
    for (int rep = 0; rep < EXP_REP_P0; ++rep) {
        int tl = threadIdx.x; asm volatile("" : "+v"(tl)); const int tid = tl, lane = tl & 63, wave = __builtin_amdgcn_readfirstlane(tl >> 6);
        const int gw = bx * 8 + wave, NGW = G * 8;
        for (int i = bx * 512 + tid; i < (int)(WS_ZERO_BYTES / 4); i += G * 512) if (i < (int)(WS_RS0 / 4) || i >= (int)(WS_BAR / 4)) ((unsigned*)ws)[i] = 0u;
        LAS float* scr = (LAS float*)(lds + wave * 16384);
        constexpr int I_IN = (DM / 64) * (INW / 32);
        for (int it = gw; it < I_IN; it += NGW) p0_transpose_item<false>(args.in[2], DM, INW, Win_t, args.in[1], scr, it, lane);
        for (int m0 = gw; m0 < T_; m0 += 2 * NGW) {
            const int m1 = m0 + NGW;
            const f32x4* xa = (const f32x4*)(x + (size_t)m0 * DM) + lane; const f32x4* xb2 = (const f32x4*)(x + (size_t)(m1 < T_ ? m1 : m0) * DM) + lane;
            f32x4 va[4], vb[4]; float sa = 0.f, sb = 0.f;
#pragma unroll
            for (int j = 0; j < 4; ++j) { va[j] = xa[64 * j]; vb[j] = xb2[64 * j]; }
#pragma unroll
            for (int j = 0; j < 4; ++j) { sa += (va[j][0] * va[j][0] + va[j][1] * va[j][1]) + (va[j][2] * va[j][2] + va[j][3] * va[j][3]); sb += (vb[j][0] * vb[j][0] + vb[j][1] * vb[j][1]) + (vb[j][2] * vb[j][2] + vb[j][3] * vb[j][3]); }
            sa = wave_sum(sa); sb = wave_sum(sb);
            u32x2* oa = (u32x2*)(XB + (size_t)m0 * DM) + lane;
#pragma unroll
            for (int j = 0; j < 4; ++j) { u32x2 w; w.x = cvtpk(va[j][0], va[j][1]); w.y = cvtpk(va[j][2], va[j][3]); oa[64 * j] = w; }
            if (lane == 0) rs0[m0] = __builtin_amdgcn_rsqf(sa * (1.f / DM) + EPS);
            if (m1 < T_) { u32x2* ob = (u32x2*)(XB + (size_t)m1 * DM) + lane;
#pragma unroll
                for (int j = 0; j < 4; ++j) { u32x2 w; w.x = cvtpk(vb[j][0], vb[j][1]); w.y = cvtpk(vb[j][2], vb[j][3]); ob[64 * j] = w; }
                if (lane == 0) rs0[m1] = __builtin_amdgcn_rsqf(sb * (1.f / DM) + EPS); }
        }
    }
#endif
    grid.sync();
    const XcdBarrier xbar = xcd_barrier_post(barw, (volatile LAS unsigned*)(lds + LDS_MISC) + 8);

    for (int rep = 0; rep < EXP_EXTRA_SYNC; ++rep) xcd_barrier(xbar);
#if (PHMASK >> 1) & 1
    for (int rep = 0; rep < EXP_REP_P1; ++rep) {
        pg8::Gemm g{XB, Win_t, T_, INW, DM, 256}; pg8::StaticOrder S; S.init(T_, INW, G, bx);
        pg8::EpiProj E{PROJ, INW, rs0};
        pg8::gemm_phase<pg8::EpiProj, pg8::StaticOrder, true, true>(lds, g, S, E);
    }
#endif
    xcd_barrier(xbar);

#if (PHMASK >> 2) & 1
    {
        int tl = threadIdx.x; asm volatile("" : "+v"(tl)); const int tid = tl;
        float lam;
        { float d1 = 0.f, d2 = 0.f;
          for (int i = 0; i < 64; ++i) { d1 += args.in[3][i] * args.in[4][i]; d2 += args.in[5][i] * args.in[6][i]; }
          lam = __expf(d1) - __expf(d2) + 0.2f; }
        lru::Params lp{PROJ, YS, MIX, (unsigned*)(ws + WS_LCNT), args.in[8], args.in[9], args.in[10], args.in[11], args.in[12], args.in[13], args.in[14]};
        volatile LAS unsigned* misc = (volatile LAS unsigned*)(lds + LDS_MISC);
#ifndef NO_LRU
        for (int rep = 0; rep < EXP_REP_LRU; ++rep)
        for (;;) {
            if (tid == 0) misc[0] = atomicAdd(queue + rep * 128, 1u);
            __syncthreads();
            const int item = (int)misc[0];
            __syncthreads();
            if (item >= 128) break;
            lru::lru_item(item, lp, lds);
        }
#endif
#ifndef NO_ATT
        for (int rep = 0; rep < EXP_REP_ATT; ++rep)
        for (;;) {
            if (tid == 0) misc[0] = atomicAdd(queue + 64 + rep * 128, 1u);
            __syncthreads();
            const int item = (int)misc[0];
            __syncthreads();
            if (item >= 512) break;
            att::attn_unit(item, PROJ, MIX, args.in[7], lam, (char*)lds_raw);
        }
#endif
        {
            constexpr int I_OUT = (DM / 64) * (DM / 32), I_UP = (DM / 64) * (FF2 / 32), NF = (I_OUT + I_UP) / 8;
            const int lane = tid & 63, wave = __builtin_amdgcn_readfirstlane(tid >> 6);
            LAS float* scr = (LAS float*)(lds + wave * 16384);
            for (;;) {
                if (tid == 0) misc[0] = atomicAdd(queue + 320, 1u);
                __syncthreads();
                const int item = (int)misc[0];
                __syncthreads();
                if (item >= NF) break;
                int r = item * 8 + wave;
                if (r < I_OUT) p0_transpose_item<false>(args.in[15], DM, DM, Wout_t, nullptr, scr, r, lane);
                else p0_transpose_item<true>(args.in[17], DM, FF2, Wup_t, args.in[16], scr, r - I_OUT, lane);
            }
        }
    }
#endif
    xcd_barrier(xbar);

#if (PHMASK >> 3) & 1
    {
        pg8::Gemm g{MIX, Wout_t, T_, DM, DM, 256}; pg8::StaticOrder S; S.init(T_, DM, G, bx);
        pg8::EpiResBf E{XB, ss1, (LAS float*)(lds + LDS_EDGE)};
        pg8::gemm_phase<pg8::EpiResBf, pg8::StaticOrder, true, true>(lds, g, S, E);
    }
#endif
    xcd_barrier(xbar);

#if (PHMASK >> 4) & 1
    for (int rep = 0; rep < EXP_REP_P4; ++rep) {
        pg8::Gemm g{XB - DM, Wup_t, 65 * 256, FF2, DM, 254}; pg8::StaticOrder S; S.init(65 * 256, FF2, G, bx);
        pg8::EpiUp E{ACT, ss1, args.in[18], args.in[19], (LAS float*)(lds + LDS_EDGE)};
        pg8::gemm_phase<pg8::EpiUp, pg8::StaticOrder, true, true>(lds, g, S, E);
    }
    {
        constexpr int I_DN = (FF / 64) * (DM / 32), NF4 = I_DN / 8;
        int tl = threadIdx.x; asm volatile("" : "+v"(tl)); const int tid = tl, lane = tid & 63, wave = __builtin_amdgcn_readfirstlane(tid >> 6);
        volatile LAS unsigned* misc = (volatile LAS unsigned*)(lds + LDS_MISC); LAS float* scr = (LAS float*)(lds + wave * 16384);
        for (;;) {
            if (tid == 0) misc[0] = atomicAdd(queue + 384, 1u);
            __syncthreads();
            const int item = (int)misc[0];
            __syncthreads();
            if (item >= NF4) break;
            p0_transpose_item<false>(args.in[20], FF, DM, Wdn_t, nullptr, scr, item * 8 + wave, lane);
        }
    }
#endif
    xcd_barrier(xbar);

#if (PHMASK >> 5) & 1
    {
        pg8::Gemm g{ACT, Wdn_t, T_, DM, FF, 256}; pg8::StaticOrder S; S.init(T_, DM, G, bx);
        pg8::EpiResNorm E{XB, args.out, ss2, (unsigned*)(ws + WS_PCNT), args.in[21], (LAS float*)(lds + LDS_EDGE)};
        pg8::gemm_phase<pg8::EpiResNorm, pg8::StaticOrder, true, true>(lds, g, S, E);
    }
#endif

}

extern "C" void kernel_launch(void* const* d_in, const int* in_sizes, int n_in, void* d_out, int out_size, void* d_ws, size_t ws_size, hipStream_t stream) {
    static int grid = 0;
    if (grid == 0) {
        if (n_in != 22 || out_size != T_ * DM || ws_size < WS_END) { fprintf(stderr, "kernel_launch: unexpected shapes (n_in %d out %d ws %zu)\n", n_in, out_size, ws_size); grid = -1; return; }
        int dev = 0, cus = 0, per_cu = 0;
        (void)hipGetDevice(&dev); (void)hipDeviceGetAttribute(&cus, hipDeviceAttributeMultiprocessorCount, dev);
        if (hipFuncSetAttribute((const void*)hymba_fwd, hipFuncAttributeMaxDynamicSharedMemorySize, LDS_BYTES) != hipSuccess) { fprintf(stderr, "kernel_launch: hipFuncSetAttribute failed\n"); grid = -1; return; }
        if (hipOccupancyMaxActiveBlocksPerMultiprocessor(&per_cu, (const void*)hymba_fwd, 512, LDS_BYTES) != hipSuccess || per_cu < 1) per_cu = 1;
        (void)hipGetLastError();
        grid = cus * 1;
        if (grid != 256) { fprintf(stderr, "kernel_launch: built for a 256-CU device (got %d)\n", cus); grid = 256; }
    }
    if (grid < 0) return;
    Args a{};
    for (int i = 0; i < 22; ++i) a.in[i] = (const float*)d_in[i];
    a.out = (float*)d_out; a.ws = (unsigned char*)d_ws;
    void* kargs[] = {&a};
    hipError_t e = hipLaunchCooperativeKernel((const void*)hymba_fwd, dim3(grid), dim3(512), kargs, LDS_BYTES, stream);
    if (e != hipSuccess) fprintf(stderr, "cooperative launch failed: %s (grid %d)\n", hipGetErrorString(e), grid);
}
```

```cpp
#include <hip/hip_runtime.h>
#include <hip/hip_cooperative_groups.h>
#include <cstdint>
#include <cstdio>
namespace cg = cooperative_groups;
#ifndef EXP_REP_LRU
#define EXP_REP_LRU 1
#endif
#ifndef EXP_REP_ATT
#define EXP_REP_ATT 1
#endif
#ifndef EXP_REP_P1
#define EXP_REP_P1 1
#endif
#ifndef EXP_REP_P4
#define EXP_REP_P4 1
#endif
#ifndef EXP_REP_P0
#define EXP_REP_P0 1
#endif
#ifndef EXP_EXTRA_SYNC
#define EXP_EXTRA_SYNC 0
#endif
#ifndef EXP_REP_P3
#define EXP_REP_P3 1
#endif
#ifndef EXP_REP_P5
#define EXP_REP_P5 1
#endif
#ifndef EXP_MIXSCALE
#define EXP_MIXSCALE 1.f
#endif
#ifndef EXP_FFNSCALE
#define EXP_FFNSCALE 1.f
#endif
#ifndef EXP_ATTSCALE
#define EXP_ATTSCALE 1.f
#endif
#ifndef EXP_LRUSCALE
#define EXP_LRUSCALE 1.f
#endif

#define LAS __attribute__((address_space(3)))
typedef short bf16x8 __attribute__((ext_vector_type(8)));
typedef short s16x4 __attribute__((ext_vector_type(4)));
typedef float f32x2 __attribute__((ext_vector_type(2)));
typedef float f32x4 __attribute__((ext_vector_type(4)));
typedef float f32x8 __attribute__((ext_vector_type(8)));
typedef float f32x16 __attribute__((ext_vector_type(16)));
typedef unsigned u32x2 __attribute__((ext_vector_type(2)));
typedef unsigned u32x4 __attribute__((ext_vector_type(4)));

constexpr int T_ = 16384, DM = 1024, SEQ = 2048, INW = 2560, FF = 2816, FF2 = 5632;
constexpr float EPS = 1e-6f, L2E = 1.4426950408889634f;
constexpr size_t MiB = 1u << 20;
constexpr size_t WS_BAR = 262144;
constexpr size_t WS_PCNT = 327680;
constexpr size_t WS_LCNT = 360448;
constexpr size_t WS_ZERO_BYTES = 393216;
constexpr size_t WS_QUEUE = 0, WS_SS1 = 65536, WS_SS2 = 131072, WS_RS0 = 196608;
constexpr size_t WS_WIN = 1 * MiB, WS_WOUT = 6 * MiB, WS_WUP = 8 * MiB, WS_WDN = 19 * MiB;
constexpr size_t WS_PACKW = 25 * MiB;
constexpr size_t WS_XB = 26 * MiB;
constexpr size_t WS_PROJ = 59 * MiB;
constexpr size_t WS_MIX = 139 * MiB;
constexpr size_t WS_YS = 171 * MiB;
constexpr size_t WS_ACT = 59 * MiB;
constexpr size_t WS_END = 235 * MiB;
constexpr int LDS_EDGE = 131072, LDS_TOT = 135168, LDS_CW = 143360, LDS_MISC = 145408, LDS_BYTES = 147456;

__device__ __forceinline__ unsigned cvtpk(float lo, float hi) { unsigned r; asm volatile("v_cvt_pk_bf16_f32 %0, %1, %2" : "=v"(r) : "v"(lo), "v"(hi)); return r; }
__device__ __forceinline__ float bf2f(short s) { return __uint_as_float(((unsigned)(unsigned short)s) << 16); }
__device__ __forceinline__ bf16x8 pack8(f32x8 x) { u32x4 w = {cvtpk(x[0], x[1]), cvtpk(x[2], x[3]), cvtpk(x[4], x[5]), cvtpk(x[6], x[7])}; return __builtin_bit_cast(bf16x8, w); }
__device__ __forceinline__ float gelu_tanh(float x) {
    const float e = __builtin_amdgcn_exp2f(-2.302208198f * x * (1.f + 0.044715f * x * x));
    return x * __builtin_amdgcn_rcpf(1.f + e);
}
__device__ __forceinline__ float wave_sum(float v) {
#pragma unroll
    for (int o = 1; o < 64; o <<= 1) v += __shfl_xor(v, o);
    return v;
}
typedef unsigned short bf16_t;
namespace pg8 {
#define PG8_LAS __attribute__((address_space(3)))
constexpr int BM = 256, BK = 64, HALF = 128, HTB = HALF * BK * 2  , STAGE_BYTES = 8 * HTB, NXCD = 8, WGM = 8;

__host__ __device__ __forceinline__ int lds_byte(int r, int c) { const int st = (r >> 4) * 2 + (c >> 5), rr = r & 15, cc = c & 31, ob = rr * 64 + cc * 2; return st * 1024 + (ob ^ (((ob >> 9) & 1) << 5)); }
__host__ __device__ __forceinline__ void stage_rc(int b, int& R, int& C) { const int st = b / 1024, sb = b % 1024, swz = sb ^ (((sb >> 9) & 1) << 5); R = (st >> 1) * 16 + swz / 64; C = (st & 1) * 32 + (swz % 64) / 2; }
__host__ __device__ __forceinline__ int perm32(int rho) { const int n = rho >> 4, i = rho & 15; return 8 * (i >> 2) + 4 * n + (i & 3); }

struct Unit { int pm, pn; };
struct Gemm { const bf16_t* A; const bf16_t* Bt; int M, N, K, a_rows; };

struct StaticOrder {
    int nM, nN, nwg, G, c;
    __host__ __device__ void init(int M, int N, int G_, int c_) { nM = M / BM; nN = N / BM; nwg = nM * nN; G = G_; c = c_; }
    __host__ __device__ bool next(int i, Unit& u) const {
        const long L = (long)i * G + c; if (L >= nwg) return false;
        int wgid = (int)L; { const int q = nwg / NXCD, r = nwg % NXCD, xcd = wgid % NXCD, off = wgid / NXCD; wgid = (xcd < r ? xcd * (q + 1) : r * (q + 1) + (xcd - r) * q) + off; }
        const int nig = WGM * nN, gid = wgid / nig, fm = gid * WGM, gsz = (nM - fm) < WGM ? (nM - fm) : WGM;
        u.pm = fm + ((wgid % nig) % gsz); u.pn = (wgid % nig) / gsz; return true;
    }
    __device__ __forceinline__ void a_ready(const Unit&) const {}
    __device__ __forceinline__ void done(const Unit&) const {}
};
struct EpiProj {
    static constexpr bool PERM = true, AFTER_DRAIN = false;
    bf16_t* O; int ldc; const float* rs;
    __device__ __forceinline__ void operator()(f32x4 (&acc)[2][2][4][2], const Unit& u, int wr, int wc, int fr, int fq) const {
        const int row0 = u.pm * BM + wr * 64 + fr, col0 = u.pn * BM + wc * 32 + 8 * fq;
#pragma unroll
        for (int ai = 0; ai < 2; ++ai)
#pragma unroll
            for (int m = 0; m < 4; ++m) { const int row = row0 + ai * HALF + m * 16; const float s = rs[row]; bf16_t* rowp = O + (size_t)row * ldc + col0;
#pragma unroll
                for (int bj = 0; bj < 2; ++bj) { const f32x4 v0 = acc[ai][bj][m][0] * s, v1 = acc[ai][bj][m][1] * s;
                    u32x4 w; w.x = cvtpk(v0[0], v0[1]); w.y = cvtpk(v0[2], v0[3]); w.z = cvtpk(v1[0], v1[1]); w.w = cvtpk(v1[2], v1[3]);
                    *(u32x4*)(rowp + bj * HALF) = w; } }
    }
};
struct EpiRes {
    static constexpr bool PERM = false, AFTER_DRAIN = false;
    const float* base; float* out; bf16_t* xb; float* ss; float ascale;
    __device__ __forceinline__ void operator()(f32x4 (&acc)[2][2][4][2], const Unit& u, int wr, int wc, int fr, int fq) const {
        const int row0 = u.pm * BM + wr * 64 + fr, col0 = u.pn * BM + wc * 32 + 4 * fq;
#pragma unroll
        for (int ai = 0; ai < 2; ++ai)
#pragma unroll
            for (int m = 0; m < 4; ++m) { const int row = row0 + ai * HALF + m * 16; const size_t off = (size_t)row * 1024 + col0; float sq = 0.f;
#pragma unroll
                for (int bj = 0; bj < 2; ++bj)
#pragma unroll
                    for (int n = 0; n < 2; ++n) { const size_t o2 = off + bj * HALF + n * 16; const f32x4 b = *(const f32x4*)(base + o2); const f32x4 o = b + acc[ai][bj][m][n] * ascale;
                        *(f32x4*)(out + o2) = o; sq += (o[0] * o[0] + o[1] * o[1]) + (o[2] * o[2] + o[3] * o[3]);
                        if (xb) { u32x2 w; w.x = cvtpk(o[0], o[1]); w.y = cvtpk(o[2], o[3]); *(u32x2*)(xb + o2) = w; } }
                sq += __shfl_xor(sq, 16); sq += __shfl_xor(sq, 32);
                if (fq == 0) atomicAdd(ss + row, sq); }
    }
};
__device__ __forceinline__ float bflo(unsigned w) { return __uint_as_float(w << 16); }
__device__ __forceinline__ float bfhi(unsigned w) { return __uint_as_float(w & 0xffff0000u); }
struct EpiResBf {
    static constexpr bool PERM = true, AFTER_DRAIN = false;
    bf16_t* xb; float* ss; PG8_LAS float* red;
    __device__ __forceinline__ void operator()(f32x4 (&acc)[2][2][4][2], const Unit& u, int wr, int wc, int fr, int fq) const {
        const int row0 = u.pm * BM + wr * 64 + fr, col0 = u.pn * BM + wc * 32 + 8 * fq;
#pragma unroll
        for (int ai = 0; ai < 2; ++ai)
#pragma unroll
            for (int m = 0; m < 4; ++m) { const int row = row0 + ai * HALF + m * 16; const size_t off = (size_t)row * 1024 + col0; float sq = 0.f;
#pragma unroll
                for (int bj = 0; bj < 2; ++bj) { const size_t o2 = off + bj * HALF; const u32x4 bw = *(const u32x4*)(xb + o2);
                    const f32x4 o0 = (f32x4){bflo(bw.x), bfhi(bw.x), bflo(bw.y), bfhi(bw.y)} + acc[ai][bj][m][0], o1 = (f32x4){bflo(bw.z), bfhi(bw.z), bflo(bw.w), bfhi(bw.w)} + acc[ai][bj][m][1];
                    u32x4 w; w.x = cvtpk(o0[0], o0[1]); w.y = cvtpk(o0[2], o0[3]); w.z = cvtpk(o1[0], o1[1]); w.w = cvtpk(o1[2], o1[3]); *(u32x4*)(xb + o2) = w;
                    const float r0 = bflo(w.x), r1 = bfhi(w.x), r2 = bflo(w.y), r3 = bfhi(w.y), r4 = bflo(w.z), r5 = bfhi(w.z), r6 = bflo(w.w), r7 = bfhi(w.w);
                    sq += ((r0 * r0 + r1 * r1) + (r2 * r2 + r3 * r3)) + ((r4 * r4 + r5 * r5) + (r6 * r6 + r7 * r7)); }
                sq += __shfl_xor(sq, 16); sq += __shfl_xor(sq, 32);
                if (fq == 0) red[wc * 256 + ai * HALF + wr * 64 + m * 16 + fr] = sq; }
        asm volatile("s_waitcnt lgkmcnt(0)" ::: "memory"); __builtin_amdgcn_s_barrier(); asm volatile("" ::: "memory");
        if (threadIdx.x < 256) { const int r = threadIdx.x; atomicAdd(ss + u.pm * BM + r, (red[r] + red[256 + r]) + (red[512 + r] + red[768 + r])); }
    }
};
struct EpiResNorm {
    static constexpr bool PERM = true, AFTER_DRAIN = false;
    const bf16_t* base; float* out; float* ss; unsigned* cnt; const float* gain; PG8_LAS float* red;
    __device__ __forceinline__ void operator()(f32x4 (&acc)[2][2][4][2], const Unit& u, int wr, int wc, int fr, int fq) const {
        const int row0 = u.pm * BM + wr * 64 + fr, col0 = u.pn * BM + wc * 32 + 8 * fq;
#pragma unroll
        for (int ai = 0; ai < 2; ++ai)
#pragma unroll
            for (int m = 0; m < 4; ++m) { const int row = row0 + ai * HALF + m * 16; const size_t off = (size_t)row * 1024 + col0; float sq = 0.f;
#pragma unroll
                for (int bj = 0; bj < 2; ++bj) { const u32x4 bw = *(const u32x4*)(base + off + bj * HALF);
                    const f32x4 o0 = (f32x4){bflo(bw.x), bfhi(bw.x), bflo(bw.y), bfhi(bw.y)} + acc[ai][bj][m][0], o1 = (f32x4){bflo(bw.z), bfhi(bw.z), bflo(bw.w), bfhi(bw.w)} + acc[ai][bj][m][1];
                    acc[ai][bj][m][0] = o0; acc[ai][bj][m][1] = o1;
                    sq += ((o0[0] * o0[0] + o0[1] * o0[1]) + (o0[2] * o0[2] + o0[3] * o0[3])) + ((o1[0] * o1[0] + o1[1] * o1[1]) + (o1[2] * o1[2] + o1[3] * o1[3])); }
                sq += __shfl_xor(sq, 16); sq += __shfl_xor(sq, 32);
                if (fq == 0) red[wc * 256 + ai * HALF + wr * 64 + m * 16 + fr] = sq; }
        asm volatile("s_waitcnt lgkmcnt(0)" ::: "memory"); __builtin_amdgcn_s_barrier(); asm volatile("" ::: "memory");
        unsigned* pc = cnt + 64 * u.pm;
        if (threadIdx.x < 256) { const int r = threadIdx.x;
            __hip_atomic_fetch_add(ss + u.pm * BM + r, (red[r] + red[256 + r]) + (red[512 + r] + red[768 + r]), __ATOMIC_RELAXED, __HIP_MEMORY_SCOPE_AGENT);
            asm volatile("s_waitcnt vmcnt(0)" ::: "memory");
            if ((threadIdx.x & 63) == 0) __hip_atomic_fetch_add(pc, 1u, __ATOMIC_RELAXED, __HIP_MEMORY_SCOPE_AGENT); }
        if (threadIdx.x < 64) { unsigned sp = 0;
            while ((unsigned)__builtin_amdgcn_readfirstlane(__hip_atomic_load(pc, __ATOMIC_RELAXED, __HIP_MEMORY_SCOPE_AGENT)) < 16u) { __builtin_amdgcn_s_sleep(2); if (++sp > (1u << 22)) break; }
            __builtin_amdgcn_fence(__ATOMIC_ACQUIRE, "agent"); }
        asm volatile("s_waitcnt vmcnt(0) lgkmcnt(0)" ::: "memory"); __builtin_amdgcn_s_barrier(); asm volatile("" ::: "memory");
        f32x4 gv[2][2];
#pragma unroll
        for (int bj = 0; bj < 2; ++bj)
#pragma unroll
            for (int n = 0; n < 2; ++n) gv[bj][n] = *(const f32x4*)(gain + col0 + bj * HALF + n * 4);
#pragma unroll
        for (int ai = 0; ai < 2; ++ai)
#pragma unroll
            for (int m = 0; m < 4; ++m) { const int row = row0 + ai * HALF + m * 16; const size_t off = (size_t)row * 1024 + col0;
                const float rs = __builtin_amdgcn_rsqf(__hip_atomic_load(ss + row, __ATOMIC_RELAXED, __HIP_MEMORY_SCOPE_AGENT) * (1.f / 1024.f) + EPS);
#pragma unroll
                for (int bj = 0; bj < 2; ++bj)
#pragma unroll
                    for (int n = 0; n < 2; ++n) *(f32x4*)(out + off + bj * HALF + n * 4) = acc[ai][bj][m][n] * rs * gv[bj][n]; }
    }
};
__device__ __forceinline__ f32x4 dpp_shr1(f32x4 c, f32x4 old) { float r0 = old[0], r1 = old[1], r2 = old[2], r3 = old[3];
    asm("s_nop 1\n\tv_mov_b32_dpp %0, %4 row_shr:1 row_mask:0xf bank_mask:0xf\n\tv_mov_b32_dpp %1, %5 row_shr:1 row_mask:0xf bank_mask:0xf\n\tv_mov_b32_dpp %2, %6 row_shr:1 row_mask:0xf bank_mask:0xf\n\tv_mov_b32_dpp %3, %7 row_shr:1 row_mask:0xf bank_mask:0xf"
        : "+&v"(r0), "+&v"(r1), "+&v"(r2), "+&v"(r3) : "v"(c[0]), "v"(c[1]), "v"(c[2]), "v"(c[3]));
    return (f32x4){r0, r1, r2, r3}; }
__device__ __forceinline__ f32x4 dpp_shl1(f32x4 c, f32x4 old) { float r0 = old[0], r1 = old[1], r2 = old[2], r3 = old[3];
    asm("s_nop 1\n\tv_mov_b32_dpp %0, %4 row_shl:1 row_mask:0xf bank_mask:0xf\n\tv_mov_b32_dpp %1, %5 row_shl:1 row_mask:0xf bank_mask:0xf\n\tv_mov_b32_dpp %2, %6 row_shl:1 row_mask:0xf bank_mask:0xf\n\tv_mov_b32_dpp %3, %7 row_shl:1 row_mask:0xf bank_mask:0xf"
        : "+&v"(r0), "+&v"(r1), "+&v"(r2), "+&v"(r3) : "v"(c[0]), "v"(c[1]), "v"(c[2]), "v"(c[3]));
    return (f32x4){r0, r1, r2, r3}; }
__device__ __forceinline__ f32x4 dpp_mirror(f32x4 c) { float r0, r1, r2, r3;
    asm("s_nop 1\n\tv_mov_b32_dpp %0, %4 row_mirror row_mask:0xf bank_mask:0xf\n\tv_mov_b32_dpp %1, %5 row_mirror row_mask:0xf bank_mask:0xf\n\tv_mov_b32_dpp %2, %6 row_mirror row_mask:0xf bank_mask:0xf\n\tv_mov_b32_dpp %3, %7 row_mirror row_mask:0xf bank_mask:0xf"
        : "=&v"(r0), "=&v"(r1), "=&v"(r2), "=&v"(r3) : "v"(c[0]), "v"(c[1]), "v"(c[2]), "v"(c[3]));
    return (f32x4){r0, r1, r2, r3}; }
struct EpiUp {
    static constexpr bool PERM = true, AFTER_DRAIN = false;
    bf16_t* act; const float* ss1; const float* cw; const float* cb; PG8_LAS float* edge;
    __device__ __forceinline__ void operator()(f32x4 (&acc)[2][2][4][2], const Unit& u, int wr, int wc, int fr, int fq) const {
        const int tbase = u.pm * 254 - 1;
        const bool bnd = ((tbase + 1) >> 11) != ((tbase + 256) >> 11) || ((tbase + 1) & (SEQ - 1)) == 0 || tbase < 0;
#pragma unroll
        for (int ai = 0; ai < 2; ++ai)
#pragma unroll
            for (int m = 0; m < 4; ++m) { const int t = tbase + ai * HALF + wr * 64 + m * 16 + fr; float s = 0.f;
                if (t >= 0 && t < T_) s = __builtin_amdgcn_rsqf(ss1[t] * (1.f / 1024.f) + EPS);
#pragma unroll
                for (int bj = 0; bj < 2; ++bj)
#pragma unroll
                    for (int n = 0; n < 2; ++n) acc[ai][bj][m][n] *= s; }
        const int colw = wc * 32 + 4 * fq;
        if (fr == 0 || fr == 15) { const int e = (fr == 15) ? 1 : 0;
#pragma unroll
            for (int ai = 0; ai < 2; ++ai) { const int g = 2 * ai + wr;
#pragma unroll
                for (int bj = 0; bj < 2; ++bj)
#pragma unroll
                    for (int n = 0; n < 2; ++n) *(PG8_LAS f32x4*)(edge + ((g * 2 + e) * 256 + 128 * bj + colw + 16 * n)) = e ? acc[ai][bj][3][n] : acc[ai][bj][0][n]; } }
        asm volatile("s_waitcnt lgkmcnt(0)" ::: "memory"); __builtin_amdgcn_s_barrier(); asm volatile("" ::: "memory");
        u32x2 stash[2][4];
#pragma unroll
        for (int n = 0; n < 2; ++n) {
            const int f = u.pn * 128 + wc * 32 + 8 * fq + 4 * n;
            f32x4 w0[2], w1[2], w2[2], bb[2];
#pragma unroll
            for (int bj = 0; bj < 2; ++bj) { const int c = f + bj * FF; w0[bj] = *(const f32x4*)(cw + c); w1[bj] = *(const f32x4*)(cw + FF2 + c); w2[bj] = *(const f32x4*)(cw + 2 * FF2 + c); bb[bj] = *(const f32x4*)(cb + c); }
#pragma unroll
            for (int ai = 0; ai < 2; ++ai) { const int g = 2 * ai + wr;
#pragma unroll
                for (int m = 0; m < 4; ++m) { const int R = ai * HALF + wr * 64 + m * 16 + fr, t = tbase + R, tp = t & (SEQ - 1);
                    f32x4 uu[2];
#pragma unroll
                    for (int bj = 0; bj < 2; ++bj) { const f32x4 cur = acc[ai][bj][m][n]; f32x4 upe, dne;
                        if (m > 0) upe = dpp_mirror(acc[ai][bj][m - 1][n]); else upe = (g > 0) ? *(PG8_LAS const f32x4*)(edge + (((g - 1) * 2 + 1) * 256 + 128 * bj + colw + 16 * n)) : (f32x4){0.f, 0.f, 0.f, 0.f};
                        if (m < 3) dne = dpp_mirror(acc[ai][bj][m + 1][n]); else dne = (g < 3) ? *(PG8_LAS const f32x4*)(edge + (((g + 1) * 2 + 0) * 256 + 128 * bj + colw + 16 * n)) : (f32x4){0.f, 0.f, 0.f, 0.f};
                        f32x4 up = dpp_shr1(cur, upe), dn = dpp_shl1(cur, dne);
                        if (bnd) {
                            if (tp == 0) up = (f32x4){0.f, 0.f, 0.f, 0.f};
                            if (tp == SEQ - 1) dn = (f32x4){0.f, 0.f, 0.f, 0.f}; }
                        uu[bj] = bb[bj] + w0[bj] * up + w1[bj] * cur + w2[bj] * dn; }
                    { u32x2 w; w.x = cvtpk(gelu_tanh(uu[0][0]) * uu[1][0], gelu_tanh(uu[0][1]) * uu[1][1]); w.y = cvtpk(gelu_tanh(uu[0][2]) * uu[1][2], gelu_tanh(uu[0][3]) * uu[1][3]);
                        if (n == 0) stash[ai][m] = w;
                        else if (R >= 1 && R <= 254 && t < T_) *(u32x4*)(act + (size_t)t * FF + (f - 4)) = (u32x4){stash[ai][m].x, stash[ai][m].y, w.x, w.y}; } } }
        }
    }
};
template <class Epi, class Sched, bool ALIGN_EPI = false, bool SP2 = false>
__device__ __forceinline__ void gemm_phase(PG8_LAS unsigned char* lds, const Gemm g, const Sched& S, const Epi& E) {
    int tid_l = threadIdx.x; asm volatile("" : "+v"(tid_l));
    const int tid = tid_l, wid = __builtin_amdgcn_readfirstlane(tid >> 6), lane = tid & 63, wr = wid >> 2, wc = wid & 3, fr = lane & 15, fq = lane >> 4;
    const int K = g.K, nt = K / BK;
    unsigned voffA[2], voffB[2];
#pragma unroll
    for (int i = 0; i < 2; ++i) { int R, C; stage_rc(tid * 16 + i * 8192, R, C); const int Rb = Epi::PERM ? ((R & ~31) + perm32(R & 31)) : R;
        voffA[i] = (unsigned)(R * K + C) * 2u; voffB[i] = (unsigned)(Rb * K + C) * 2u; }
    const size_t kstep = (size_t)(BK * 2);
    const size_t hstep = (size_t)HALF * K * 2;
    const size_t tstep = 2 * hstep; const size_t tstepA = (size_t)g.a_rows * K * 2;
    const unsigned ldsw = (unsigned)wid * 1024u;
    const int aoff = lds_byte(wr * 64 + fr, fq * 8), boff = lds_byte(wc * 32 + fr, fq * 8);
#define PG8_SA(b, h) (((b) * 2 + (h)) * HTB)
#define PG8_SB(b, h) ((4 + (b) * 2 + (h)) * HTB)
#define PG8_STAGE(bufoff, gbase, voff) do { _Pragma("unroll") for (int _i = 0; _i < 2; ++_i) \
        __builtin_amdgcn_global_load_lds((const unsigned*)((const char*)(gbase) + (voff)[_i]), (PG8_LAS unsigned*)(lds + (bufoff) + ldsw + _i * 8192), 16, 0, 0); } while (0)
#define PG8_LDA(dst, b, h) do { _Pragma("unroll") for (int m = 0; m < 4; ++m) _Pragma("unroll") for (int k = 0; k < 2; ++k) dst[m][k] = *(const PG8_LAS bf16x8*)(lds + PG8_SA(b, h) + aoff + m * 2048 + k * 1024); } while (0)
#define PG8_LDB(dst, b, h) do { _Pragma("unroll") for (int n = 0; n < 2; ++n) _Pragma("unroll") for (int k = 0; k < 2; ++k) dst[n][k] = *(const PG8_LAS bf16x8*)(lds + PG8_SB(b, h) + boff + n * 2048 + k * 1024); } while (0)
#define PG8_MMA(ai, bj, At, Bt) do { __builtin_amdgcn_s_setprio(1); _Pragma("unroll") for (int m = 0; m < 4; ++m) _Pragma("unroll") for (int n = 0; n < 2; ++n) _Pragma("unroll") for (int k = 0; k < 2; ++k) \
        acc[ai][bj][m][n] = __builtin_amdgcn_mfma_f32_16x16x32_bf16(Bt[n][k], At[m][k], acc[ai][bj][m][n], 0, 0, 0); __builtin_amdgcn_s_setprio(0); } while (0)
#define PG8_WAIT_V(n) asm volatile("s_waitcnt vmcnt(" #n ")" ::: "memory")
#define PG8_WAIT_L(n) asm volatile("s_waitcnt lgkmcnt(" #n ")" ::: "memory")
#define PG8_BAR __builtin_amdgcn_s_barrier()
#define PG8_SCHED __builtin_amdgcn_sched_barrier(0)
    Unit cur, nxt; int ui = 0;
    if (!S.next(0, cur)) return;
    f32x4 acc[2][2][4][2];
#pragma unroll
    for (int a = 0; a < 2; ++a)
#pragma unroll
        for (int b = 0; b < 2; ++b)
#pragma unroll
            for (int m = 0; m < 4; ++m)
#pragma unroll
                for (int n = 0; n < 2; ++n) acc[a][b][m][n] = (f32x4){0.f, 0.f, 0.f, 0.f};
    bf16x8 At[4][2], B0[2][2], B1[2][2];
    const char* cA = (const char*)g.A + (size_t)cur.pm * tstepA; const char* cB = (const char*)g.Bt + (size_t)cur.pn * tstep;
    S.a_ready(cur);
    if constexpr (SP2) {
        PG8_STAGE(PG8_SB(0, 0), cB, voffB); PG8_STAGE(PG8_SB(0, 1), cB + hstep, voffB); PG8_STAGE(PG8_SA(0, 0), cA, voffA); PG8_STAGE(PG8_SA(0, 1), cA + hstep, voffA);
        if (wr == 1) PG8_BAR;
        PG8_WAIT_V(2); PG8_BAR;
        PG8_STAGE(PG8_SB(1, 0), cB + kstep, voffB); PG8_STAGE(PG8_SA(1, 0), cA + kstep, voffA); PG8_STAGE(PG8_SB(1, 1), cB + hstep + kstep, voffB);
        PG8_WAIT_V(6); PG8_BAR;
    } else {
        PG8_STAGE(PG8_SB(0, 0), cB, voffB); PG8_STAGE(PG8_SA(0, 0), cA, voffA); PG8_STAGE(PG8_SB(0, 1), cB + hstep, voffB); PG8_STAGE(PG8_SA(0, 1), cA + hstep, voffA);
        if (wr == 1) PG8_BAR;
        PG8_WAIT_V(4); PG8_BAR;
        PG8_STAGE(PG8_SB(1, 0), cB + kstep, voffB); PG8_STAGE(PG8_SA(1, 0), cA + kstep, voffA); PG8_STAGE(PG8_SB(1, 1), cB + hstep + kstep, voffB);
        PG8_WAIT_V(6); PG8_BAR;
    }
    for (;;) {
        const bool has_next = S.next(ui + 1, nxt);
        const char* nA = has_next ? (const char*)g.A + (size_t)nxt.pm * tstepA : cA; const char* nB = has_next ? (const char*)g.Bt + (size_t)nxt.pn * tstep : cB;
        for (int t = 0; t < nt; t += 2) {
            const bool last = (t == nt - 2);
            const char* a1 = cA + (size_t)(t + 1) * kstep;
            const char* a2 = last ? nA : cA + (size_t)(t + 2) * kstep; const char* b2 = last ? nB : cB + (size_t)(t + 2) * kstep;
            const char* a3 = a2 + kstep; const char* b3 = b2 + kstep;
            if (last && has_next) S.a_ready(nxt);
            if constexpr (SP2) {
            PG8_LDB(B0, 0, 0); PG8_LDB(B1, 0, 1); PG8_SCHED; PG8_LDA(At, 0, 0); PG8_STAGE(PG8_SA(1, 1), a1 + hstep, voffA);
            PG8_WAIT_V(8); PG8_WAIT_L(0); PG8_BAR; PG8_MMA(0, 0, At, B0); PG8_MMA(0, 1, At, B1); PG8_BAR; PG8_SCHED;
            PG8_LDA(At, 0, 1); PG8_STAGE(PG8_SB(0, 0), b2, voffB); PG8_STAGE(PG8_SB(0, 1), b2 + hstep, voffB); PG8_STAGE(PG8_SA(0, 0), a2, voffA);
            PG8_WAIT_V(8); PG8_WAIT_L(0); PG8_BAR; PG8_MMA(1, 0, At, B0); PG8_MMA(1, 1, At, B1); PG8_BAR; PG8_SCHED;
            PG8_LDB(B0, 1, 0); PG8_LDB(B1, 1, 1); PG8_SCHED; PG8_LDA(At, 1, 0); PG8_STAGE(PG8_SA(0, 1), a2 + hstep, voffA);
            PG8_WAIT_V(8); PG8_WAIT_L(0); PG8_BAR; PG8_MMA(0, 0, At, B0); PG8_MMA(0, 1, At, B1); PG8_BAR; PG8_SCHED;
            PG8_LDA(At, 1, 1); PG8_STAGE(PG8_SB(1, 0), b3, voffB); PG8_STAGE(PG8_SB(1, 1), b3 + hstep, voffB); PG8_STAGE(PG8_SA(1, 0), a3, voffA);
            PG8_WAIT_V(8); PG8_WAIT_L(0); PG8_BAR; PG8_MMA(1, 0, At, B0); PG8_MMA(1, 1, At, B1); PG8_BAR; PG8_SCHED;
            } else {
            PG8_LDB(B0, 0, 0); PG8_SCHED; PG8_LDA(At, 0, 0); PG8_STAGE(PG8_SA(1, 1), a1 + hstep, voffA);
            PG8_WAIT_L(8); PG8_BAR; PG8_WAIT_L(0); PG8_MMA(0, 0, At, B0); PG8_BAR; PG8_SCHED;
            PG8_LDB(B1, 0, 1); PG8_STAGE(PG8_SB(0, 0), b2, voffB);
            PG8_BAR; PG8_WAIT_L(0); PG8_MMA(0, 1, At, B1); PG8_BAR;
            PG8_LDA(At, 0, 1); PG8_STAGE(PG8_SA(0, 0), a2, voffA);
            PG8_BAR; PG8_WAIT_L(0); PG8_MMA(1, 0, At, B0); PG8_BAR; PG8_SCHED;
            PG8_STAGE(PG8_SB(0, 1), b2 + hstep, voffB);
            PG8_WAIT_V(6); PG8_BAR; PG8_MMA(1, 1, At, B1); PG8_BAR;
            PG8_LDB(B0, 1, 0); PG8_SCHED; PG8_LDA(At, 1, 0); PG8_STAGE(PG8_SA(0, 1), a2 + hstep, voffA);
            PG8_WAIT_L(8); PG8_BAR; PG8_WAIT_L(0); PG8_MMA(0, 0, At, B0); PG8_BAR; PG8_SCHED;
            PG8_LDB(B1, 1, 1); PG8_STAGE(PG8_SB(1, 0), b3, voffB);
            PG8_BAR; PG8_WAIT_L(0); PG8_MMA(0, 1, At, B1); PG8_BAR;
            PG8_LDA(At, 1, 1); PG8_STAGE(PG8_SA(1, 0), a3, voffA);
            PG8_BAR; PG8_WAIT_L(0); PG8_MMA(1, 0, At, B0); PG8_BAR; PG8_SCHED;
            PG8_STAGE(PG8_SB(1, 1), b3 + hstep, voffB);
            PG8_WAIT_V(6); PG8_BAR; PG8_MMA(1, 1, At, B1); PG8_BAR;
            }
        }
        if constexpr (ALIGN_EPI) { if (wr == 0) PG8_BAR; }
        if constexpr (!Epi::AFTER_DRAIN) { E(acc, cur, wr, wc, fr, fq); S.done(cur); }
        if (!has_next) break;
#pragma unroll
        for (int a = 0; a < 2; ++a)
#pragma unroll
            for (int b = 0; b < 2; ++b)
#pragma unroll
                for (int m = 0; m < 4; ++m)
#pragma unroll
                    for (int n = 0; n < 2; ++n) acc[a][b][m][n] = (f32x4){0.f, 0.f, 0.f, 0.f};
        cur = nxt; cA = nA; cB = nB; ++ui;
        if constexpr (ALIGN_EPI) { if (wr == 1) PG8_BAR; }
    }
    PG8_WAIT_V(0);
    if constexpr (!ALIGN_EPI) { if (wr == 0) PG8_BAR; }
    PG8_BAR;
    if constexpr (Epi::AFTER_DRAIN) { E.fused(acc, cur, wr, wc, fr, fq, lds, wid, lane); S.done(cur); }
#undef PG8_SA
#undef PG8_SB
#undef PG8_STAGE
#undef PG8_LDA
#undef PG8_LDB
#undef PG8_MMA
#undef PG8_WAIT_V
#undef PG8_WAIT_L
#undef PG8_BAR
#undef PG8_SCHED
}
}
namespace att {
constexpr int LD = INW, KVBLK = 64;
constexpr size_t SHM_V = KVBLK * 128 * 2, SHM_K = KVBLK * 128 * 2;
constexpr float THR2 = 8.f * L2E;
#define KSWZ(row, colB) ((row) * 256 + ((colB) ^ (((row) & 7) << 4)))
#define SBAR() __builtin_amdgcn_sched_barrier(0)
__device__ __forceinline__ int crow(int r, int hi) { return (r & 3) + 8 * (r >> 2) + 4 * hi; }
__device__ __forceinline__ void partialSM(f32x16& p0, f32x16& p1, float& m_reg, float& mn, float& alpha, float dqs, float sl2) {
  constexpr float C = 0.125f * L2E;
#pragma unroll
  for (int r = 0; r < 16; ++r) { const float k0 = (float)((r & 3) + 8 * (r >> 2));
    p0[r] = fmaf(p0[r], C, -fabsf(fmaf(sl2, -k0, dqs))); p1[r] = fmaf(p1[r], C, -fabsf(fmaf(sl2, -(k0 + 32.f), dqs))); }
  float pmax = p0[0];
#pragma unroll
  for (int r = 1; r < 16; ++r) pmax = fmaxf(pmax, p0[r]);
#pragma unroll
  for (int r = 0; r < 16; ++r) pmax = fmaxf(pmax, p1[r]);
  { auto rr = __builtin_amdgcn_permlane32_swap(__float_as_uint(pmax), __float_as_uint(pmax), false, false);
    pmax = fmaxf(__uint_as_float(rr[0]), __uint_as_float(rr[1])); }
  if (__builtin_expect(__all(pmax - m_reg <= THR2), 1)) { mn = m_reg; alpha = 1.f; }
  else { mn = fmaxf(m_reg, pmax); alpha = __builtin_amdgcn_exp2f(m_reg - mn); m_reg = mn; }
#pragma unroll
  for (int r = 0; r < 16; ++r) { p0[r] -= mn; p1[r] -= mn; }
#pragma unroll
  for (int r = 0; r < 16; ++r) p0[r] = __builtin_amdgcn_exp2f(p0[r]);
}
__device__ __forceinline__ void partialSM1(f32x16& p0, f32x16& p1, float& m_reg, float& mn, float& alpha, float dqs, float sl2, int side) {
  constexpr float C = 0.125f * L2E;
  const float sg = side > 0 ? -sl2 : sl2, D0 = side > 0 ? (m_reg + dqs) : (m_reg - dqs);
  const f32x2 sg2 = {sg, sg}, C2 = {C, C}, Da = {D0, D0}, Db = {fmaf(sg, 32.f, D0), fmaf(sg, 32.f, D0)};
#pragma unroll
  for (int r = 0; r < 16; r += 2) {
    const f32x2 kk = {(float)((r & 3) + 8 * (r >> 2)), (float)(((r + 1) & 3) + 8 * ((r + 1) >> 2))};
    const f32x2 b0 = __builtin_elementwise_fma(sg2, kk, Da), b1 = __builtin_elementwise_fma(sg2, kk, Db);
    const f32x2 x0 = __builtin_elementwise_fma((f32x2){p0[r], p0[r + 1]}, C2, -b0), x1 = __builtin_elementwise_fma((f32x2){p1[r], p1[r + 1]}, C2, -b1);
    p0[r] = x0[0]; p0[r + 1] = x0[1]; p1[r] = x1[0]; p1[r + 1] = x1[1]; }
  float pmax = p0[0];
#pragma unroll
  for (int r = 1; r < 16; ++r) pmax = fmaxf(pmax, p0[r]);
#pragma unroll
  for (int r = 0; r < 16; ++r) pmax = fmaxf(pmax, p1[r]);
  { auto rr = __builtin_amdgcn_permlane32_swap(__float_as_uint(pmax), __float_as_uint(pmax), false, false);
    pmax = fmaxf(__uint_as_float(rr[0]), __uint_as_float(rr[1])); }
  if (__builtin_expect(__all(pmax <= THR2), 1)) { mn = m_reg; alpha = 1.f; }
  else { const float pm = fmaxf(pmax, 0.f); mn = m_reg + pm; alpha = __builtin_amdgcn_exp2f(-pm); m_reg = mn;
#pragma unroll
    for (int r = 0; r < 16; ++r) { p0[r] -= pm; p1[r] -= pm; } }
#pragma unroll
  for (int r = 0; r < 16; ++r) p0[r] = __builtin_amdgcn_exp2f(p0[r]);
}
__device__ __forceinline__ void finishSM(f32x16& p0, f32x16& p1, float alpha, float& l_reg, bf16x8& pa0, bf16x8& pa1, bf16x8& pa2, bf16x8& pa3) {
#pragma unroll
  for (int r = 0; r < 16; ++r) p1[r] = __builtin_amdgcn_exp2f(p1[r]);
  f32x2 ps2 = {0.f, 0.f};
#pragma unroll
  for (int r = 0; r < 16; r += 2) ps2 += (f32x2){p0[r], p0[r + 1]};
#pragma unroll
  for (int r = 0; r < 16; r += 2) ps2 += (f32x2){p1[r], p1[r + 1]};
  float ps = ps2[0] + ps2[1];
  { auto rr = __builtin_amdgcn_permlane32_swap(__float_as_uint(ps), __float_as_uint(ps), false, false);
    ps = __uint_as_float(rr[0]) + __uint_as_float(rr[1]); }
  l_reg = l_reg * alpha + ps;
#define PK4(P, BASE, OUT) do { unsigned a0 = cvtpk(P[BASE + 0], P[BASE + 1]), a1 = cvtpk(P[BASE + 2], P[BASE + 3]);   \
    unsigned b0 = cvtpk(P[BASE + 4], P[BASE + 5]), b1 = cvtpk(P[BASE + 6], P[BASE + 7]);                              \
    auto r0 = __builtin_amdgcn_permlane32_swap(a0, b0, false, false); auto r1 = __builtin_amdgcn_permlane32_swap(a1, b1, false, false); \
    u32x4 w = {r0[0], r1[0], r0[1], r1[1]}; OUT = __builtin_bit_cast(bf16x8, w); } while (0)
  PK4(p0, 0, pa0); PK4(p0, 8, pa1); PK4(p1, 0, pa2); PK4(p1, 8, pa3);
#undef PK4
}
__device__ __forceinline__ void qkt(f32x16& p0, f32x16& p1, const char* Ks, const bf16x8* qr, int r32, int hi, int c) {
  p0 = f32x16{}; p1 = f32x16{};
#pragma unroll
  for (int d0 = 0; d0 < 4; ++d0) { const int cb = (c * 64 + d0 * 16 + hi * 8) * 2;
    bf16x8 b0 = *reinterpret_cast<const bf16x8*>(Ks + KSWZ(r32, cb));
    bf16x8 b1 = *reinterpret_cast<const bf16x8*>(Ks + KSWZ(32 + r32, cb));
    p0 = __builtin_amdgcn_mfma_f32_32x32x16_bf16(b0, qr[d0], p0, 0, 0, 0);
    p1 = __builtin_amdgcn_mfma_f32_32x32x16_bf16(b1, qr[d0], p1, 0, 0, 0); }
}
__device__ __forceinline__ int v_st(int k, int c) { const int kk = (k & ~0xC) | ((k & 4) << 1) | ((k & 8) >> 1); return ((kk >> 3) * 4 + (c >> 5)) * 512 + ((kk & 7) * 32 + (c & 31)) * 2; }
__device__ __forceinline__ int v_rd_base(int lane) { return ((lane & 3) << 3) | (((lane >> 2) & 3) << 6) | (((lane >> 4) & 1) << 5) | (((lane >> 5) & 1) << 8); }
constexpr int v_rd_off(int d0, int ks, int half) { return d0 * 512 + ks * 4096 + half * 2048; }
template <int OFF> __device__ __forceinline__ s16x4 tr_read(int vb) {
  s16x4 r; asm volatile("ds_read_b64_tr_b16 %0, %1 offset:%2" : "=&v"(r) : "v"(vb), "i"(OFF) : "memory"); return r;
}
template <int D0> __device__ __forceinline__ void pv_one(f32x16& od, int vb, bf16x8 pa0, bf16x8 pa1, bf16x8 pa2, bf16x8 pa3) {
  const s16x4 l0 = tr_read<v_rd_off(D0, 0, 0)>(vb), h0 = tr_read<v_rd_off(D0, 0, 1)>(vb), l1 = tr_read<v_rd_off(D0, 1, 0)>(vb), h1 = tr_read<v_rd_off(D0, 1, 1)>(vb);
  const s16x4 l2 = tr_read<v_rd_off(D0, 2, 0)>(vb), h2 = tr_read<v_rd_off(D0, 2, 1)>(vb), l3 = tr_read<v_rd_off(D0, 3, 0)>(vb), h3 = tr_read<v_rd_off(D0, 3, 1)>(vb);
  asm volatile("s_waitcnt lgkmcnt(0)" ::: "memory"); SBAR();
#define PK(L, H) (bf16x8){L[0], L[1], L[2], L[3], H[0], H[1], H[2], H[3]}
  od = __builtin_amdgcn_mfma_f32_32x32x16_bf16(pa0, PK(l0, h0), od, 0, 0, 0);
  od = __builtin_amdgcn_mfma_f32_32x32x16_bf16(pa1, PK(l1, h1), od, 0, 0, 0);
  od = __builtin_amdgcn_mfma_f32_32x32x16_bf16(pa2, PK(l2, h2), od, 0, 0, 0);
  od = __builtin_amdgcn_mfma_f32_32x32x16_bf16(pa3, PK(l3, h3), od, 0, 0, 0);
#undef PK
}
__device__ __forceinline__ void pv_d0(f32x16* o, int vb, bf16x8 pa0, bf16x8 pa1, bf16x8 pa2, bf16x8 pa3) {
  pv_one<0>(o[0], vb, pa0, pa1, pa2, pa3); pv_one<1>(o[1], vb, pa0, pa1, pa2, pa3); pv_one<2>(o[2], vb, pa0, pa1, pa2, pa3); pv_one<3>(o[3], vb, pa0, pa1, pa2, pa3);
}
__device__ __forceinline__ void pv_sm1(f32x16* o, int vb, bf16x8 pa0, bf16x8 pa1, bf16x8 pa2, bf16x8 pa3, f32x16& p0, f32x16& p1, float& m_reg, float& mn, float& alpha, float dqs, float sl2, int side) {
  constexpr float C = 0.125f * L2E;
  const float sg = side > 0 ? -sl2 : sl2, D0 = side > 0 ? (m_reg + dqs) : (m_reg - dqs);
  const f32x2 sg2 = {sg, sg}, C2 = {C, C}, Da = {D0, D0}, Db = {fmaf(sg, 32.f, D0), fmaf(sg, 32.f, D0)};
  pv_one<0>(o[0], vb, pa0, pa1, pa2, pa3);
#pragma unroll
  for (int r = 0; r < 16; r += 2) { const f32x2 kk = {(float)((r & 3) + 8 * (r >> 2)), (float)(((r + 1) & 3) + 8 * ((r + 1) >> 2))};
    const f32x2 x0 = __builtin_elementwise_fma((f32x2){p0[r], p0[r + 1]}, C2, -__builtin_elementwise_fma(sg2, kk, Da)); p0[r] = x0[0]; p0[r + 1] = x0[1]; }
  pv_one<1>(o[1], vb, pa0, pa1, pa2, pa3);
#pragma unroll
  for (int r = 0; r < 16; r += 2) { const f32x2 kk = {(float)((r & 3) + 8 * (r >> 2)), (float)(((r + 1) & 3) + 8 * ((r + 1) >> 2))};
    const f32x2 x1 = __builtin_elementwise_fma((f32x2){p1[r], p1[r + 1]}, C2, -__builtin_elementwise_fma(sg2, kk, Db)); p1[r] = x1[0]; p1[r + 1] = x1[1]; }
  pv_one<2>(o[2], vb, pa0, pa1, pa2, pa3);
  float pmax = p0[0];
#pragma unroll
  for (int r = 1; r < 16; ++r) pmax = fmaxf(pmax, p0[r]);
#pragma unroll
  for (int r = 0; r < 16; ++r) pmax = fmaxf(pmax, p1[r]);
  { auto rr = __builtin_amdgcn_permlane32_swap(__float_as_uint(pmax), __float_as_uint(pmax), false, false);
    pmax = fmaxf(__uint_as_float(rr[0]), __uint_as_float(rr[1])); }
  if (__builtin_expect(__all(pmax <= THR2), 1)) { mn = m_reg; alpha = 1.f; }
  else { const float pm = fmaxf(pmax, 0.f); mn = m_reg + pm; alpha = __builtin_amdgcn_exp2f(-pm); m_reg = mn;
#pragma unroll
    for (int r = 0; r < 16; ++r) { p0[r] -= pm; p1[r] -= pm; } }
  pv_one<3>(o[3], vb, pa0, pa1, pa2, pa3);
#pragma unroll
  for (int r = 0; r < 16; ++r) p0[r] = __builtin_amdgcn_exp2f(p0[r]);
}
constexpr int XS = 132;

__device__ __forceinline__ void attn_unit(int unit, const bf16_t* __restrict__ proj, bf16_t* __restrict__ mix, const float* __restrict__ subln_g, float lam, char* lds) {
  const int b = unit >> 6, h = (unit >> 4) & 3, qb = unit & 15;
  int tid_l = threadIdx.x; asm volatile("" : "+v"(tid_l));
  const int tid = tid_l, wid = tid >> 6, lane = tid & 63, r32 = lane & 31, hi = lane >> 5, c = wid >> 2, wq = wid & 3;
  const int q0 = qb * 128;
  const bf16_t* Qb = proj + (size_t)(b * SEQ + q0) * LD + h * 128 + c * 64;
  const bf16_t* Kh = proj + (size_t)(b * SEQ) * LD + 512 + h * 128;
  const bf16_t* Vh = proj + (size_t)(b * SEQ) * LD + 1024 + h * 128;
  char* V_lds = lds; char* K_lds = lds + 3 * SHM_V;
  float* ws = (float*)(lds + 3 * SHM_V + 3 * SHM_K) + wid * 64; float* li_l = ws; float* al_l = ws + 32;
  float m_reg = -1e30f, l_reg = 0; f32x16 o[4] = {}; bf16x8 qr[4];
  const bf16_t* Qw = Qb + (size_t)(wq * 32 + r32) * LD + hi * 8;
#pragma unroll
  for (int d0 = 0; d0 < 4; ++d0) qr[d0] = *reinterpret_cast<const bf16x8*>(Qw + d0 * 16);
  const float sl2 = __builtin_amdgcn_exp2f(-2.f * (float)(h + 1)) * L2E;
  float dqs = sl2 * (float)(q0 + wq * 32 + r32 - 4 * hi);
  const int sr = tid >> 4, sc = (tid & 15) * 8, vst0 = v_st(sr, sc), vst1 = v_st(32 + sr, sc);
  const int vb0 = (int)(uintptr_t)V_lds + v_rd_base(lane);
  struct { bf16x8 vs0, vs1, ks0, ks1; } sr_[1];
#define SLOAD(i, k0) do { sr_[i].vs0 = *(const bf16x8*)(&Vh[(size_t)((k0) + sr) * LD + sc]); sr_[i].vs1 = *(const bf16x8*)(&Vh[(size_t)((k0) + 32 + sr) * LD + sc]); \
    sr_[i].ks0 = *(const bf16x8*)(&Kh[(size_t)((k0) + sr) * LD + sc]); sr_[i].ks1 = *(const bf16x8*)(&Kh[(size_t)((k0) + 32 + sr) * LD + sc]); } while (0)
#define SWRITE(bb, i) do { *(bf16x8*)(V_lds + (bb) * SHM_V + vst0) = sr_[i].vs0;          \
    *(bf16x8*)(V_lds + (bb) * SHM_V + vst1) = sr_[i].vs1; int kc = sc * 2;               \
    *(bf16x8*)(K_lds + (bb) * SHM_K + KSWZ(sr, kc)) = sr_[i].ks0;                       \
    *(bf16x8*)(K_lds + (bb) * SHM_K + KSWZ(32 + sr, kc)) = sr_[i].ks1; } while (0)
#define SWAIT() asm volatile("s_waitcnt vmcnt(0)" ::: "memory")
#define RESC(a) do { if (__any((a) < 1.f)) { if (hi == 0) al_l[r32] = (a); asm volatile("s_waitcnt lgkmcnt(0)" ::: "memory"); \
    _Pragma("unroll") for (int d = 0; d < 4; ++d) _Pragma("unroll") for (int r = 0; r < 16; ++r) o[d][r] *= al_l[crow(r, hi)]; } } while (0)
  f32x16 pA0, pA1, pB0, pB1; float mnA, mnB, alA, alB; bf16x8 pa0, pa1, pa2, pa3; constexpr int NT = SEQ / KVBLK;
  const int jd = 2 * qb; const float dq0 = dqs;
#define TK(j) ((((j) + jd) & (NT - 1)) * KVBLK)
#define DQS(j) fmaf(-sl2, (float)TK(j), dq0)
  SLOAD(0, TK(0)); asm volatile("s_waitcnt vmcnt(0)" ::: "memory"); SWRITE(0, 0);
  SLOAD(0, TK(1)); asm volatile("s_waitcnt vmcnt(0)" ::: "memory"); SWRITE(1, 0); __syncthreads();
  qkt(pA0, pA1, K_lds, qr, r32, hi, c); partialSM(pA0, pA1, m_reg, mnA, alA, DQS(0), sl2);
  const int qw0 = q0 + wq * 32;
  int cb = 0;
#define ATT_STEP(PC0, PC1, ALC, PN0, PN1, MNN, ALN, J) do { const int nb_ = (cb == 2) ? 0 : cb + 1, wb_ = (nb_ == 2) ? 0 : nb_ + 1; \
    SBAR(); qkt(PN0, PN1, K_lds + nb_ * SHM_K, qr, r32, hi, c); \
    finishSM(PC0, PC1, ALC, l_reg, pa0, pa1, pa2, pa3); SBAR(); \
    if ((J) + 2 < NT) SLOAD(0, TK((J) + 2)); SBAR(); \
    { const int kn_ = TK((J) + 1); const float dqs = DQS((J) + 1); const int side_ = (kn_ + KVBLK - 1 < qw0) ? 1 : ((kn_ > qw0 + 31) ? -1 : 0); \
      if (side_ != 0) pv_sm1(o, vb0 + cb * (int)SHM_V, pa0, pa1, pa2, pa3, PN0, PN1, m_reg, MNN, ALN, dqs, sl2, side_); \
      else { pv_d0(o, vb0 + cb * (int)SHM_V, pa0, pa1, pa2, pa3); partialSM(PN0, PN1, m_reg, MNN, ALN, dqs, sl2); } } \
    if ((J) + 2 < NT) { SWAIT(); SWRITE(wb_, 0); } \
    RESC(ALN); __syncthreads(); cb = nb_; } while (0)
  for (int j = 0; j + 2 < NT; j += 2) {
    ATT_STEP(pA0, pA1, alA, pB0, pB1, mnB, alB, j);
    ATT_STEP(pB0, pB1, alB, pA0, pA1, mnA, alA, j + 1);
  }
  ATT_STEP(pA0, pA1, alA, pB0, pB1, mnB, alB, NT - 2);
  finishSM(pB0, pB1, alB, l_reg, pa0, pa1, pa2, pa3); SBAR();
  pv_d0(o, vb0 + cb * (int)SHM_V, pa0, pa1, pa2, pa3);
#undef ATT_STEP
#undef TK
#undef DQS
  if (hi == 0) li_l[r32] = l_reg; asm volatile("s_waitcnt lgkmcnt(0)" ::: "memory");
  float rli[16];
#pragma unroll
  for (int r = 0; r < 16; ++r) rli[r] = __builtin_amdgcn_rcpf(li_l[crow(r, hi)]);
  asm volatile("s_waitcnt vmcnt(0)" ::: "memory");
  __syncthreads();
  float* X = (float*)lds + c * (128 * XS);
#pragma unroll
  for (int r = 0; r < 16; ++r) { const int orow = wq * 32 + crow(r, hi);
#pragma unroll
    for (int d0 = 0; d0 < 4; ++d0) X[orow * XS + d0 * 32 + r32] = o[d0][r] * rli[r]; }
  __syncthreads();
  { const int row = tid >> 2, q = tid & 3; const float* X1 = (const float*)lds + row * XS + q * 32; const float* X2 = X1 + 128 * XS;
    f32x4 v[8]; float ss = 0.f;
#pragma unroll
    for (int i = 0; i < 8; ++i) { const int ii = (i + 4 * (q >> 1)) & 7; const f32x4 a = *(const f32x4*)(X1 + 4 * ii), bb = *(const f32x4*)(X2 + 4 * ii);
      v[i] = a - lam * bb; ss += (v[i][0] * v[i][0] + v[i][1] * v[i][1]) + (v[i][2] * v[i][2] + v[i][3] * v[i][3]); }
    ss += __shfl_xor(ss, 1); ss += __shfl_xor(ss, 2);
    const float rn = __builtin_amdgcn_rsqf(ss * (1.f / 128.f) + EPS) * 0.8f * EXP_ATTSCALE;
    bf16_t* orow = mix + (size_t)(b * SEQ + q0 + row) * DM + h * 128 + q * 32;
#pragma unroll
    for (int i = 0; i < 8; i += 2) { const int i0 = (i + 4 * (q >> 1)) & 7;
      const f32x4 g0 = *(const f32x4*)(subln_g + q * 32 + 4 * i0), g1 = *(const f32x4*)(subln_g + q * 32 + 4 * i0 + 4);
      const f32x4 a = v[i] * rn * g0, bb = v[i + 1] * rn * g1;
      u32x4 w = {cvtpk(a[0], a[1]), cvtpk(a[2], a[3]), cvtpk(bb[0], bb[1]), cvtpk(bb[2], bb[3])};
      *(u32x4*)(orow + 4 * i0) = w; } }
  __syncthreads();
#undef SLOAD
#undef SWRITE
#undef SWAIT
#undef RESC
}
}
namespace lru {
__device__ __forceinline__ int crow(int r, int hi) { return (r & 3) + 8 * (r >> 2) + 4 * hi; }
__device__ __forceinline__ f32x8 lds_ld8(const LAS float* p) { const f32x4 a = *(const LAS f32x4*)p, b = *(const LAS f32x4*)(p + 4); return (f32x8){a[0], a[1], a[2], a[3], b[0], b[1], b[2], b[3]}; }
__device__ __forceinline__ void lds_st8(LAS float* p, f32x8 v) { *(LAS f32x4*)p = (f32x4){v[0], v[1], v[2], v[3]}; *(LAS f32x4*)(p + 4) = (f32x4){v[4], v[5], v[6], v[7]}; }
struct Params { const bf16_t* proj; float* ys; bf16_t* mix; unsigned* pair_cnt; const bf16x8* packw; const float *conv_w, *conv_b, *b_a, *b_x, *lambda; };
__device__ __forceinline__ void lru_item(int item, const Params& p, LAS unsigned char* lds) {
  int tid_l = threadIdx.x; asm volatile("" : "+v"(tid_l));
  const int tid = tid_l, wid = __builtin_amdgcn_readfirstlane(tid >> 6), lane = tid & 63, r32 = lane & 31, hi = lane >> 5;
  const int dir = item & 1, seg = wid, b = item >> 4, n = (item >> 1) & 7;
  LAS float* xcu = (LAS float*)(lds + wid * 16896);
  LAS float* abuf = (LAS float*)(lds + wid * 16896 + 8704);
  LAS float* tot = (LAS float*)(lds + LDS_TOT);
  LAS float* cwl = (LAS float*)(lds + LDS_CW);
  if (tid < 320) { const int k = tid >> 6, ch = tid & 63; cwl[tid] = (k < 4) ? p.conv_w[k * 512 + 64 * n + ch] : p.conv_b[64 * n + ch]; }
  bf16x8 Bf[2][2][4];
  { const bf16x8* pw = p.packw + (size_t)((dir * 8 + n) * 16) * 64 + lane;
#pragma unroll
    for (int g = 0; g < 2; ++g)
#pragma unroll
      for (int nb = 0; nb < 2; ++nb)
#pragma unroll
        for (int s = 0; s < 4; ++s) Bf[g][nb][s] = pw[((g * 2 + nb) * 4 + s) * 64]; }
  float ba[2], bx[2], cl2[2];
#pragma unroll
  for (int nb = 0; nb < 2; ++nb) { const int ch = dir * 512 + 64 * n + 32 * nb + r32; ba[nb] = p.b_a[ch]; bx[nb] = p.b_x[ch];
    const float lam = p.lambda[ch]; const float sp = (lam > 15.f) ? __expf(-lam) : log1pf(__expf(-lam));
    cl2[nb] = 8.f * sp * L2E; }
  float hc = 0.f;
  __syncthreads();
  const bf16_t* xr_base = p.proj + (size_t)(b * SEQ) * INW + 1536 + 64 * n;
  float* ybase = p.ys + (size_t)dir * T_ * 512 + (size_t)(b * SEQ) * 512 + 64 * n;
  u32x4 pre[5];
#define LRU_LOAD_RAW(T0) do { _Pragma("unroll") for (int i = 0; i < 5; ++i) { const int row = i * 8 + (lane >> 3), tt = (T0) - 2 + row; pre[i] = (u32x4){0u, 0u, 0u, 0u}; \
      if (row < 35 && tt >= 0 && tt < SEQ) pre[i] = *(const u32x4*)(xr_base + (size_t)tt * INW + (lane & 7) * 8); } } while (0)
  LRU_LOAD_RAW((dir ? 7 : 0) * 256 + seg * 32);
  for (int it = 0; it < 8; ++it) {
    const int tile = dir ? 7 - it : it, t0 = tile * 256 + seg * 32;
    { LAS unsigned char* raw = (LAS unsigned char*)abuf;
#pragma unroll
      for (int i = 0; i < 5; ++i) { const int row = i * 8 + (lane >> 3); if (row < 35) *(LAS u32x4*)(raw + row * 144 + (lane & 7) * 16) = pre[i]; }
      if (it < 7) LRU_LOAD_RAW((dir ? 6 - it : it + 1) * 256 + seg * 32);
#pragma unroll
      for (int cc = 0; cc < 4; ++cc) { const int ch0 = 32 * hi + 8 * cc;
        f32x8 acc = lds_ld8(cwl + 4 * 64 + ch0);
#pragma unroll
        for (int k = 0; k < 4; ++k) { const bf16x8 v = *(LAS const bf16x8*)(raw + (r32 + k) * 144 + ch0 * 2); const f32x8 w = lds_ld8(cwl + k * 64 + ch0);
#pragma unroll
          for (int j = 0; j < 8; ++j) acc[j] += w[j] * bf2f(v[j]); }
        lds_st8(xcu + r32 * 68 + ch0, acc); } }
    bf16x8 af[4];
#pragma unroll
    for (int s = 0; s < 4; ++s) af[s] = pack8(lds_ld8(xcu + r32 * 68 + 16 * s + 8 * hi));
#pragma unroll
    for (int nb = 0; nb < 2; ++nb) {
      f32x16 acca = {}, accx = {};
#pragma unroll
      for (int s = 0; s < 4; ++s) { acca = __builtin_amdgcn_mfma_f32_32x32x16_bf16(af[s], Bf[0][nb][s], acca, 0, 0, 0); accx = __builtin_amdgcn_mfma_f32_32x32x16_bf16(af[s], Bf[1][nb][s], accx, 0, 0, 0); }
#pragma unroll
      for (int rg = 0; rg < 16; ++rg) { const int tk = crow(rg, hi), ch = 32 * nb + r32;
        const float xc = xcu[tk * 68 + ch];
        const float ga = acca[rg] + ba[nb], gx = accx[rg] + bx[nb];
        const float r = __builtin_amdgcn_rcpf(1.f + __builtin_amdgcn_exp2f(-ga * L2E)), ii = __builtin_amdgcn_rcpf(1.f + __builtin_amdgcn_exp2f(-gx * L2E));
        const float a = __builtin_amdgcn_exp2f(-cl2[nb] * r);
        const float u = __builtin_amdgcn_sqrtf(fmaxf(fmaf(-a, a, 1.f), 0.f)) * ii * xc;
        abuf[tk * 64 + ch] = a; xcu[tk * 68 + ch] = u; }
    }
    { float P = 1.f, H = 0.f;
#pragma unroll 8
      for (int j = 0; j < 32; ++j) { const int tk = dir ? 31 - j : j; const float a = abuf[tk * 64 + lane], u = xcu[tk * 68 + lane];
        H = a * H + u; P *= a; abuf[tk * 64 + lane] = P; xcu[tk * 68 + lane] = H; }
      LAS float* tt = tot + (((it & 1) * 8 + seg) * 128);
      tt[lane] = P; tt[64 + lane] = H; }
    __syncthreads();
    float cin = hc;
    { float c = hc;
#pragma unroll
      for (int j = 0; j < 8; ++j) { const int sg = dir ? 7 - j : j; const LAS float* tt = tot + (((it & 1) * 8 + sg) * 128);
        const float Pj = tt[lane], Hj = tt[64 + lane]; if (sg == seg) cin = c; c = Pj * c + Hj; }
      hc = c; }
#pragma unroll 8
    for (int tk = 0; tk < 32; ++tk) __hip_atomic_store(ybase + (size_t)(t0 + tk) * 512 + lane, xcu[tk * 68 + lane] + abuf[tk * 64 + lane] * cin, __ATOMIC_RELAXED, __HIP_MEMORY_SCOPE_AGENT);
  }
  asm volatile("s_waitcnt vmcnt(0)" ::: "memory"); __syncthreads();
  volatile LAS unsigned* misc = (volatile LAS unsigned*)(lds + LDS_MISC);
  if (tid == 0) misc[1] = __hip_atomic_fetch_add(p.pair_cnt + (b * 8 + n), 1u, __ATOMIC_RELAXED, __HIP_MEMORY_SCOPE_AGENT);
  __syncthreads();
  const unsigned arrived = misc[1];
  if (arrived == 1u) {
    __builtin_amdgcn_fence(__ATOMIC_ACQUIRE, "agent");
    const float* yf = p.ys + (size_t)(b * SEQ) * 512 + 64 * n; const float* yb = yf + (size_t)T_ * 512;
    const bf16_t* gr = p.proj + (size_t)(b * SEQ) * INW + 2048 + 64 * n; bf16_t* mo = p.mix + (size_t)(b * SEQ) * DM + 512 + 64 * n;
#pragma unroll 8
    for (int idx = tid; idx < SEQ * 8; idx += 512) { const int t = idx >> 3, c8 = (idx & 7) * 8;
      const f32x8 a = *(const f32x8*)(yf + (size_t)t * 512 + c8), bb = *(const f32x8*)(yb + (size_t)t * 512 + c8); const bf16x8 g = *(const bf16x8*)(gr + (size_t)t * INW + c8);
      f32x8 o;
#pragma unroll
      for (int j = 0; j < 8; ++j) o[j] = gelu_tanh(bf2f(g[j])) * (a[j] + bb[j]) * EXP_LRUSCALE;
      *(bf16x8*)(mo + (size_t)t * DM + c8) = pack8(o); } }
  __syncthreads();
}
#undef LRU_LOAD_RAW
}
template <bool UPMAP>
__device__ __forceinline__ void p0_transpose_item(const float* __restrict__ W, int K, int N, bf16_t* WT, const float* __restrict__ kscale, LAS float* scr, int item, int lane) {
    const int nblk = N / 32, kb = item / nblk, nb = item % nblk, k0 = 64 * kb, n0 = 32 * nb;
#pragma unroll
    for (int i = 0; i < 32; ++i) { const int kk = 2 * i + (lane >> 5); float w = W[(size_t)(k0 + kk) * N + n0 + (lane & 31)]; if (kscale) w *= kscale[k0 + kk]; scr[kk * 33 + (lane & 31)] = w; }
    asm volatile("s_waitcnt lgkmcnt(0)" ::: "memory");
    const int c = lane & 7;
#pragma unroll
    for (int j = 0; j < 4; ++j) { const int n = (lane >> 3) + 8 * j; const LAS float* s = scr + (8 * c) * 33 + n;
        u32x4 o; o.x = cvtpk(s[0 * 33], s[1 * 33]); o.y = cvtpk(s[2 * 33], s[3 * 33]); o.z = cvtpk(s[4 * 33], s[5 * 33]); o.w = cvtpk(s[6 * 33], s[7 * 33]);
        int row = n0 + n;
        if (UPMAP) { const int f = row < FF ? row : row - FF; row = (f >> 7) * 256 + (row < FF ? 0 : 128) + (f & 127); }
        *(u32x4*)(WT + (size_t)row * K + k0 + 8 * c) = o; }
    asm volatile("s_waitcnt lgkmcnt(0)" ::: "memory");
}

#define XB_TMO      128
#define XB_XCNT(j)  (256  + 64 * (j))
#define XB_XSUB(j)  (1280 + 64 * (j))
#define XB_XGEN(j)  (2304 + 64 * (j))
#define XB_TOP      3328
#define XB_TOPGEN   3392
#define XCD_BAR_WORDS 3456
#define XB_SPIN_CAP (1u << 18)

__device__ __forceinline__ unsigned xb_ld(unsigned* p)              { return __hip_atomic_load(p, __ATOMIC_RELAXED, __HIP_MEMORY_SCOPE_AGENT); }
__device__ __forceinline__ unsigned xb_add(unsigned* p, unsigned v) { return __hip_atomic_fetch_add(p, v, __ATOMIC_RELAXED, __HIP_MEMORY_SCOPE_AGENT); }
__device__ __forceinline__ unsigned xb_xcc_id() { return (unsigned)__builtin_amdgcn_s_getreg((3 << 11) | 20) & 0xFu; }
#define XB_SPIN(cond, bar) do { unsigned _sp = 0; while (cond) { __builtin_amdgcn_s_sleep(1); \
    if ((++_sp & 255u) == 0u) { if (xb_ld(&(bar)[XB_TMO])) break; if (_sp > XB_SPIN_CAP) { atomicAdd(&(bar)[XB_TMO], 1u); break; } } } } while (0)

struct XcdBarrier {
    unsigned* bar; unsigned x;
    volatile LAS unsigned* st;
};

__device__ __forceinline__ XcdBarrier xcd_barrier_post(unsigned* bar, volatile LAS unsigned* st) {
    XcdBarrier b; b.bar = bar; b.x = xb_xcc_id(); b.st = st;
    if (threadIdx.x == 0) (void)xb_add(&bar[XB_XCNT(b.x)], 1u);
    return b;
}
__device__ __forceinline__ void xcd_barrier_complete(unsigned* bar, unsigned x, unsigned& nloc, unsigned& nx) {
    const unsigned G = gridDim.x * gridDim.y * gridDim.z;
    unsigned sum, cnt, mine, sp = 0u;
    for (;;) {
        sum = 0u; cnt = 0u; mine = 0u;
#pragma unroll
        for (unsigned j = 0; j < 16; ++j) { const unsigned c = xb_ld(&bar[XB_XCNT(j)]); sum += c; cnt += (c > 0u) ? 1u : 0u; mine = (j == x) ? c : mine; }
        if (sum == G) break;
        __builtin_amdgcn_s_sleep(1);
        if ((++sp & 255u) == 0u) { if (xb_ld(&bar[XB_TMO])) break; if (sp > XB_SPIN_CAP) { atomicAdd(&bar[XB_TMO], 1u); break; } }
    }
    nloc = mine > 0u ? mine : 1u; nx = cnt > 0u ? cnt : 1u;
}

__device__ __forceinline__ void xcd_barrier(const XcdBarrier& b) {
    asm volatile("s_waitcnt vmcnt(0)" ::: "memory");
    __syncthreads();
    if (threadIdx.x == 0) {
        unsigned* bar = b.bar;
        __builtin_amdgcn_s_waitcnt(0);
        unsigned nloc = b.st[0], nx = b.st[1];
        if (nloc == 0u) { xcd_barrier_complete(bar, b.x, nloc, nx); b.st[0] = nloc; b.st[1] = nx; }
        const unsigned old = xb_add(&bar[XB_XSUB(b.x)], 1u);
        const unsigned gen = old / nloc;
        if (old + 1u == (gen + 1u) * nloc) {
            __builtin_amdgcn_fence(__ATOMIC_RELEASE, "agent");
            asm volatile("s_waitcnt vmcnt(0)" ::: "memory");
            const unsigned og = xb_add(&bar[XB_TOP], 1u);
            const unsigned tg = og / nx;
            if (og + 1u == (tg + 1u) * nx) xb_add(&bar[XB_TOPGEN], 1u);
            else XB_SPIN(xb_ld(&bar[XB_TOPGEN]) == tg, bar);
            __builtin_amdgcn_fence(__ATOMIC_ACQUIRE, "agent");
            xb_add(&bar[XB_XGEN(b.x)], 1u);
            asm volatile("s_waitcnt vmcnt(0)" ::: "memory");
        } else {
            XB_SPIN(xb_ld(&bar[XB_XGEN(b.x)]) == gen, bar);
            __builtin_amdgcn_fence(__ATOMIC_ACQUIRE, "agent");
            asm volatile("s_waitcnt vmcnt(0)" ::: "memory");
        }
    }
    __syncthreads();
}

#ifndef PHMASK
#define PHMASK 127
#endif
struct Args { const float* in[22]; float* out; unsigned char* ws; };

__global__ void __launch_bounds__(512, 2) hymba_fwd(Args args) {
    extern __shared__ __attribute__((aligned(16))) unsigned char lds_raw[];
    LAS unsigned char* lds = (LAS unsigned char*)lds_raw;
    cg::grid_group grid = cg::this_grid();
    const int G = gridDim.x, bx = blockIdx.x;
    if (threadIdx.x < 32) ((volatile LAS unsigned*)(lds + LDS_MISC))[threadIdx.x] = 0u;
    __syncthreads();
    unsigned* barw = (unsigned*)(args.ws + WS_BAR);
    unsigned char* ws = args.ws;
    const float* x = args.in[0];
    unsigned* queue = (unsigned*)(ws + WS_QUEUE);
    float* ss1 = (float*)(ws + WS_SS1); float* ss2 = (float*)(ws + WS_SS2); float* rs0 = (float*)(ws + WS_RS0);
    bf16_t* Win_t = (bf16_t*)(ws + WS_WIN); bf16_t* Wout_t = (bf16_t*)(ws + WS_WOUT); bf16_t* Wup_t = (bf16_t*)(ws + WS_WUP); bf16_t* Wdn_t = (bf16_t*)(ws + WS_WDN);
    bf16_t* XB = (bf16_t*)(ws + WS_XB); bf16_t* PROJ = (bf16_t*)(ws + WS_PROJ); bf16_t* MIX = (bf16_t*)(ws + WS_MIX); bf16_t* ACT = (bf16_t*)(ws + WS_ACT);
    float* YS = (float*)(ws + WS_YS);

#if (PHMASK >> 0) & 1
    for (int rep = 0; rep < EXP_REP_P0; ++rep) {
        int tl = threadIdx.x; asm volatile("" : "+v"(tl)); const int tid = tl, lane = tl & 63, wave = __builtin_amdgcn_readfirstlane(tl >> 6);
        const int gw = bx * 8 + wave, NGW = G * 8;
        for (int i = bx * 512 + tid; i < (int)(WS_ZERO_BYTES / 4); i += G * 512) if (i < (int)(WS_RS0 / 4) || i >= (int)(WS_BAR / 4)) ((unsigned*)ws)[i] = 0u;
        for (int f = bx * 512 + tid; f < 32768; f += G * 512) {
            const int ln = f & 63, s = (f >> 6) & 3, nb = (f >> 8) & 1, gt = (f >> 9) & 1, dn = f >> 10;
            const float* W = (gt ? args.in[12] : args.in[10]) + (size_t)dn * 4096; f32x8 w;
#pragma unroll
            for (int j = 0; j < 8; ++j) w[j] = W[(16 * s + 8 * (ln >> 5) + j) * 64 + 32 * nb + (ln & 31)];
            ((bf16x8*)(ws + WS_PACKW))[f] = pack8(w); }
        LAS float* scr = (LAS float*)(lds + wave * 16384);
        constexpr int I_IN = (DM / 64) * (INW / 32);
        for (int it = gw; it < I_IN; it += NGW) p0_transpose_item<false>(args.in[2], DM, INW, Win_t, args.in[1], scr, it, lane);
        for (int m0 = gw; m0 < T_; m0 += 2 * NGW) {
            const int m1 = m0 + NGW;
            const f32x4* xa = (const f32x4*)(x + (size_t)m0 * DM) + lane; const f32x4* xb2 = (const f32x4*)(x + (size_t)(m1 < T_ ? m1 : m0) * DM) + lane;
            f32x4 va[4], vb[4]; float sa = 0.f, sb = 0.f;
#pragma unroll
            for (int j = 0; j < 4; ++j) { va[j] = xa[64 * j]; vb[j] = xb2[64 * j]; }
#pragma unroll
            for (int j = 0; j < 4; ++j) { sa += (va[j][0] * va[j][0] + va[j][1] * va[j][1]) + (va[j][2] * va[j][2] + va[j][3] * va[j][3]); sb += (vb[j][0] * vb[j][0] + vb[j][1] * vb[j][1]) + (vb[j][2] * vb[j][2] + vb[j][3] * vb[j][3]); }
            sa = wave_sum(sa); sb = wave_sum(sb);
            u32x2* oa = (u32x2*)(XB + (size_t)m0 * DM) + lane;
#pragma unroll
            for (int j = 0; j < 4; ++j) { u32x2 w; w.x = cvtpk(va[j][0], va[j][1]); w.y = cvtpk(va[j][2], va[j][3]); oa[64 * j] = w; }
            if (lane == 0) rs0[m0] = __builtin_amdgcn_rsqf(sa * (1.f / DM) + EPS);
            if (m1 < T_) { u32x2* ob = (u32x2*)(XB + (size_t)m1 * DM) + lane;
#pragma unroll
                for (int j = 0; j < 4; ++j) { u32x2 w; w.x = cvtpk(vb[j][0], vb[j][1]); w.y = cvtpk(vb[j][2], vb[j][3]); ob[64 * j] = w; }
                if (lane == 0) rs0[m1] = __builtin_amdgcn_rsqf(sb * (1.f / DM) + EPS); }
        }
    }
#endif
    grid.sync();
    const XcdBarrier xbar = xcd_barrier_post(barw, (volatile LAS unsigned*)(lds + LDS_MISC) + 8);

    for (int rep = 0; rep < EXP_EXTRA_SYNC; ++rep) xcd_barrier(xbar);
#if (PHMASK >> 1) & 1
    for (int rep = 0; rep < EXP_REP_P1; ++rep) {
        pg8::Gemm g{XB, Win_t, T_, INW, DM, 256}; pg8::StaticOrder S; S.init(T_, INW, G, bx);
        pg8::EpiProj E{PROJ, INW, rs0};
        pg8::gemm_phase<pg8::EpiProj, pg8::StaticOrder, true, true>(lds, g, S, E);
    }
#endif
    xcd_barrier(xbar);

#if (PHMASK >> 2) & 1
    {
        int tl = threadIdx.x; asm volatile("" : "+v"(tl)); const int tid = tl;
        float lam;
        { float d1 = 0.f, d2 = 0.f;
          for (int i = 0; i < 64; ++i) { d1 += args.in[3][i] * args.in[4][i]; d2 += args.in[5][i] * args.in[6][i]; }
          lam = __expf(d1) - __expf(d2) + 0.2f; }
        lru::Params lp{PROJ, YS, MIX, (unsigned*)(ws + WS_LCNT), (const bf16x8*)(ws + WS_PACKW), args.in[8], args.in[9], args.in[11], args.in[13], args.in[14]};
        volatile LAS unsigned* misc = (volatile LAS unsigned*)(lds + LDS_MISC);
#ifndef NO_LRU
        for (int rep = 0; rep < EXP_REP_LRU; ++rep)
        for (;;) {
            if (tid == 0) misc[0] = atomicAdd(queue + rep * 128, 1u);
            __syncthreads();
            const int item = (int)misc[0];
            __syncthreads();
            if (item >= 128) break;
            lru::lru_item(item, lp, lds);
        }
#endif
#ifndef NO_ATT
        for (int rep = 0; rep < EXP_REP_ATT; ++rep)
        for (;;) {
            if (tid == 0) misc[0] = atomicAdd(queue + 64 + rep * 128, 1u);
            __syncthreads();
            const int item = (int)misc[0];
            __syncthreads();
            if (item >= 512) break;
            att::attn_unit(item, PROJ, MIX, args.in[7], lam, (char*)lds_raw);
        }
#endif
        {
            constexpr int I_OUT = (DM / 64) * (DM / 32), I_UP = (DM / 64) * (FF2 / 32), NF = (I_OUT + I_UP) / 8;
            const int lane = tid & 63, wave = __builtin_amdgcn_readfirstlane(tid >> 6);
            LAS float* scr = (LAS float*)(lds + wave * 16384);
            for (;;) {
                if (tid == 0) misc[0] = atomicAdd(queue + 320, 1u);
                __syncthreads();
                const int item = (int)misc[0];
                __syncthreads();
                if (item >= NF) break;
                int r = item * 8 + wave;
                if (r < I_OUT) p0_transpose_item<false>(args.in[15], DM, DM, Wout_t, nullptr, scr, r, lane);
                else p0_transpose_item<true>(args.in[17], DM, FF2, Wup_t, args.in[16], scr, r - I_OUT, lane);
            }
        }
    }
#endif
    xcd_barrier(xbar);

#if (PHMASK >> 3) & 1
    {
        pg8::Gemm g{MIX, Wout_t, T_, DM, DM, 256}; pg8::StaticOrder S; S.init(T_, DM, G, bx);
        pg8::EpiResBf E{XB, ss1, (LAS float*)(lds + LDS_EDGE)};
        pg8::gemm_phase<pg8::EpiResBf, pg8::StaticOrder, true, true>(lds, g, S, E);
    }
#endif
    xcd_barrier(xbar);

#if (PHMASK >> 4) & 1
    for (int rep = 0; rep < EXP_REP_P4; ++rep) {
        pg8::Gemm g{XB - DM, Wup_t, 65 * 256, FF2, DM, 254}; pg8::StaticOrder S; S.init(65 * 256, FF2, G, bx);
        pg8::EpiUp E{ACT, ss1, args.in[18], args.in[19], (LAS float*)(lds + LDS_EDGE)};
        pg8::gemm_phase<pg8::EpiUp, pg8::StaticOrder, true, true>(lds, g, S, E);
    }
    {
        constexpr int I_DN = (FF / 64) * (DM / 32), NF4 = I_DN / 8;
        int tl = threadIdx.x; asm volatile("" : "+v"(tl)); const int tid = tl, lane = tid & 63, wave = __builtin_amdgcn_readfirstlane(tid >> 6);
        volatile LAS unsigned* misc = (volatile LAS unsigned*)(lds + LDS_MISC); LAS float* scr = (LAS float*)(lds + wave * 16384);
        for (;;) {
            if (tid == 0) misc[0] = atomicAdd(queue + 384, 1u);
            __syncthreads();
            const int item = (int)misc[0];
            __syncthreads();
            if (item >= NF4) break;
            p0_transpose_item<false>(args.in[20], FF, DM, Wdn_t, nullptr, scr, item * 8 + wave, lane);
        }
    }
#endif
    xcd_barrier(xbar);

#if (PHMASK >> 5) & 1
    {
        pg8::Gemm g{ACT, Wdn_t, T_, DM, FF, 256}; pg8::StaticOrder S; S.init(T_, DM, G, bx);
        pg8::EpiResNorm E{XB, args.out, ss2, (unsigned*)(ws + WS_PCNT), args.in[21], (LAS float*)(lds + LDS_EDGE)};
        pg8::gemm_phase<pg8::EpiResNorm, pg8::StaticOrder, true, true>(lds, g, S, E);
    }
#endif

}

extern "C" void kernel_launch(void* const* d_in, const int* in_sizes, int n_in, void* d_out, int out_size, void* d_ws, size_t ws_size, hipStream_t stream) {
    static int grid = 0;
    if (grid == 0) {
        if (n_in != 22 || out_size != T_ * DM || ws_size < WS_END) { fprintf(stderr, "kernel_launch: unexpected shapes (n_in %d out %d ws %zu)\n", n_in, out_size, ws_size); grid = -1; return; }
        int dev = 0, cus = 0, per_cu = 0;
        (void)hipGetDevice(&dev); (void)hipDeviceGetAttribute(&cus, hipDeviceAttributeMultiprocessorCount, dev);
        if (hipFuncSetAttribute((const void*)hymba_fwd, hipFuncAttributeMaxDynamicSharedMemorySize, LDS_BYTES) != hipSuccess) { fprintf(stderr, "kernel_launch: hipFuncSetAttribute failed\n"); grid = -1; return; }
        if (hipOccupancyMaxActiveBlocksPerMultiprocessor(&per_cu, (const void*)hymba_fwd, 512, LDS_BYTES) != hipSuccess || per_cu < 1) per_cu = 1;
        (void)hipGetLastError();
        grid = cus * 1;
        if (grid != 256) { fprintf(stderr, "kernel_launch: built for a 256-CU device (got %d)\n", cus); grid = 256; }
    }
    if (grid < 0) return;
    Args a{};
    for (int i = 0; i < 22; ++i) a.in[i] = (const float*)d_in[i];
    a.out = (float*)d_out; a.ws = (unsigned char*)d_ws;
    void* kargs[] = {&a};
    hipError_t e = hipLaunchCooperativeKernel((const void*)hymba_fwd, dim3(grid), dim3(512), kargs, LDS_BYTES, stream);
    if (e != hipSuccess) fprintf(stderr, "cooperative launch failed: %s (grid %d)\n", hipGetErrorString(e), grid);
}
```

```cpp
#include <hip/hip_runtime.h>
#include <hip/hip_cooperative_groups.h>
#include <cstdint>
#include <cstdio>
namespace cg = cooperative_groups;
#ifndef EXP_REP_LRU
#define EXP_REP_LRU 1
#endif
#ifndef EXP_REP_ATT
#define EXP_REP_ATT 1
#endif
#ifndef EXP_REP_P1
#define EXP_REP_P1 1
#endif
#ifndef EXP_REP_P4
#define EXP_REP_P4 1
#endif
#ifndef EXP_REP_P0
#define EXP_REP_P0 1
#endif
#ifndef EXP_EXTRA_SYNC
#define EXP_EXTRA_SYNC 0
#endif
#ifndef EXP_REP_P3
#define EXP_REP_P3 1
#endif
#ifndef EXP_REP_P5
#define EXP_REP_P5 1
#endif
#ifndef EXP_MIXSCALE
#define EXP_MIXSCALE 1.f
#endif
#ifndef EXP_FFNSCALE
#define EXP_FFNSCALE 1.f
#endif
#ifndef EXP_ATTSCALE
#define EXP_ATTSCALE 1.f
#endif
#ifndef EXP_LRUSCALE
#define EXP_LRUSCALE 1.f
#endif

#define LAS __attribute__((address_space(3)))
typedef short bf16x8 __attribute__((ext_vector_type(8)));
typedef short s16x4 __attribute__((ext_vector_type(4)));
typedef float f32x2 __attribute__((ext_vector_type(2)));
typedef float f32x4 __attribute__((ext_vector_type(4)));
typedef float f32x8 __attribute__((ext_vector_type(8)));
typedef float f32x16 __attribute__((ext_vector_type(16)));
typedef unsigned u32x2 __attribute__((ext_vector_type(2)));
typedef unsigned u32x4 __attribute__((ext_vector_type(4)));

constexpr int T_ = 16384, DM = 1024, SEQ = 2048, INW = 2560, FF = 2816, FF2 = 5632;
constexpr float EPS = 1e-6f, L2E = 1.4426950408889634f;
constexpr size_t MiB = 1u << 20;
constexpr size_t WS_BAR = 262144;
constexpr size_t WS_PCNT = 327680;
constexpr size_t WS_LCNT = 360448;
constexpr size_t WS_ZERO_BYTES = 393216;
constexpr size_t WS_QUEUE = 0, WS_SS1 = 65536, WS_SS2 = 131072, WS_RS0 = 196608;
constexpr size_t WS_WIN = 1 * MiB, WS_WOUT = 6 * MiB, WS_WUP = 8 * MiB, WS_WDN = 19 * MiB;
constexpr size_t WS_LAM = 458752;
constexpr size_t WS_PACKW = 25 * MiB;
constexpr size_t WS_XB = 26 * MiB;
constexpr size_t WS_PROJ = 59 * MiB;
constexpr size_t WS_MIX = 139 * MiB;
constexpr size_t WS_YS = 171 * MiB;
constexpr size_t WS_ACT = 59 * MiB;
constexpr size_t WS_END = 235 * MiB;
constexpr int LDS_EDGE = 131072, LDS_TOT = 135168, LDS_CW = 143360, LDS_MISC = 145408, LDS_BYTES = 147456;

__device__ __forceinline__ unsigned cvtpk(float lo, float hi) { unsigned r; asm volatile("v_cvt_pk_bf16_f32 %0, %1, %2" : "=v"(r) : "v"(lo), "v"(hi)); return r; }
__device__ __forceinline__ float bf2f(short s) { return __uint_as_float(((unsigned)(unsigned short)s) << 16); }
__device__ __forceinline__ bf16x8 pack8(f32x8 x) { u32x4 w = {cvtpk(x[0], x[1]), cvtpk(x[2], x[3]), cvtpk(x[4], x[5]), cvtpk(x[6], x[7])}; return __builtin_bit_cast(bf16x8, w); }
__device__ __forceinline__ float gelu_tanh(float x) {
    const float e = __builtin_amdgcn_exp2f(-2.302208198f * x * (1.f + 0.044715f * x * x));
    return x * __builtin_amdgcn_rcpf(1.f + e);
}
__device__ __forceinline__ float wave_sum(float v) {
#pragma unroll
    for (int o = 1; o < 64; o <<= 1) v += __shfl_xor(v, o);
    return v;
}
typedef unsigned short bf16_t;
namespace pg8 {
#define PG8_LAS __attribute__((address_space(3)))
constexpr int BM = 256, BK = 64, HALF = 128, HTB = HALF * BK * 2  , STAGE_BYTES = 8 * HTB, NXCD = 8, WGM = 8;

__host__ __device__ __forceinline__ int lds_byte(int r, int c) { const int st = (r >> 4) * 2 + (c >> 5), rr = r & 15, cc = c & 31, ob = rr * 64 + cc * 2; return st * 1024 + (ob ^ (((ob >> 9) & 1) << 5)); }
__host__ __device__ __forceinline__ void stage_rc(int b, int& R, int& C) { const int st = b / 1024, sb = b % 1024, swz = sb ^ (((sb >> 9) & 1) << 5); R = (st >> 1) * 16 + swz / 64; C = (st & 1) * 32 + (swz % 64) / 2; }
__host__ __device__ __forceinline__ int perm32(int rho) { const int n = rho >> 4, i = rho & 15; return 8 * (i >> 2) + 4 * n + (i & 3); }

struct Unit { int pm, pn; };
struct Gemm { const bf16_t* A; const bf16_t* Bt; int M, N, K, a_rows; };

struct StaticOrder {
    int nM, nN, nwg, G, c;
    __host__ __device__ void init(int M, int N, int G_, int c_) { nM = M / BM; nN = N / BM; nwg = nM * nN; G = G_; c = c_; }
    __host__ __device__ bool next(int i, Unit& u) const {
        const long L = (long)i * G + c; if (L >= nwg) return false;
        int wgid = (int)L; { const int q = nwg / NXCD, r = nwg % NXCD, xcd = wgid % NXCD, off = wgid / NXCD; wgid = (xcd < r ? xcd * (q + 1) : r * (q + 1) + (xcd - r) * q) + off; }
        const int nig = WGM * nN, gid = wgid / nig, fm = gid * WGM, gsz = (nM - fm) < WGM ? (nM - fm) : WGM;
        u.pm = fm + ((wgid % nig) % gsz); u.pn = (wgid % nig) / gsz; return true;
    }
    __device__ __forceinline__ void a_ready(const Unit&) const {}
    __device__ __forceinline__ void done(const Unit&) const {}
};
struct EpiProj {
    static constexpr bool PERM = true, AFTER_DRAIN = false;
    bf16_t* O; int ldc; const float* rs;
    __device__ __forceinline__ void operator()(f32x4 (&acc)[2][2][4][2], const Unit& u, int wr, int wc, int fr, int fq) const {
        const int row0 = u.pm * BM + wr * 64 + fr, col0 = u.pn * BM + wc * 32 + 8 * fq;
#pragma unroll
        for (int ai = 0; ai < 2; ++ai)
#pragma unroll
            for (int m = 0; m < 4; ++m) { const int row = row0 + ai * HALF + m * 16; const float s = rs[row]; bf16_t* rowp = O + (size_t)row * ldc + col0;
#pragma unroll
                for (int bj = 0; bj < 2; ++bj) { const f32x4 v0 = acc[ai][bj][m][0] * s, v1 = acc[ai][bj][m][1] * s;
                    u32x4 w; w.x = cvtpk(v0[0], v0[1]); w.y = cvtpk(v0[2], v0[3]); w.z = cvtpk(v1[0], v1[1]); w.w = cvtpk(v1[2], v1[3]);
                    *(u32x4*)(rowp + bj * HALF) = w; } }
    }
};
struct EpiRes {
    static constexpr bool PERM = false, AFTER_DRAIN = false;
    const float* base; float* out; bf16_t* xb; float* ss; float ascale;
    __device__ __forceinline__ void operator()(f32x4 (&acc)[2][2][4][2], const Unit& u, int wr, int wc, int fr, int fq) const {
        const int row0 = u.pm * BM + wr * 64 + fr, col0 = u.pn * BM + wc * 32 + 4 * fq;
#pragma unroll
        for (int ai = 0; ai < 2; ++ai)
#pragma unroll
            for (int m = 0; m < 4; ++m) { const int row = row0 + ai * HALF + m * 16; const size_t off = (size_t)row * 1024 + col0; float sq = 0.f;
#pragma unroll
                for (int bj = 0; bj < 2; ++bj)
#pragma unroll
                    for (int n = 0; n < 2; ++n) { const size_t o2 = off + bj * HALF + n * 16; const f32x4 b = *(const f32x4*)(base + o2); const f32x4 o = b + acc[ai][bj][m][n] * ascale;
                        *(f32x4*)(out + o2) = o; sq += (o[0] * o[0] + o[1] * o[1]) + (o[2] * o[2] + o[3] * o[3]);
                        if (xb) { u32x2 w; w.x = cvtpk(o[0], o[1]); w.y = cvtpk(o[2], o[3]); *(u32x2*)(xb + o2) = w; } }
                sq += __shfl_xor(sq, 16); sq += __shfl_xor(sq, 32);
                if (fq == 0) atomicAdd(ss + row, sq); }
    }
};
__device__ __forceinline__ float bflo(unsigned w) { return __uint_as_float(w << 16); }
__device__ __forceinline__ float bfhi(unsigned w) { return __uint_as_float(w & 0xffff0000u); }
struct EpiResBf {
    static constexpr bool PERM = true, AFTER_DRAIN = false;
    bf16_t* xb; float* ss; PG8_LAS float* red;
    __device__ __forceinline__ void operator()(f32x4 (&acc)[2][2][4][2], const Unit& u, int wr, int wc, int fr, int fq) const {
        const int row0 = u.pm * BM + wr * 64 + fr, col0 = u.pn * BM + wc * 32 + 8 * fq;
#pragma unroll
        for (int ai = 0; ai < 2; ++ai)
#pragma unroll
            for (int m = 0; m < 4; ++m) { const int row = row0 + ai * HALF + m * 16; const size_t off = (size_t)row * 1024 + col0; float sq = 0.f;
#pragma unroll
                for (int bj = 0; bj < 2; ++bj) { const size_t o2 = off + bj * HALF; const u32x4 bw = *(const u32x4*)(xb + o2);
                    const f32x4 o0 = (f32x4){bflo(bw.x), bfhi(bw.x), bflo(bw.y), bfhi(bw.y)} + acc[ai][bj][m][0], o1 = (f32x4){bflo(bw.z), bfhi(bw.z), bflo(bw.w), bfhi(bw.w)} + acc[ai][bj][m][1];
                    u32x4 w; w.x = cvtpk(o0[0], o0[1]); w.y = cvtpk(o0[2], o0[3]); w.z = cvtpk(o1[0], o1[1]); w.w = cvtpk(o1[2], o1[3]); *(u32x4*)(xb + o2) = w;
                    const float r0 = bflo(w.x), r1 = bfhi(w.x), r2 = bflo(w.y), r3 = bfhi(w.y), r4 = bflo(w.z), r5 = bfhi(w.z), r6 = bflo(w.w), r7 = bfhi(w.w);
                    sq += ((r0 * r0 + r1 * r1) + (r2 * r2 + r3 * r3)) + ((r4 * r4 + r5 * r5) + (r6 * r6 + r7 * r7)); }
                sq += __shfl_xor(sq, 16); sq += __shfl_xor(sq, 32);
                if (fq == 0) red[wc * 256 + ai * HALF + wr * 64 + m * 16 + fr] = sq; }
        asm volatile("s_waitcnt lgkmcnt(0)" ::: "memory"); __builtin_amdgcn_s_barrier(); asm volatile("" ::: "memory");
        if (threadIdx.x < 256) { const int r = threadIdx.x; atomicAdd(ss + u.pm * BM + r, (red[r] + red[256 + r]) + (red[512 + r] + red[768 + r])); }
    }
};
struct EpiResNorm {
    static constexpr bool PERM = true, AFTER_DRAIN = false;
    const bf16_t* base; float* out; float* ss; unsigned* cnt; const float* gain; PG8_LAS float* red;
    __device__ __forceinline__ void operator()(f32x4 (&acc)[2][2][4][2], const Unit& u, int wr, int wc, int fr, int fq) const {
        const int row0 = u.pm * BM + wr * 64 + fr, col0 = u.pn * BM + wc * 32 + 8 * fq;
#pragma unroll
        for (int ai = 0; ai < 2; ++ai)
#pragma unroll
            for (int m = 0; m < 4; ++m) { const int row = row0 + ai * HALF + m * 16; const size_t off = (size_t)row * 1024 + col0; float sq = 0.f;
#pragma unroll
                for (int bj = 0; bj < 2; ++bj) { const u32x4 bw = *(const u32x4*)(base + off + bj * HALF);
                    const f32x4 o0 = (f32x4){bflo(bw.x), bfhi(bw.x), bflo(bw.y), bfhi(bw.y)} + acc[ai][bj][m][0], o1 = (f32x4){bflo(bw.z), bfhi(bw.z), bflo(bw.w), bfhi(bw.w)} + acc[ai][bj][m][1];
                    acc[ai][bj][m][0] = o0; acc[ai][bj][m][1] = o1;
                    sq += ((o0[0] * o0[0] + o0[1] * o0[1]) + (o0[2] * o0[2] + o0[3] * o0[3])) + ((o1[0] * o1[0] + o1[1] * o1[1]) + (o1[2] * o1[2] + o1[3] * o1[3])); }
                sq += __shfl_xor(sq, 16); sq += __shfl_xor(sq, 32);
                if (fq == 0) red[wc * 256 + ai * HALF + wr * 64 + m * 16 + fr] = sq; }
        asm volatile("s_waitcnt lgkmcnt(0)" ::: "memory"); __builtin_amdgcn_s_barrier(); asm volatile("" ::: "memory");
        unsigned* pc = cnt + 64 * u.pm;
        if (threadIdx.x < 256) { const int r = threadIdx.x;
            __hip_atomic_fetch_add(ss + u.pm * BM + r, (red[r] + red[256 + r]) + (red[512 + r] + red[768 + r]), __ATOMIC_RELAXED, __HIP_MEMORY_SCOPE_AGENT);
            asm volatile("s_waitcnt vmcnt(0)" ::: "memory");
            if ((threadIdx.x & 63) == 0) __hip_atomic_fetch_add(pc, 1u, __ATOMIC_RELAXED, __HIP_MEMORY_SCOPE_AGENT); }
        if (threadIdx.x < 64) { unsigned sp = 0;
            while ((unsigned)__builtin_amdgcn_readfirstlane(__hip_atomic_load(pc, __ATOMIC_RELAXED, __HIP_MEMORY_SCOPE_AGENT)) < 16u) { __builtin_amdgcn_s_sleep(2); if (++sp > (1u << 22)) break; }
            __builtin_amdgcn_fence(__ATOMIC_ACQUIRE, "agent"); }
        asm volatile("s_waitcnt vmcnt(0) lgkmcnt(0)" ::: "memory"); __builtin_amdgcn_s_barrier(); asm volatile("" ::: "memory");
        f32x4 gv[2][2];
#pragma unroll
        for (int bj = 0; bj < 2; ++bj)
#pragma unroll
            for (int n = 0; n < 2; ++n) gv[bj][n] = *(const f32x4*)(gain + col0 + bj * HALF + n * 4);
#pragma unroll
        for (int ai = 0; ai < 2; ++ai)
#pragma unroll
            for (int m = 0; m < 4; ++m) { const int row = row0 + ai * HALF + m * 16; const size_t off = (size_t)row * 1024 + col0;
                const float rs = __builtin_amdgcn_rsqf(__hip_atomic_load(ss + row, __ATOMIC_RELAXED, __HIP_MEMORY_SCOPE_AGENT) * (1.f / 1024.f) + EPS);
#pragma unroll
                for (int bj = 0; bj < 2; ++bj)
#pragma unroll
                    for (int n = 0; n < 2; ++n) *(f32x4*)(out + off + bj * HALF + n * 4) = acc[ai][bj][m][n] * rs * gv[bj][n]; }
    }
};
__device__ __forceinline__ f32x4 dpp_shr1(f32x4 c, f32x4 old) { float r0 = old[0], r1 = old[1], r2 = old[2], r3 = old[3];
    asm("s_nop 1\n\tv_mov_b32_dpp %0, %4 row_shr:1 row_mask:0xf bank_mask:0xf\n\tv_mov_b32_dpp %1, %5 row_shr:1 row_mask:0xf bank_mask:0xf\n\tv_mov_b32_dpp %2, %6 row_shr:1 row_mask:0xf bank_mask:0xf\n\tv_mov_b32_dpp %3, %7 row_shr:1 row_mask:0xf bank_mask:0xf"
        : "+&v"(r0), "+&v"(r1), "+&v"(r2), "+&v"(r3) : "v"(c[0]), "v"(c[1]), "v"(c[2]), "v"(c[3]));
    return (f32x4){r0, r1, r2, r3}; }
__device__ __forceinline__ f32x4 dpp_shl1(f32x4 c, f32x4 old) { float r0 = old[0], r1 = old[1], r2 = old[2], r3 = old[3];
    asm("s_nop 1\n\tv_mov_b32_dpp %0, %4 row_shl:1 row_mask:0xf bank_mask:0xf\n\tv_mov_b32_dpp %1, %5 row_shl:1 row_mask:0xf bank_mask:0xf\n\tv_mov_b32_dpp %2, %6 row_shl:1 row_mask:0xf bank_mask:0xf\n\tv_mov_b32_dpp %3, %7 row_shl:1 row_mask:0xf bank_mask:0xf"
        : "+&v"(r0), "+&v"(r1), "+&v"(r2), "+&v"(r3) : "v"(c[0]), "v"(c[1]), "v"(c[2]), "v"(c[3]));
    return (f32x4){r0, r1, r2, r3}; }
__device__ __forceinline__ f32x4 dpp_mirror(f32x4 c) { float r0, r1, r2, r3;
    asm("s_nop 1\n\tv_mov_b32_dpp %0, %4 row_mirror row_mask:0xf bank_mask:0xf\n\tv_mov_b32_dpp %1, %5 row_mirror row_mask:0xf bank_mask:0xf\n\tv_mov_b32_dpp %2, %6 row_mirror row_mask:0xf bank_mask:0xf\n\tv_mov_b32_dpp %3, %7 row_mirror row_mask:0xf bank_mask:0xf"
        : "=&v"(r0), "=&v"(r1), "=&v"(r2), "=&v"(r3) : "v"(c[0]), "v"(c[1]), "v"(c[2]), "v"(c[3]));
    return (f32x4){r0, r1, r2, r3}; }
struct EpiUp {
    static constexpr bool PERM = true, AFTER_DRAIN = false;
    bf16_t* act; const float* ss1; const float* cw; const float* cb; PG8_LAS float* edge;
    __device__ __forceinline__ void operator()(f32x4 (&acc)[2][2][4][2], const Unit& u, int wr, int wc, int fr, int fq) const {
        const int tbase = u.pm * 254 - 1;
        const bool bnd = ((tbase + 1) >> 11) != ((tbase + 256) >> 11) || ((tbase + 1) & (SEQ - 1)) == 0 || tbase < 0;
#pragma unroll
        for (int ai = 0; ai < 2; ++ai)
#pragma unroll
            for (int m = 0; m < 4; ++m) { const int t = tbase + ai * HALF + wr * 64 + m * 16 + fr; float s = 0.f;
                if (t >= 0 && t < T_) s = __builtin_amdgcn_rsqf(ss1[t] * (1.f / 1024.f) + EPS);
#pragma unroll
                for (int bj = 0; bj < 2; ++bj)
#pragma unroll
                    for (int n = 0; n < 2; ++n) acc[ai][bj][m][n] *= s; }
        const int colw = wc * 32 + 4 * fq;
        if (fr == 0 || fr == 15) { const int e = (fr == 15) ? 1 : 0;
#pragma unroll
            for (int ai = 0; ai < 2; ++ai) { const int g = 2 * ai + wr;
#pragma unroll
                for (int bj = 0; bj < 2; ++bj)
#pragma unroll
                    for (int n = 0; n < 2; ++n) *(PG8_LAS f32x4*)(edge + ((g * 2 + e) * 256 + 128 * bj + colw + 16 * n)) = e ? acc[ai][bj][3][n] : acc[ai][bj][0][n]; } }
        asm volatile("s_waitcnt lgkmcnt(0)" ::: "memory"); __builtin_amdgcn_s_barrier(); asm volatile("" ::: "memory");
        u32x2 stash[2][4];
#pragma unroll
        for (int n = 0; n < 2; ++n) {
            const int f = u.pn * 128 + wc * 32 + 8 * fq + 4 * n;
            f32x4 w0[2], w1[2], w2[2], bb[2];
#pragma unroll
            for (int bj = 0; bj < 2; ++bj) { const int c = f + bj * FF; w0[bj] = *(const f32x4*)(cw + c); w1[bj] = *(const f32x4*)(cw + FF2 + c); w2[bj] = *(const f32x4*)(cw + 2 * FF2 + c); bb[bj] = *(const f32x4*)(cb + c); }
#pragma unroll
            for (int ai = 0; ai < 2; ++ai) { const int g = 2 * ai + wr;
#pragma unroll
                for (int m = 0; m < 4; ++m) { const int R = ai * HALF + wr * 64 + m * 16 + fr, t = tbase + R, tp = t & (SEQ - 1);
                    f32x4 uu[2];
#pragma unroll
                    for (int bj = 0; bj < 2; ++bj) { const f32x4 cur = acc[ai][bj][m][n]; f32x4 upe, dne;
                        if (m > 0) upe = dpp_mirror(acc[ai][bj][m - 1][n]); else upe = (g > 0) ? *(PG8_LAS const f32x4*)(edge + (((g - 1) * 2 + 1) * 256 + 128 * bj + colw + 16 * n)) : (f32x4){0.f, 0.f, 0.f, 0.f};
                        if (m < 3) dne = dpp_mirror(acc[ai][bj][m + 1][n]); else dne = (g < 3) ? *(PG8_LAS const f32x4*)(edge + (((g + 1) * 2 + 0) * 256 + 128 * bj + colw + 16 * n)) : (f32x4){0.f, 0.f, 0.f, 0.f};
                        f32x4 up = dpp_shr1(cur, upe), dn = dpp_shl1(cur, dne);
                        if (bnd) {
                            if (tp == 0) up = (f32x4){0.f, 0.f, 0.f, 0.f};
                            if (tp == SEQ - 1) dn = (f32x4){0.f, 0.f, 0.f, 0.f}; }
                        uu[bj] = bb[bj] + w0[bj] * up + w1[bj] * cur + w2[bj] * dn; }
                    { u32x2 w; w.x = cvtpk(gelu_tanh(uu[0][0]) * uu[1][0], gelu_tanh(uu[0][1]) * uu[1][1]); w.y = cvtpk(gelu_tanh(uu[0][2]) * uu[1][2], gelu_tanh(uu[0][3]) * uu[1][3]);
                        if (n == 0) stash[ai][m] = w;
                        else if (R >= 1 && R <= 254 && t < T_) *(u32x4*)(act + (size_t)t * FF + (f - 4)) = (u32x4){stash[ai][m].x, stash[ai][m].y, w.x, w.y}; } } }
        }
    }
};
template <class Epi, class Sched, bool ALIGN_EPI = false, bool SP2 = false>
__device__ __forceinline__ void gemm_phase(PG8_LAS unsigned char* lds, const Gemm g, const Sched& S, const Epi& E) {
    int tid_l = threadIdx.x; asm volatile("" : "+v"(tid_l));
    const int tid = tid_l, wid = __builtin_amdgcn_readfirstlane(tid >> 6), lane = tid & 63, wr = wid >> 2, wc = wid & 3, fr = lane & 15, fq = lane >> 4;
    const int K = g.K, nt = K / BK;
    unsigned voffA[2], voffB[2];
#pragma unroll
    for (int i = 0; i < 2; ++i) { int R, C; stage_rc(tid * 16 + i * 8192, R, C); const int Rb = Epi::PERM ? ((R & ~31) + perm32(R & 31)) : R;
        voffA[i] = (unsigned)(R * K + C) * 2u; voffB[i] = (unsigned)(Rb * K + C) * 2u; }
    const size_t kstep = (size_t)(BK * 2);
    const size_t hstep = (size_t)HALF * K * 2;
    const size_t tstep = 2 * hstep; const size_t tstepA = (size_t)g.a_rows * K * 2;
    const unsigned ldsw = (unsigned)wid * 1024u;
    const int aoff = lds_byte(wr * 64 + fr, fq * 8), boff = lds_byte(wc * 32 + fr, fq * 8);
#define PG8_SA(b, h) (((b) * 2 + (h)) * HTB)
#define PG8_SB(b, h) ((4 + (b) * 2 + (h)) * HTB)
#define PG8_STAGE(bufoff, gbase, voff) do { _Pragma("unroll") for (int _i = 0; _i < 2; ++_i) \
        __builtin_amdgcn_global_load_lds((const unsigned*)((const char*)(gbase) + (voff)[_i]), (PG8_LAS unsigned*)(lds + (bufoff) + ldsw + _i * 8192), 16, 0, 0); } while (0)
#define PG8_LDA(dst, b, h) do { _Pragma("unroll") for (int m = 0; m < 4; ++m) _Pragma("unroll") for (int k = 0; k < 2; ++k) dst[m][k] = *(const PG8_LAS bf16x8*)(lds + PG8_SA(b, h) + aoff + m * 2048 + k * 1024); } while (0)
#define PG8_LDB(dst, b, h) do { _Pragma("unroll") for (int n = 0; n < 2; ++n) _Pragma("unroll") for (int k = 0; k < 2; ++k) dst[n][k] = *(const PG8_LAS bf16x8*)(lds + PG8_SB(b, h) + boff + n * 2048 + k * 1024); } while (0)
#define PG8_MMA(ai, bj, At, Bt) do { __builtin_amdgcn_s_setprio(1); _Pragma("unroll") for (int m = 0; m < 4; ++m) _Pragma("unroll") for (int n = 0; n < 2; ++n) _Pragma("unroll") for (int k = 0; k < 2; ++k) \
        acc[ai][bj][m][n] = __builtin_amdgcn_mfma_f32_16x16x32_bf16(Bt[n][k], At[m][k], acc[ai][bj][m][n], 0, 0, 0); __builtin_amdgcn_s_setprio(0); } while (0)
#define PG8_WAIT_V(n) asm volatile("s_waitcnt vmcnt(" #n ")" ::: "memory")
#define PG8_WAIT_L(n) asm volatile("s_waitcnt lgkmcnt(" #n ")" ::: "memory")
#define PG8_BAR __builtin_amdgcn_s_barrier()
#define PG8_SCHED __builtin_amdgcn_sched_barrier(0)
    Unit cur, nxt; int ui = 0;
    if (!S.next(0, cur)) return;
    f32x4 acc[2][2][4][2];
#pragma unroll
    for (int a = 0; a < 2; ++a)
#pragma unroll
        for (int b = 0; b < 2; ++b)
#pragma unroll
            for (int m = 0; m < 4; ++m)
#pragma unroll
                for (int n = 0; n < 2; ++n) acc[a][b][m][n] = (f32x4){0.f, 0.f, 0.f, 0.f};
    bf16x8 At[4][2], B0[2][2], B1[2][2];
    const char* cA = (const char*)g.A + (size_t)cur.pm * tstepA; const char* cB = (const char*)g.Bt + (size_t)cur.pn * tstep;
    S.a_ready(cur);
    if constexpr (SP2) {
        PG8_STAGE(PG8_SB(0, 0), cB, voffB); PG8_STAGE(PG8_SB(0, 1), cB + hstep, voffB); PG8_STAGE(PG8_SA(0, 0), cA, voffA); PG8_STAGE(PG8_SA(0, 1), cA + hstep, voffA);
        if (wr == 1) PG8_BAR;
        PG8_WAIT_V(2); PG8_BAR;
        PG8_STAGE(PG8_SB(1, 0), cB + kstep, voffB); PG8_STAGE(PG8_SA(1, 0), cA + kstep, voffA); PG8_STAGE(PG8_SB(1, 1), cB + hstep + kstep, voffB);
        PG8_WAIT_V(6); PG8_BAR;
    } else {
        PG8_STAGE(PG8_SB(0, 0), cB, voffB); PG8_STAGE(PG8_SA(0, 0), cA, voffA); PG8_STAGE(PG8_SB(0, 1), cB + hstep, voffB); PG8_STAGE(PG8_SA(0, 1), cA + hstep, voffA);
        if (wr == 1) PG8_BAR;
        PG8_WAIT_V(4); PG8_BAR;
        PG8_STAGE(PG8_SB(1, 0), cB + kstep, voffB); PG8_STAGE(PG8_SA(1, 0), cA + kstep, voffA); PG8_STAGE(PG8_SB(1, 1), cB + hstep + kstep, voffB);
        PG8_WAIT_V(6); PG8_BAR;
    }
    for (;;) {
        const bool has_next = S.next(ui + 1, nxt);
        const char* nA = has_next ? (const char*)g.A + (size_t)nxt.pm * tstepA : cA; const char* nB = has_next ? (const char*)g.Bt + (size_t)nxt.pn * tstep : cB;
        for (int t = 0; t < nt; t += 2) {
            const bool last = (t == nt - 2);
            const char* a1 = cA + (size_t)(t + 1) * kstep;
            const char* a2 = last ? nA : cA + (size_t)(t + 2) * kstep; const char* b2 = last ? nB : cB + (size_t)(t + 2) * kstep;
            const char* a3 = a2 + kstep; const char* b3 = b2 + kstep;
            if (last && has_next) S.a_ready(nxt);
            if constexpr (SP2) {
            PG8_LDB(B0, 0, 0); PG8_LDB(B1, 0, 1); PG8_SCHED; PG8_LDA(At, 0, 0); PG8_STAGE(PG8_SA(1, 1), a1 + hstep, voffA);
            PG8_WAIT_V(8); PG8_WAIT_L(0); PG8_BAR; PG8_MMA(0, 0, At, B0); PG8_MMA(0, 1, At, B1); PG8_BAR; PG8_SCHED;
            PG8_LDA(At, 0, 1); PG8_STAGE(PG8_SB(0, 0), b2, voffB); PG8_STAGE(PG8_SB(0, 1), b2 + hstep, voffB); PG8_STAGE(PG8_SA(0, 0), a2, voffA);
            PG8_WAIT_V(8); PG8_WAIT_L(0); PG8_BAR; PG8_MMA(1, 0, At, B0); PG8_MMA(1, 1, At, B1); PG8_BAR; PG8_SCHED;
            PG8_LDB(B0, 1, 0); PG8_LDB(B1, 1, 1); PG8_SCHED; PG8_LDA(At, 1, 0); PG8_STAGE(PG8_SA(0, 1), a2 + hstep, voffA);
            PG8_WAIT_V(8); PG8_WAIT_L(0); PG8_BAR; PG8_MMA(0, 0, At, B0); PG8_MMA(0, 1, At, B1); PG8_BAR; PG8_SCHED;
            PG8_LDA(At, 1, 1); PG8_STAGE(PG8_SB(1, 0), b3, voffB); PG8_STAGE(PG8_SB(1, 1), b3 + hstep, voffB); PG8_STAGE(PG8_SA(1, 0), a3, voffA);
            PG8_WAIT_V(8); PG8_WAIT_L(0); PG8_BAR; PG8_MMA(1, 0, At, B0); PG8_MMA(1, 1, At, B1); PG8_BAR; PG8_SCHED;
            } else {
            PG8_LDB(B0, 0, 0); PG8_SCHED; PG8_LDA(At, 0, 0); PG8_STAGE(PG8_SA(1, 1), a1 + hstep, voffA);
            PG8_WAIT_L(8); PG8_BAR; PG8_WAIT_L(0); PG8_MMA(0, 0, At, B0); PG8_BAR; PG8_SCHED;
            PG8_LDB(B1, 0, 1); PG8_STAGE(PG8_SB(0, 0), b2, voffB);
            PG8_BAR; PG8_WAIT_L(0); PG8_MMA(0, 1, At, B1); PG8_BAR;
            PG8_LDA(At, 0, 1); PG8_STAGE(PG8_SA(0, 0), a2, voffA);
            PG8_BAR; PG8_WAIT_L(0); PG8_MMA(1, 0, At, B0); PG8_BAR; PG8_SCHED;
            PG8_STAGE(PG8_SB(0, 1), b2 + hstep, voffB);
            PG8_WAIT_V(6); PG8_BAR; PG8_MMA(1, 1, At, B1); PG8_BAR;
            PG8_LDB(B0, 1, 0); PG8_SCHED; PG8_LDA(At, 1, 0); PG8_STAGE(PG8_SA(0, 1), a2 + hstep, voffA);
            PG8_WAIT_L(8); PG8_BAR; PG8_WAIT_L(0); PG8_MMA(0, 0, At, B0); PG8_BAR; PG8_SCHED;
            PG8_LDB(B1, 1, 1); PG8_STAGE(PG8_SB(1, 0), b3, voffB);
            PG8_BAR; PG8_WAIT_L(0); PG8_MMA(0, 1, At, B1); PG8_BAR;
            PG8_LDA(At, 1, 1); PG8_STAGE(PG8_SA(1, 0), a3, voffA);
            PG8_BAR; PG8_WAIT_L(0); PG8_MMA(1, 0, At, B0); PG8_BAR; PG8_SCHED;
            PG8_STAGE(PG8_SB(1, 1), b3 + hstep, voffB);
            PG8_WAIT_V(6); PG8_BAR; PG8_MMA(1, 1, At, B1); PG8_BAR;
            }
        }
        if constexpr (ALIGN_EPI) { if (wr == 0) PG8_BAR; }
        if constexpr (!Epi::AFTER_DRAIN) { E(acc, cur, wr, wc, fr, fq); S.done(cur); }
        if (!has_next) break;
#pragma unroll
        for (int a = 0; a < 2; ++a)
#pragma unroll
            for (int b = 0; b < 2; ++b)
#pragma unroll
                for (int m = 0; m < 4; ++m)
#pragma unroll
                    for (int n = 0; n < 2; ++n) acc[a][b][m][n] = (f32x4){0.f, 0.f, 0.f, 0.f};
        cur = nxt; cA = nA; cB = nB; ++ui;
        if constexpr (ALIGN_EPI) { if (wr == 1) PG8_BAR; }
    }
    PG8_WAIT_V(0);
    if constexpr (!ALIGN_EPI) { if (wr == 0) PG8_BAR; }
    PG8_BAR;
    if constexpr (Epi::AFTER_DRAIN) { E.fused(acc, cur, wr, wc, fr, fq, lds, wid, lane); S.done(cur); }
#undef PG8_SA
#undef PG8_SB
#undef PG8_STAGE
#undef PG8_LDA
#undef PG8_LDB
#undef PG8_MMA
#undef PG8_WAIT_V
#undef PG8_WAIT_L
#undef PG8_BAR
#undef PG8_SCHED
}
}
namespace att {
constexpr int LD = INW, KVBLK = 64;
constexpr size_t SHM_V = KVBLK * 128 * 2, SHM_K = KVBLK * 128 * 2;
constexpr float THR2 = 8.f * L2E;
#define KSWZ(row, colB) ((row) * 256 + ((colB) ^ (((row) & 7) << 4)))
#define SBAR() __builtin_amdgcn_sched_barrier(0)
__device__ __forceinline__ int crow(int r, int hi) { return (r & 3) + 8 * (r >> 2) + 4 * hi; }
__device__ __forceinline__ void partialSM(f32x16& p0, f32x16& p1, float& m_reg, float& mn, float& alpha, float dqs, float sl2) {
  constexpr float C = 0.125f * L2E;
#pragma unroll
  for (int r = 0; r < 16; ++r) { const float k0 = (float)((r & 3) + 8 * (r >> 2));
    p0[r] = fmaf(p0[r], C, -fabsf(fmaf(sl2, -k0, dqs))); p1[r] = fmaf(p1[r], C, -fabsf(fmaf(sl2, -(k0 + 32.f), dqs))); }
  float pmax = p0[0];
#pragma unroll
  for (int r = 1; r < 16; ++r) pmax = fmaxf(pmax, p0[r]);
#pragma unroll
  for (int r = 0; r < 16; ++r) pmax = fmaxf(pmax, p1[r]);
  { auto rr = __builtin_amdgcn_permlane32_swap(__float_as_uint(pmax), __float_as_uint(pmax), false, false);
    pmax = fmaxf(__uint_as_float(rr[0]), __uint_as_float(rr[1])); }
  if (__builtin_expect(__all(pmax - m_reg <= THR2), 1)) { mn = m_reg; alpha = 1.f; }
  else { mn = fmaxf(m_reg, pmax); alpha = __builtin_amdgcn_exp2f(m_reg - mn); m_reg = mn; }
#pragma unroll
  for (int r = 0; r < 16; ++r) { p0[r] -= mn; p1[r] -= mn; }
#pragma unroll
  for (int r = 0; r < 16; ++r) p0[r] = __builtin_amdgcn_exp2f(p0[r]);
}
__device__ __forceinline__ void partialSM1(f32x16& p0, f32x16& p1, float& m_reg, float& mn, float& alpha, float dqs, float sl2, int side) {
  constexpr float C = 0.125f * L2E;
  const float sg = side > 0 ? -sl2 : sl2, D0 = side > 0 ? (m_reg + dqs) : (m_reg - dqs);
  const f32x2 sg2 = {sg, sg}, C2 = {C, C}, Da = {D0, D0}, Db = {fmaf(sg, 32.f, D0), fmaf(sg, 32.f, D0)};
#pragma unroll
  for (int r = 0; r < 16; r += 2) {
    const f32x2 kk = {(float)((r & 3) + 8 * (r >> 2)), (float)(((r + 1) & 3) + 8 * ((r + 1) >> 2))};
    const f32x2 b0 = __builtin_elementwise_fma(sg2, kk, Da), b1 = __builtin_elementwise_fma(sg2, kk, Db);
    const f32x2 x0 = __builtin_elementwise_fma((f32x2){p0[r], p0[r + 1]}, C2, -b0), x1 = __builtin_elementwise_fma((f32x2){p1[r], p1[r + 1]}, C2, -b1);
    p0[r] = x0[0]; p0[r + 1] = x0[1]; p1[r] = x1[0]; p1[r + 1] = x1[1]; }
  float pmax = p0[0];
#pragma unroll
  for (int r = 1; r < 16; ++r) pmax = fmaxf(pmax, p0[r]);
#pragma unroll
  for (int r = 0; r < 16; ++r) pmax = fmaxf(pmax, p1[r]);
  { auto rr = __builtin_amdgcn_permlane32_swap(__float_as_uint(pmax), __float_as_uint(pmax), false, false);
    pmax = fmaxf(__uint_as_float(rr[0]), __uint_as_float(rr[1])); }
  if (__builtin_expect(__all(pmax <= THR2), 1)) { mn = m_reg; alpha = 1.f; }
  else { const float pm = fmaxf(pmax, 0.f); mn = m_reg + pm; alpha = __builtin_amdgcn_exp2f(-pm); m_reg = mn;
#pragma unroll
    for (int r = 0; r < 16; ++r) { p0[r] -= pm; p1[r] -= pm; } }
#pragma unroll
  for (int r = 0; r < 16; ++r) p0[r] = __builtin_amdgcn_exp2f(p0[r]);
}
__device__ __forceinline__ void finishSM(f32x16& p0, f32x16& p1, float alpha, float& l_reg, bf16x8& pa0, bf16x8& pa1, bf16x8& pa2, bf16x8& pa3) {
#pragma unroll
  for (int r = 0; r < 16; ++r) p1[r] = __builtin_amdgcn_exp2f(p1[r]);
  f32x2 ps2 = {0.f, 0.f};
#pragma unroll
  for (int r = 0; r < 16; r += 2) ps2 += (f32x2){p0[r], p0[r + 1]};
#pragma unroll
  for (int r = 0; r < 16; r += 2) ps2 += (f32x2){p1[r], p1[r + 1]};
  float ps = ps2[0] + ps2[1];
  { auto rr = __builtin_amdgcn_permlane32_swap(__float_as_uint(ps), __float_as_uint(ps), false, false);
    ps = __uint_as_float(rr[0]) + __uint_as_float(rr[1]); }
  l_reg = l_reg * alpha + ps;
#define PK4(P, BASE, OUT) do { unsigned a0 = cvtpk(P[BASE + 0], P[BASE + 1]), a1 = cvtpk(P[BASE + 2], P[BASE + 3]);   \
    unsigned b0 = cvtpk(P[BASE + 4], P[BASE + 5]), b1 = cvtpk(P[BASE + 6], P[BASE + 7]);                              \
    auto r0 = __builtin_amdgcn_permlane32_swap(a0, b0, false, false); auto r1 = __builtin_amdgcn_permlane32_swap(a1, b1, false, false); \
    u32x4 w = {r0[0], r1[0], r0[1], r1[1]}; OUT = __builtin_bit_cast(bf16x8, w); } while (0)
  PK4(p0, 0, pa0); PK4(p0, 8, pa1); PK4(p1, 0, pa2); PK4(p1, 8, pa3);
#undef PK4
}
__device__ __forceinline__ void qkt(f32x16& p0, f32x16& p1, const char* Ks, const bf16x8* qr, int r32, int hi, int c) {
  p0 = f32x16{}; p1 = f32x16{};
#pragma unroll
  for (int d0 = 0; d0 < 4; ++d0) { const int cb = (c * 64 + d0 * 16 + hi * 8) * 2;
    bf16x8 b0 = *reinterpret_cast<const bf16x8*>(Ks + KSWZ(r32, cb));
    bf16x8 b1 = *reinterpret_cast<const bf16x8*>(Ks + KSWZ(32 + r32, cb));
    p0 = __builtin_amdgcn_mfma_f32_32x32x16_bf16(b0, qr[d0], p0, 0, 0, 0);
    p1 = __builtin_amdgcn_mfma_f32_32x32x16_bf16(b1, qr[d0], p1, 0, 0, 0); }
}
__device__ __forceinline__ int v_st(int k, int c) { const int kk = (k & ~0xC) | ((k & 4) << 1) | ((k & 8) >> 1); return ((kk >> 3) * 4 + (c >> 5)) * 512 + ((kk & 7) * 32 + (c & 31)) * 2; }
__device__ __forceinline__ int v_rd_base(int lane) { return ((lane & 3) << 3) | (((lane >> 2) & 3) << 6) | (((lane >> 4) & 1) << 5) | (((lane >> 5) & 1) << 8); }
constexpr int v_rd_off(int d0, int ks, int half) { return d0 * 512 + ks * 4096 + half * 2048; }
template <int OFF> __device__ __forceinline__ s16x4 tr_read(int vb) {
  s16x4 r; asm volatile("ds_read_b64_tr_b16 %0, %1 offset:%2" : "=&v"(r) : "v"(vb), "i"(OFF) : "memory"); return r;
}
template <int D0> __device__ __forceinline__ void pv_one(f32x16& od, int vb, bf16x8 pa0, bf16x8 pa1, bf16x8 pa2, bf16x8 pa3) {
  const s16x4 l0 = tr_read<v_rd_off(D0, 0, 0)>(vb), h0 = tr_read<v_rd_off(D0, 0, 1)>(vb), l1 = tr_read<v_rd_off(D0, 1, 0)>(vb), h1 = tr_read<v_rd_off(D0, 1, 1)>(vb);
  const s16x4 l2 = tr_read<v_rd_off(D0, 2, 0)>(vb), h2 = tr_read<v_rd_off(D0, 2, 1)>(vb), l3 = tr_read<v_rd_off(D0, 3, 0)>(vb), h3 = tr_read<v_rd_off(D0, 3, 1)>(vb);
  asm volatile("s_waitcnt lgkmcnt(0)" ::: "memory"); SBAR();
#define PK(L, H) (bf16x8){L[0], L[1], L[2], L[3], H[0], H[1], H[2], H[3]}
  od = __builtin_amdgcn_mfma_f32_32x32x16_bf16(pa0, PK(l0, h0), od, 0, 0, 0);
  od = __builtin_amdgcn_mfma_f32_32x32x16_bf16(pa1, PK(l1, h1), od, 0, 0, 0);
  od = __builtin_amdgcn_mfma_f32_32x32x16_bf16(pa2, PK(l2, h2), od, 0, 0, 0);
  od = __builtin_amdgcn_mfma_f32_32x32x16_bf16(pa3, PK(l3, h3), od, 0, 0, 0);
#undef PK
}
__device__ __forceinline__ void pv_d0(f32x16* o, int vb, bf16x8 pa0, bf16x8 pa1, bf16x8 pa2, bf16x8 pa3) {
  pv_one<0>(o[0], vb, pa0, pa1, pa2, pa3); pv_one<1>(o[1], vb, pa0, pa1, pa2, pa3); pv_one<2>(o[2], vb, pa0, pa1, pa2, pa3); pv_one<3>(o[3], vb, pa0, pa1, pa2, pa3);
}
__device__ __forceinline__ void pv_sm1(f32x16* o, int vb, bf16x8 pa0, bf16x8 pa1, bf16x8 pa2, bf16x8 pa3, f32x16& p0, f32x16& p1, float& m_reg, float& mn, float& alpha, float dqs, float sl2, int side) {
  constexpr float C = 0.125f * L2E;
  const float sg = side > 0 ? -sl2 : sl2, D0 = side > 0 ? (m_reg + dqs) : (m_reg - dqs);
  const f32x2 sg2 = {sg, sg}, C2 = {C, C}, Da = {D0, D0}, Db = {fmaf(sg, 32.f, D0), fmaf(sg, 32.f, D0)};
  pv_one<0>(o[0], vb, pa0, pa1, pa2, pa3);
#pragma unroll
  for (int r = 0; r < 16; r += 2) { const f32x2 kk = {(float)((r & 3) + 8 * (r >> 2)), (float)(((r + 1) & 3) + 8 * ((r + 1) >> 2))};
    const f32x2 x0 = __builtin_elementwise_fma((f32x2){p0[r], p0[r + 1]}, C2, -__builtin_elementwise_fma(sg2, kk, Da)); p0[r] = x0[0]; p0[r + 1] = x0[1]; }
  pv_one<1>(o[1], vb, pa0, pa1, pa2, pa3);
#pragma unroll
  for (int r = 0; r < 16; r += 2) { const f32x2 kk = {(float)((r & 3) + 8 * (r >> 2)), (float)(((r + 1) & 3) + 8 * ((r + 1) >> 2))};
    const f32x2 x1 = __builtin_elementwise_fma((f32x2){p1[r], p1[r + 1]}, C2, -__builtin_elementwise_fma(sg2, kk, Db)); p1[r] = x1[0]; p1[r + 1] = x1[1]; }
  pv_one<2>(o[2], vb, pa0, pa1, pa2, pa3);
  float pmax = p0[0];
#pragma unroll
  for (int r = 1; r < 16; ++r) pmax = fmaxf(pmax, p0[r]);
#pragma unroll
  for (int r = 0; r < 16; ++r) pmax = fmaxf(pmax, p1[r]);
  { auto rr = __builtin_amdgcn_permlane32_swap(__float_as_uint(pmax), __float_as_uint(pmax), false, false);
    pmax = fmaxf(__uint_as_float(rr[0]), __uint_as_float(rr[1])); }
  if (__builtin_expect(__all(pmax <= THR2), 1)) { mn = m_reg; alpha = 1.f; }
  else { const float pm = fmaxf(pmax, 0.f); mn = m_reg + pm; alpha = __builtin_amdgcn_exp2f(-pm); m_reg = mn;
#pragma unroll
    for (int r = 0; r < 16; ++r) { p0[r] -= pm; p1[r] -= pm; } }
  pv_one<3>(o[3], vb, pa0, pa1, pa2, pa3);
#pragma unroll
  for (int r = 0; r < 16; ++r) p0[r] = __builtin_amdgcn_exp2f(p0[r]);
}
constexpr int XS = 132;

__device__ __forceinline__ void attn_unit(int unit, const bf16_t* __restrict__ proj, bf16_t* __restrict__ mix, const float* __restrict__ subln_g, float lam, char* lds) {
  const int b = unit >> 6, h = (unit >> 4) & 3, qb = unit & 15;
  int tid_l = threadIdx.x; asm volatile("" : "+v"(tid_l));
  const int tid = tid_l, wid = tid >> 6, lane = tid & 63, r32 = lane & 31, hi = lane >> 5, c = wid >> 2, wq = wid & 3;
  const int q0 = qb * 128;
  const bf16_t* Qb = proj + (size_t)(b * SEQ + q0) * LD + h * 128 + c * 64;
  const bf16_t* Kh = proj + (size_t)(b * SEQ) * LD + 512 + h * 128;
  const bf16_t* Vh = proj + (size_t)(b * SEQ) * LD + 1024 + h * 128;
  char* V_lds = lds; char* K_lds = lds + 3 * SHM_V;
  float* ws = (float*)(lds + 3 * SHM_V + 3 * SHM_K) + wid * 64; float* li_l = ws; float* al_l = ws + 32;
  float m_reg = -1e30f, l_reg = 0; f32x16 o[4] = {}; bf16x8 qr[4];
  const bf16_t* Qw = Qb + (size_t)(wq * 32 + r32) * LD + hi * 8;
#pragma unroll
  for (int d0 = 0; d0 < 4; ++d0) qr[d0] = *reinterpret_cast<const bf16x8*>(Qw + d0 * 16);
  const float sl2 = __builtin_amdgcn_exp2f(-2.f * (float)(h + 1)) * L2E;
  float dqs = sl2 * (float)(q0 + wq * 32 + r32 - 4 * hi);
  const int sr = tid >> 4, sc = (tid & 15) * 8, vst0 = v_st(sr, sc), vst1 = v_st(32 + sr, sc);
  const int vb0 = (int)(uintptr_t)V_lds + v_rd_base(lane);
  struct { bf16x8 vs0, vs1, ks0, ks1; } sr_[1];
#define SLOAD(i, k0) do { sr_[i].vs0 = *(const bf16x8*)(&Vh[(size_t)((k0) + sr) * LD + sc]); sr_[i].vs1 = *(const bf16x8*)(&Vh[(size_t)((k0) + 32 + sr) * LD + sc]); \
    sr_[i].ks0 = *(const bf16x8*)(&Kh[(size_t)((k0) + sr) * LD + sc]); sr_[i].ks1 = *(const bf16x8*)(&Kh[(size_t)((k0) + 32 + sr) * LD + sc]); } while (0)
#define SWRITE(bb, i) do { *(bf16x8*)(V_lds + (bb) * SHM_V + vst0) = sr_[i].vs0;          \
    *(bf16x8*)(V_lds + (bb) * SHM_V + vst1) = sr_[i].vs1; int kc = sc * 2;               \
    *(bf16x8*)(K_lds + (bb) * SHM_K + KSWZ(sr, kc)) = sr_[i].ks0;                       \
    *(bf16x8*)(K_lds + (bb) * SHM_K + KSWZ(32 + sr, kc)) = sr_[i].ks1; } while (0)
#define SWAIT() asm volatile("s_waitcnt vmcnt(0)" ::: "memory")
#define RESC(a) do { if (__any((a) < 1.f)) { if (hi == 0) al_l[r32] = (a); asm volatile("s_waitcnt lgkmcnt(0)" ::: "memory"); \
    _Pragma("unroll") for (int d = 0; d < 4; ++d) _Pragma("unroll") for (int r = 0; r < 16; ++r) o[d][r] *= al_l[crow(r, hi)]; } } while (0)
  f32x16 pA0, pA1, pB0, pB1; float mnA, mnB, alA, alB; bf16x8 pa0, pa1, pa2, pa3; constexpr int NT = SEQ / KVBLK;
  const int jd = 2 * qb; const float dq0 = dqs;
#define TK(j) ((((j) + jd) & (NT - 1)) * KVBLK)
#define DQS(j) fmaf(-sl2, (float)TK(j), dq0)
  SLOAD(0, TK(0)); asm volatile("s_waitcnt vmcnt(0)" ::: "memory"); SWRITE(0, 0);
  SLOAD(0, TK(1)); asm volatile("s_waitcnt vmcnt(0)" ::: "memory"); SWRITE(1, 0); __syncthreads();
  qkt(pA0, pA1, K_lds, qr, r32, hi, c); partialSM(pA0, pA1, m_reg, mnA, alA, DQS(0), sl2);
  const int qw0 = q0 + wq * 32;
  int cb = 0;
#define ATT_STEP(PC0, PC1, ALC, PN0, PN1, MNN, ALN, J) do { const int nb_ = (cb == 2) ? 0 : cb + 1, wb_ = (nb_ == 2) ? 0 : nb_ + 1; \
    SBAR(); qkt(PN0, PN1, K_lds + nb_ * SHM_K, qr, r32, hi, c); \
    finishSM(PC0, PC1, ALC, l_reg, pa0, pa1, pa2, pa3); SBAR(); \
    if ((J) + 2 < NT) SLOAD(0, TK((J) + 2)); SBAR(); \
    { const int kn_ = TK((J) + 1); const float dqs = DQS((J) + 1); const int side_ = (kn_ + KVBLK - 1 < qw0) ? 1 : ((kn_ > qw0 + 31) ? -1 : 0); \
      if (side_ != 0) pv_sm1(o, vb0 + cb * (int)SHM_V, pa0, pa1, pa2, pa3, PN0, PN1, m_reg, MNN, ALN, dqs, sl2, side_); \
      else { pv_d0(o, vb0 + cb * (int)SHM_V, pa0, pa1, pa2, pa3); partialSM(PN0, PN1, m_reg, MNN, ALN, dqs, sl2); } } \
    if ((J) + 2 < NT) { SWAIT(); SWRITE(wb_, 0); } \
    RESC(ALN); __syncthreads(); cb = nb_; } while (0)
  for (int j = 0; j + 2 < NT; j += 2) {
    ATT_STEP(pA0, pA1, alA, pB0, pB1, mnB, alB, j);
    ATT_STEP(pB0, pB1, alB, pA0, pA1, mnA, alA, j + 1);
  }
  ATT_STEP(pA0, pA1, alA, pB0, pB1, mnB, alB, NT - 2);
  finishSM(pB0, pB1, alB, l_reg, pa0, pa1, pa2, pa3); SBAR();
  pv_d0(o, vb0 + cb * (int)SHM_V, pa0, pa1, pa2, pa3);
#undef ATT_STEP
#undef TK
#undef DQS
  if (hi == 0) li_l[r32] = l_reg; asm volatile("s_waitcnt lgkmcnt(0)" ::: "memory");
  float rli[16];
#pragma unroll
  for (int r = 0; r < 16; ++r) rli[r] = __builtin_amdgcn_rcpf(li_l[crow(r, hi)]);
  asm volatile("s_waitcnt vmcnt(0)" ::: "memory");
  __syncthreads();
  float* X = (float*)lds + c * (128 * XS);
#pragma unroll
  for (int r = 0; r < 16; ++r) { const int orow = wq * 32 + crow(r, hi);
#pragma unroll
    for (int d0 = 0; d0 < 4; ++d0) X[orow * XS + d0 * 32 + r32] = o[d0][r] * rli[r]; }
  __syncthreads();
  { const int row = tid >> 2, q = tid & 3; const float* X1 = (const float*)lds + row * XS + q * 32; const float* X2 = X1 + 128 * XS;
    f32x4 v[8]; float ss = 0.f;
#pragma unroll
    for (int i = 0; i < 8; ++i) { const int ii = (i + 4 * (q >> 1)) & 7; const f32x4 a = *(const f32x4*)(X1 + 4 * ii), bb = *(const f32x4*)(X2 + 4 * ii);
      v[i] = a - lam * bb; ss += (v[i][0] * v[i][0] + v[i][1] * v[i][1]) + (v[i][2] * v[i][2] + v[i][3] * v[i][3]); }
    ss += __shfl_xor(ss, 1); ss += __shfl_xor(ss, 2);
    const float rn = __builtin_amdgcn_rsqf(ss * (1.f / 128.f) + EPS) * 0.8f * EXP_ATTSCALE;
    bf16_t* orow = mix + (size_t)(b * SEQ + q0 + row) * DM + h * 128 + q * 32;
#pragma unroll
    for (int i = 0; i < 8; i += 2) { const int i0 = (i + 4 * (q >> 1)) & 7;
      const f32x4 g0 = *(const f32x4*)(subln_g + q * 32 + 4 * i0), g1 = *(const f32x4*)(subln_g + q * 32 + 4 * i0 + 4);
      const f32x4 a = v[i] * rn * g0, bb = v[i + 1] * rn * g1;
      u32x4 w = {cvtpk(a[0], a[1]), cvtpk(a[2], a[3]), cvtpk(bb[0], bb[1]), cvtpk(bb[2], bb[3])};
      *(u32x4*)(orow + 4 * i0) = w; } }
  __syncthreads();
#undef SLOAD
#undef SWRITE
#undef SWAIT
#undef RESC
}
}
namespace lru {
__device__ __forceinline__ int crow(int r, int hi) { return (r & 3) + 8 * (r >> 2) + 4 * hi; }
__device__ __forceinline__ f32x8 lds_ld8(const LAS float* p) { const f32x4 a = *(const LAS f32x4*)p, b = *(const LAS f32x4*)(p + 4); return (f32x8){a[0], a[1], a[2], a[3], b[0], b[1], b[2], b[3]}; }
__device__ __forceinline__ void lds_st8(LAS float* p, f32x8 v) { *(LAS f32x4*)p = (f32x4){v[0], v[1], v[2], v[3]}; *(LAS f32x4*)(p + 4) = (f32x4){v[4], v[5], v[6], v[7]}; }
struct Params { const bf16_t* proj; float* ys; bf16_t* mix; unsigned* pair_cnt; const bf16x8* packw; const float *conv_w, *conv_b, *b_a, *b_x, *lambda; };
__device__ __forceinline__ void lru_item(int item, const Params& p, LAS unsigned char* lds) {
  int tid_l = threadIdx.x; asm volatile("" : "+v"(tid_l));
  const int tid = tid_l, wid = __builtin_amdgcn_readfirstlane(tid >> 6), lane = tid & 63, r32 = lane & 31, hi = lane >> 5;
  const int dir = item & 1, seg = wid, b = item >> 4, n = (item >> 1) & 7;
  LAS float* xcu = (LAS float*)(lds + wid * 16896);
  LAS float* abuf = (LAS float*)(lds + wid * 16896 + 8704);
  LAS float* tot = (LAS float*)(lds + LDS_TOT);
  LAS float* cwl = (LAS float*)(lds + LDS_CW);
  if (tid < 320) { const int k = tid >> 6, ch = tid & 63; cwl[tid] = (k < 4) ? p.conv_w[k * 512 + 64 * n + ch] : p.conv_b[64 * n + ch]; }
  bf16x8 Bf[2][2][4];
  { const bf16x8* pw = p.packw + (size_t)((dir * 8 + n) * 16) * 64 + lane;
#pragma unroll
    for (int g = 0; g < 2; ++g)
#pragma unroll
      for (int nb = 0; nb < 2; ++nb)
#pragma unroll
        for (int s = 0; s < 4; ++s) Bf[g][nb][s] = pw[((g * 2 + nb) * 4 + s) * 64]; }
  float ba[2], bx[2], cl2[2];
#pragma unroll
  for (int nb = 0; nb < 2; ++nb) { const int ch = dir * 512 + 64 * n + 32 * nb + r32; ba[nb] = p.b_a[ch]; bx[nb] = p.b_x[ch];
    const float lam = p.lambda[ch]; const float sp = (lam > 15.f) ? __expf(-lam) : log1pf(__expf(-lam));
    cl2[nb] = 8.f * sp * L2E; }
  float hc = 0.f;
  __syncthreads();
  const bf16_t* xr_base = p.proj + (size_t)(b * SEQ) * INW + 1536 + 64 * n;
  float* ybase = p.ys + (size_t)dir * T_ * 512 + (size_t)(b * SEQ) * 512 + 64 * n;
  u32x4 pre[5];
#define LRU_LOAD_RAW(T0) do { _Pragma("unroll") for (int i = 0; i < 5; ++i) { const int row = i * 8 + (lane >> 3), tt = (T0) - 2 + row; pre[i] = (u32x4){0u, 0u, 0u, 0u}; \
      if (row < 35 && tt >= 0 && tt < SEQ) pre[i] = *(const u32x4*)(xr_base + (size_t)tt * INW + (lane & 7) * 8); } } while (0)
  LRU_LOAD_RAW((dir ? 7 : 0) * 256 + seg * 32);
  for (int it = 0; it < 8; ++it) {
    const int tile = dir ? 7 - it : it, t0 = tile * 256 + seg * 32;
    { LAS unsigned char* raw = (LAS unsigned char*)abuf;
#pragma unroll
      for (int i = 0; i < 5; ++i) { const int row = i * 8 + (lane >> 3); if (row < 35) *(LAS u32x4*)(raw + row * 144 + (lane & 7) * 16) = pre[i]; }
      if (it < 7) LRU_LOAD_RAW((dir ? 6 - it : it + 1) * 256 + seg * 32);
#pragma unroll
      for (int cc = 0; cc < 4; ++cc) { const int ch0 = 32 * hi + 8 * cc;
        f32x8 acc = lds_ld8(cwl + 4 * 64 + ch0);
#pragma unroll
        for (int k = 0; k < 4; ++k) { const bf16x8 v = *(LAS const bf16x8*)(raw + (r32 + k) * 144 + ch0 * 2); const f32x8 w = lds_ld8(cwl + k * 64 + ch0);
#pragma unroll
          for (int j = 0; j < 8; ++j) acc[j] += w[j] * bf2f(v[j]); }
        lds_st8(xcu + r32 * 68 + ch0, acc); } }
    bf16x8 af[4];
#pragma unroll
    for (int s = 0; s < 4; ++s) af[s] = pack8(lds_ld8(xcu + r32 * 68 + 16 * s + 8 * hi));
#pragma unroll
    for (int nb = 0; nb < 2; ++nb) {
      f32x16 acca = {}, accx = {};
#pragma unroll
      for (int s = 0; s < 4; ++s) { acca = __builtin_amdgcn_mfma_f32_32x32x16_bf16(af[s], Bf[0][nb][s], acca, 0, 0, 0); accx = __builtin_amdgcn_mfma_f32_32x32x16_bf16(af[s], Bf[1][nb][s], accx, 0, 0, 0); }
#pragma unroll
      for (int rg = 0; rg < 16; ++rg) { const int tk = crow(rg, hi), ch = 32 * nb + r32;
        const float xc = xcu[tk * 68 + ch];
        const float ga = acca[rg] + ba[nb], gx = accx[rg] + bx[nb];
        const float r = __builtin_amdgcn_rcpf(1.f + __builtin_amdgcn_exp2f(-ga * L2E)), ii = __builtin_amdgcn_rcpf(1.f + __builtin_amdgcn_exp2f(-gx * L2E));
        const float a = __builtin_amdgcn_exp2f(-cl2[nb] * r);
        const float u = __builtin_amdgcn_sqrtf(fmaxf(fmaf(-a, a, 1.f), 0.f)) * ii * xc;
        abuf[tk * 64 + ch] = a; xcu[tk * 68 + ch] = u; }
    }
    { float P = 1.f, H = 0.f;
#pragma unroll 8
      for (int j = 0; j < 32; ++j) { const int tk = dir ? 31 - j : j; const float a = abuf[tk * 64 + lane], u = xcu[tk * 68 + lane];
        H = a * H + u; P *= a; abuf[tk * 64 + lane] = P; xcu[tk * 68 + lane] = H; }
      LAS float* tt = tot + (((it & 1) * 8 + seg) * 128);
      tt[lane] = P; tt[64 + lane] = H; }
    __syncthreads();
    float cin = hc;
    { float c = hc;
#pragma unroll
      for (int j = 0; j < 8; ++j) { const int sg = dir ? 7 - j : j; const LAS float* tt = tot + (((it & 1) * 8 + sg) * 128);
        const float Pj = tt[lane], Hj = tt[64 + lane]; if (sg == seg) cin = c; c = Pj * c + Hj; }
      hc = c; }
#pragma unroll 8
    for (int tk = 0; tk < 32; ++tk) __hip_atomic_store(ybase + (size_t)(t0 + tk) * 512 + lane, xcu[tk * 68 + lane] + abuf[tk * 64 + lane] * cin, __ATOMIC_RELAXED, __HIP_MEMORY_SCOPE_AGENT);
  }
  asm volatile("s_waitcnt vmcnt(0)" ::: "memory"); __syncthreads();
  volatile LAS unsigned* misc = (volatile LAS unsigned*)(lds + LDS_MISC);
  if (tid == 0) misc[1] = __hip_atomic_fetch_add(p.pair_cnt + (b * 8 + n), 1u, __ATOMIC_RELAXED, __HIP_MEMORY_SCOPE_AGENT);
  __syncthreads();
  const unsigned arrived = misc[1];
  if (arrived == 1u) {
    __builtin_amdgcn_fence(__ATOMIC_ACQUIRE, "agent");
    const float* yf = p.ys + (size_t)(b * SEQ) * 512 + 64 * n; const float* yb = yf + (size_t)T_ * 512;
    const bf16_t* gr = p.proj + (size_t)(b * SEQ) * INW + 2048 + 64 * n; bf16_t* mo = p.mix + (size_t)(b * SEQ) * DM + 512 + 64 * n;
#pragma unroll 8
    for (int idx = tid; idx < SEQ * 8; idx += 512) { const int t = idx >> 3, c8 = (idx & 7) * 8;
      const f32x8 a = *(const f32x8*)(yf + (size_t)t * 512 + c8), bb = *(const f32x8*)(yb + (size_t)t * 512 + c8); const bf16x8 g = *(const bf16x8*)(gr + (size_t)t * INW + c8);
      f32x8 o;
#pragma unroll
      for (int j = 0; j < 8; ++j) o[j] = gelu_tanh(bf2f(g[j])) * (a[j] + bb[j]) * EXP_LRUSCALE;
      *(bf16x8*)(mo + (size_t)t * DM + c8) = pack8(o); } }
  __syncthreads();
}
#undef LRU_LOAD_RAW
}
template <bool UPMAP>
__device__ __forceinline__ void p0_transpose_item(const float* __restrict__ W, int K, int N, bf16_t* WT, const float* __restrict__ kscale, LAS float* scr, int item, int lane) {
    const int nblk = N / 32, kb = item / nblk, nb = item % nblk, k0 = 64 * kb, n0 = 32 * nb;
#pragma unroll
    for (int i = 0; i < 32; ++i) { const int kk = 2 * i + (lane >> 5); float w = W[(size_t)(k0 + kk) * N + n0 + (lane & 31)]; if (kscale) w *= kscale[k0 + kk]; scr[kk * 33 + (lane & 31)] = w; }
    asm volatile("s_waitcnt lgkmcnt(0)" ::: "memory");
    const int c = lane & 7;
#pragma unroll
    for (int j = 0; j < 4; ++j) { const int n = (lane >> 3) + 8 * j; const LAS float* s = scr + (8 * c) * 33 + n;
        u32x4 o; o.x = cvtpk(s[0 * 33], s[1 * 33]); o.y = cvtpk(s[2 * 33], s[3 * 33]); o.z = cvtpk(s[4 * 33], s[5 * 33]); o.w = cvtpk(s[6 * 33], s[7 * 33]);
        int row = n0 + n;
        if (UPMAP) { const int f = row < FF ? row : row - FF; row = (f >> 7) * 256 + (row < FF ? 0 : 128) + (f & 127); }
        *(u32x4*)(WT + (size_t)row * K + k0 + 8 * c) = o; }
    asm volatile("s_waitcnt lgkmcnt(0)" ::: "memory");
}

#define XB_TMO      128
#define XB_XCNT(j)  (256  + 64 * (j))
#define XB_XSUB(j)  (1280 + 64 * (j))
#define XB_XGEN(j)  (2304 + 64 * (j))
#define XB_TOP      3328
#define XB_TOPGEN   3392
#define XCD_BAR_WORDS 3456
#define XB_SPIN_CAP (1u << 18)

__device__ __forceinline__ unsigned xb_ld(unsigned* p)              { return __hip_atomic_load(p, __ATOMIC_RELAXED, __HIP_MEMORY_SCOPE_AGENT); }
__device__ __forceinline__ unsigned xb_add(unsigned* p, unsigned v) { return __hip_atomic_fetch_add(p, v, __ATOMIC_RELAXED, __HIP_MEMORY_SCOPE_AGENT); }
__device__ __forceinline__ unsigned xb_xcc_id() { return (unsigned)__builtin_amdgcn_s_getreg((3 << 11) | 20) & 0xFu; }
#define XB_SPIN(cond, bar) do { unsigned _sp = 0; while (cond) { __builtin_amdgcn_s_sleep(1); \
    if ((++_sp & 255u) == 0u) { if (xb_ld(&(bar)[XB_TMO])) break; if (_sp > XB_SPIN_CAP) { atomicAdd(&(bar)[XB_TMO], 1u); break; } } } } while (0)

struct XcdBarrier {
    unsigned* bar; unsigned x;
    volatile LAS unsigned* st;
};

__device__ __forceinline__ XcdBarrier xcd_barrier_post(unsigned* bar, volatile LAS unsigned* st) {
    XcdBarrier b; b.bar = bar; b.x = xb_xcc_id(); b.st = st;
    if (threadIdx.x == 0) (void)xb_add(&bar[XB_XCNT(b.x)], 1u);
    return b;
}
__device__ __forceinline__ void xcd_barrier_complete(unsigned* bar, unsigned x, unsigned& nloc, unsigned& nx) {
    const unsigned G = gridDim.x * gridDim.y * gridDim.z;
    unsigned sum, cnt, mine, sp = 0u;
    for (;;) {
        sum = 0u; cnt = 0u; mine = 0u;
#pragma unroll
        for (unsigned j = 0; j < 16; ++j) { const unsigned c = xb_ld(&bar[XB_XCNT(j)]); sum += c; cnt += (c > 0u) ? 1u : 0u; mine = (j == x) ? c : mine; }
        if (sum == G) break;
        __builtin_amdgcn_s_sleep(1);
        if ((++sp & 255u) == 0u) { if (xb_ld(&bar[XB_TMO])) break; if (sp > XB_SPIN_CAP) { atomicAdd(&bar[XB_TMO], 1u); break; } }
    }
    nloc = mine > 0u ? mine : 1u; nx = cnt > 0u ? cnt : 1u;
}

__device__ __forceinline__ void xcd_barrier(const XcdBarrier& b) {
    asm volatile("s_waitcnt vmcnt(0)" ::: "memory");
    __syncthreads();
    if (threadIdx.x == 0) {
        unsigned* bar = b.bar;
        __builtin_amdgcn_s_waitcnt(0);
        unsigned nloc = b.st[0], nx = b.st[1];
        if (nloc == 0u) { xcd_barrier_complete(bar, b.x, nloc, nx); b.st[0] = nloc; b.st[1] = nx; }
        const unsigned old = xb_add(&bar[XB_XSUB(b.x)], 1u);
        const unsigned gen = old / nloc;
        if (old + 1u == (gen + 1u) * nloc) {
            __builtin_amdgcn_fence(__ATOMIC_RELEASE, "agent");
            asm volatile("s_waitcnt vmcnt(0)" ::: "memory");
            const unsigned og = xb_add(&bar[XB_TOP], 1u);
            const unsigned tg = og / nx;
            if (og + 1u == (tg + 1u) * nx) xb_add(&bar[XB_TOPGEN], 1u);
            else XB_SPIN(xb_ld(&bar[XB_TOPGEN]) == tg, bar);
            __builtin_amdgcn_fence(__ATOMIC_ACQUIRE, "agent");
            xb_add(&bar[XB_XGEN(b.x)], 1u);
            asm volatile("s_waitcnt vmcnt(0)" ::: "memory");
        } else {
            XB_SPIN(xb_ld(&bar[XB_XGEN(b.x)]) == gen, bar);
            __builtin_amdgcn_fence(__ATOMIC_ACQUIRE, "agent");
            asm volatile("s_waitcnt vmcnt(0)" ::: "memory");
        }
    }
    __syncthreads();
}

#ifndef PHMASK
#define PHMASK 127
#endif
struct Args { const float* in[22]; float* out; unsigned char* ws; };

__global__ void __launch_bounds__(512, 2) hymba_fwd(Args args) {
    extern __shared__ __attribute__((aligned(16))) unsigned char lds_raw[];
    LAS unsigned char* lds = (LAS unsigned char*)lds_raw;
    cg::grid_group grid = cg::this_grid();
    const int G = gridDim.x, bx = blockIdx.x;
    if (threadIdx.x < 32) ((volatile LAS unsigned*)(lds + LDS_MISC))[threadIdx.x] = 0u;
    __syncthreads();
    unsigned* barw = (unsigned*)(args.ws + WS_BAR);
    unsigned char* ws = args.ws;
    const float* x = args.in[0];
    unsigned* queue = (unsigned*)(ws + WS_QUEUE);
    float* ss1 = (float*)(ws + WS_SS1); float* ss2 = (float*)(ws + WS_SS2); float* rs0 = (float*)(ws + WS_RS0);
    bf16_t* Win_t = (bf16_t*)(ws + WS_WIN); bf16_t* Wout_t = (bf16_t*)(ws + WS_WOUT); bf16_t* Wup_t = (bf16_t*)(ws + WS_WUP); bf16_t* Wdn_t = (bf16_t*)(ws + WS_WDN);
    bf16_t* XB = (bf16_t*)(ws + WS_XB); bf16_t* PROJ = (bf16_t*)(ws + WS_PROJ); bf16_t* MIX = (bf16_t*)(ws + WS_MIX); bf16_t* ACT = (bf16_t*)(ws + WS_ACT);
    float* YS = (float*)(ws + WS_YS);

#if (PHMASK >> 0) & 1
    for (int rep = 0; rep < EXP_REP_P0; ++rep) {
        int tl = threadIdx.x; asm volatile("" : "+v"(tl)); const int tid = tl, lane = tl & 63, wave = __builtin_amdgcn_readfirstlane(tl >> 6);
        const int gw = bx * 8 + wave, NGW = G * 8;
        for (int i = bx * 512 + tid; i < (int)(WS_ZERO_BYTES / 4); i += G * 512) if (i < (int)(WS_RS0 / 4) || i >= (int)(WS_BAR / 4)) ((unsigned*)ws)[i] = 0u;
        if (bx == 0 && wave == 0) { const float d1 = wave_sum(args.in[3][lane] * args.in[4][lane]), d2 = wave_sum(args.in[5][lane] * args.in[6][lane]);
            if (lane == 0) *(float*)(ws + WS_LAM) = __expf(d1) - __expf(d2) + 0.2f; }
        for (int f = bx * 512 + tid; f < 32768; f += G * 512) {
            const int ln = f & 63, s = (f >> 6) & 3, nb = (f >> 8) & 1, gt = (f >> 9) & 1, dn = f >> 10;
            const float* W = (gt ? args.in[12] : args.in[10]) + (size_t)dn * 4096; f32x8 w;
#pragma unroll
            for (int j = 0; j < 8; ++j) w[j] = W[(16 * s + 8 * (ln >> 5) + j) * 64 + 32 * nb + (ln & 31)];
            ((bf16x8*)(ws + WS_PACKW))[f] = pack8(w); }
        LAS float* scr = (LAS float*)(lds + wave * 16384);
        constexpr int I_IN = (DM / 64) * (INW / 32);
        for (int it = gw; it < I_IN; it += NGW) p0_transpose_item<false>(args.in[2], DM, INW, Win_t, args.in[1], scr, it, lane);
        for (int m0 = gw; m0 < T_; m0 += 2 * NGW) {
            const int m1 = m0 + NGW;
            const f32x4* xa = (const f32x4*)(x + (size_t)m0 * DM) + lane; const f32x4* xb2 = (const f32x4*)(x + (size_t)(m1 < T_ ? m1 : m0) * DM) + lane;
            f32x4 va[4], vb[4]; float sa = 0.f, sb = 0.f;
#pragma unroll
            for (int j = 0; j < 4; ++j) { va[j] = xa[64 * j]; vb[j] = xb2[64 * j]; }
#pragma unroll
            for (int j = 0; j < 4; ++j) { sa += (va[j][0] * va[j][0] + va[j][1] * va[j][1]) + (va[j][2] * va[j][2] + va[j][3] * va[j][3]); sb += (vb[j][0] * vb[j][0] + vb[j][1] * vb[j][1]) + (vb[j][2] * vb[j][2] + vb[j][3] * vb[j][3]); }
            sa = wave_sum(sa); sb = wave_sum(sb);
            u32x2* oa = (u32x2*)(XB + (size_t)m0 * DM) + lane;
#pragma unroll
            for (int j = 0; j < 4; ++j) { u32x2 w; w.x = cvtpk(va[j][0], va[j][1]); w.y = cvtpk(va[j][2], va[j][3]); oa[64 * j] = w; }
            if (lane == 0) rs0[m0] = __builtin_amdgcn_rsqf(sa * (1.f / DM) + EPS);
            if (m1 < T_) { u32x2* ob = (u32x2*)(XB + (size_t)m1 * DM) + lane;
#pragma unroll
                for (int j = 0; j < 4; ++j) { u32x2 w; w.x = cvtpk(vb[j][0], vb[j][1]); w.y = cvtpk(vb[j][2], vb[j][3]); ob[64 * j] = w; }
                if (lane == 0) rs0[m1] = __builtin_amdgcn_rsqf(sb * (1.f / DM) + EPS); }
        }
    }
#endif
    grid.sync();
    const XcdBarrier xbar = xcd_barrier_post(barw, (volatile LAS unsigned*)(lds + LDS_MISC) + 8);

    for (int rep = 0; rep < EXP_EXTRA_SYNC; ++rep) xcd_barrier(xbar);
#if (PHMASK >> 1) & 1
    for (int rep = 0; rep < EXP_REP_P1; ++rep) {
        pg8::Gemm g{XB, Win_t, T_, INW, DM, 256}; pg8::StaticOrder S; S.init(T_, INW, G, bx);
        pg8::EpiProj E{PROJ, INW, rs0};
        pg8::gemm_phase<pg8::EpiProj, pg8::StaticOrder, true, true>(lds, g, S, E);
    }
#endif
    xcd_barrier(xbar);

#if (PHMASK >> 2) & 1
    {
        int tl = threadIdx.x; asm volatile("" : "+v"(tl)); const int tid = tl;
        const float lam = *(const float*)(ws + WS_LAM);
        lru::Params lp{PROJ, YS, MIX, (unsigned*)(ws + WS_LCNT), (const bf16x8*)(ws + WS_PACKW), args.in[8], args.in[9], args.in[11], args.in[13], args.in[14]};
        volatile LAS unsigned* misc = (volatile LAS unsigned*)(lds + LDS_MISC);
#ifndef NO_LRU
        for (int rep = 0; rep < EXP_REP_LRU; ++rep)
        for (;;) {
            if (tid == 0) misc[0] = atomicAdd(queue + rep * 128, 1u);
            __syncthreads();
            const int item = (int)misc[0];
            __syncthreads();
            if (item >= 128) break;
            lru::lru_item(item, lp, lds);
        }
#endif
#ifndef NO_ATT
        for (int rep = 0; rep < EXP_REP_ATT; ++rep)
        for (;;) {
            if (tid == 0) misc[0] = atomicAdd(queue + 64 + rep * 128, 1u);
            __syncthreads();
            const int item = (int)misc[0];
            __syncthreads();
            if (item >= 512) break;
            att::attn_unit(item, PROJ, MIX, args.in[7], lam, (char*)lds_raw);
        }
#endif
        {
            constexpr int I_OUT = (DM / 64) * (DM / 32), I_UP = (DM / 64) * (FF2 / 32), NF = (I_OUT + I_UP) / 8;
            const int lane = tid & 63, wave = __builtin_amdgcn_readfirstlane(tid >> 6);
            LAS float* scr = (LAS float*)(lds + wave * 16384);
            for (;;) {
                if (tid == 0) misc[0] = atomicAdd(queue + 320, 1u);
                __syncthreads();
                const int item = (int)misc[0];
                __syncthreads();
                if (item >= NF) break;
                int r = item * 8 + wave;
                if (r < I_OUT) p0_transpose_item<false>(args.in[15], DM, DM, Wout_t, nullptr, scr, r, lane);
                else p0_transpose_item<true>(args.in[17], DM, FF2, Wup_t, args.in[16], scr, r - I_OUT, lane);
            }
        }
    }
#endif
    xcd_barrier(xbar);

#if (PHMASK >> 3) & 1
    {
        pg8::Gemm g{MIX, Wout_t, T_, DM, DM, 256}; pg8::StaticOrder S; S.init(T_, DM, G, bx);
        pg8::EpiResBf E{XB, ss1, (LAS float*)(lds + LDS_EDGE)};
        pg8::gemm_phase<pg8::EpiResBf, pg8::StaticOrder, true, true>(lds, g, S, E);
    }
#endif
    xcd_barrier(xbar);

#if (PHMASK >> 4) & 1
    for (int rep = 0; rep < EXP_REP_P4; ++rep) {
        pg8::Gemm g{XB - DM, Wup_t, 65 * 256, FF2, DM, 254}; pg8::StaticOrder S; S.init(65 * 256, FF2, G, bx);
        pg8::EpiUp E{ACT, ss1, args.in[18], args.in[19], (LAS float*)(lds + LDS_EDGE)};
        pg8::gemm_phase<pg8::EpiUp, pg8::StaticOrder, true, true>(lds, g, S, E);
    }
    {
        constexpr int I_DN = (FF / 64) * (DM / 32), NF4 = I_DN / 8;
        int tl = threadIdx.x; asm volatile("" : "+v"(tl)); const int tid = tl, lane = tid & 63, wave = __builtin_amdgcn_readfirstlane(tid >> 6);
        volatile LAS unsigned* misc = (volatile LAS unsigned*)(lds + LDS_MISC); LAS float* scr = (LAS float*)(lds + wave * 16384);
        for (;;) {
            if (tid == 0) misc[0] = atomicAdd(queue + 384, 1u);
            __syncthreads();
            const int item = (int)misc[0];
            __syncthreads();
            if (item >= NF4) break;
            p0_transpose_item<false>(args.in[20], FF, DM, Wdn_t, nullptr, scr, item * 8 + wave, lane);
        }
    }
#endif
    xcd_barrier(xbar);

#if (PHMASK >> 5) & 1
    {
        pg8::Gemm g{ACT, Wdn_t, T_, DM, FF, 256}; pg8::StaticOrder S; S.init(T_, DM, G, bx);
        pg8::EpiResNorm E{XB, args.out, ss2, (unsigned*)(ws + WS_PCNT), args.in[21], (LAS float*)(lds + LDS_EDGE)};
        pg8::gemm_phase<pg8::EpiResNorm, pg8::StaticOrder, true, true>(lds, g, S, E);
    }
#endif

}

extern "C" void kernel_launch(void* const* d_in, const int* in_sizes, int n_in, void* d_out, int out_size, void* d_ws, size_t ws_size, hipStream_t stream) {
    static int grid = 0;
    if (grid == 0) {
        if (n_in != 22 || out_size != T_ * DM || ws_size < WS_END) { fprintf(stderr, "kernel_launch: unexpected shapes (n_in %d out %d ws %zu)\n", n_in, out_size, ws_size); grid = -1; return; }
        int dev = 0, cus = 0, per_cu = 0;
        (void)hipGetDevice(&dev); (void)hipDeviceGetAttribute(&cus, hipDeviceAttributeMultiprocessorCount, dev);
        if (hipFuncSetAttribute((const void*)hymba_fwd, hipFuncAttributeMaxDynamicSharedMemorySize, LDS_BYTES) != hipSuccess) { fprintf(stderr, "kernel_launch: hipFuncSetAttribute failed\n"); grid = -1; return; }
        if (hipOccupancyMaxActiveBlocksPerMultiprocessor(&per_cu, (const void*)hymba_fwd, 512, LDS_BYTES) != hipSuccess || per_cu < 1) per_cu = 1;
        (void)hipGetLastError();
        grid = cus * 1;
        if (grid != 256) { fprintf(stderr, "kernel_launch: built for a 256-CU device (got %d)\n", cus); grid = 256; }
    }
    if (grid < 0) return;
    Args a{};
    for (int i = 0; i < 22; ++i) a.in[i] = (const float*)d_in[i];
    a.out = (float*)d_out; a.ws = (unsigned char*)d_ws;
    void* kargs[] = {&a};
    hipError_t e = hipLaunchCooperativeKernel((const void*)hymba_fwd, dim3(grid), dim3(512), kargs, LDS_BYTES, stream);
    if (e != hipSuccess) fprintf(stderr, "cooperative launch failed: %s (grid %d)\n", hipGetErrorString(e), grid);
}
```
